# Optimizing an MI355X kernel written in HIP

```python
import jax
import jax.numpy as jnp
from jax import lax
import numpy as np

D_MODEL = 1024
BATCH = 16
SEQ = 2048
DEPTH = 2

CHUNK = 64

D_MIX = D_MODEL
N_GROUPS = 4
GROUP_W = D_MIX // N_GROUPS
HEAD_DIM = 64

FOX_HEADS = GROUP_W // HEAD_DIM
FOX_DH = HEAD_DIM
Q_BLOCK = 128
FOX_BIAS_INIT = 2.0

GDN_HEADS = GROUP_W // HEAD_DIM
GDN_DK = HEAD_DIM
GDN_DV = HEAD_DIM
GDN_CONV = 4

HG_HEADS = GROUP_W // HEAD_DIM
HG_DK = HEAD_DIM
HG_DV = HEAD_DIM
HG_KW = HG_HEADS * HG_DK

GLA_HEADS = GROUP_W // HEAD_DIM
GLA_DV = HEAD_DIM
GLA_DK = HEAD_DIM // 2
GLA_KW = GLA_HEADS * GLA_DK
GLA_RANK = 16
GLA_NORM = 16.0

LA_BLOCK = 16

D_FF = ((8 * D_MODEL // 3 + 255) // 256) * 256
FFN_CONV = 3
EPS = 1e-6

IN_SIZES = (
    3 * GROUP_W, FOX_HEADS,
    3 * GROUP_W, GDN_HEADS, GDN_HEADS, GROUP_W,
    HG_KW, HG_KW, GROUP_W, GROUP_W,
    2 * GLA_KW, GROUP_W, GLA_RANK, GROUP_W,
)
IN_COLS = sum(IN_SIZES)

kernel_name = 'hybrid_fox_gdn_hgrn2_gla_convffn'


def _cut_points(sizes):
    cuts, acc = [], 0
    for s in sizes[:-1]:
        acc += s
        cuts.append(acc)
    return cuts


def rms_norm(x, g):
    xf = x.astype(jnp.float32)
    y = xf * lax.rsqrt(jnp.mean(xf * xf, axis=-1, keepdims=True) + EPS)
    return (y * g.astype(jnp.float32)).astype(x.dtype)


def l2norm(x):
    return x * lax.rsqrt(jnp.sum(x * x, axis=-1, keepdims=True) + EPS)


def split_heads(t, n):
    b, s, w = t.shape
    return t.reshape(b, s, n, w // n).transpose(0, 2, 1, 3)


def merge_heads(t):
    b, h, s, d = t.shape
    return t.transpose(0, 2, 1, 3).reshape(b, s, h * d)


def causal_dwconv(x, w):
    k_w = w.shape[0]
    s = x.shape[1]
    xp = jnp.pad(x, ((0, 0), (k_w - 1, 0), (0, 0)))
    y = xp[:, 0:s] * w[0]
    for j in range(1, k_w):
        y = y + xp[:, j:j + s] * w[j]
    return y


def fox_attention(q, k, v, log_f):
    b, h, s, d = q.shape
    c = jnp.cumsum(log_f, axis=-1)
    nb = s // Q_BLOCK
    qb = q.reshape(b, h, nb, Q_BLOCK, d).transpose(2, 0, 1, 3, 4)
    cb = c.reshape(b, h, nb, Q_BLOCK).transpose(2, 0, 1, 3)
    pos_k = jnp.arange(s)
    scale = d ** -0.5

    def one_block(args):
        qi, ci, bi = args
        pos_q = bi * Q_BLOCK + jnp.arange(Q_BLOCK)
        logits = jnp.einsum('bhqd,bhkd->bhqk', qi, k) * scale + ci[..., :, None] - c[:, :, None, :]
        logits = jnp.where(pos_k[None, :] <= pos_q[:, None], logits, -jnp.inf)
        probs = jax.nn.softmax(logits, axis=-1)
        return jnp.einsum('bhqk,bhkd->bhqd', probs, v)

    o = lax.map(one_block, (qb, cb, jnp.arange(nb)))
    return o.transpose(1, 2, 0, 3, 4).reshape(b, h, s, d)


def gated_delta_chunked(q, k, v, g, beta):
    b, h, s, dk = q.shape
    dv = v.shape[-1]
    c = CHUNK
    n = s // c
    q = (q * dk ** -0.5).reshape(b, h, n, c, dk)
    k = k.reshape(b, h, n, c, dk)
    v = v.reshape(b, h, n, c, dv)
    beta = beta.reshape(b, h, n, c)
    G = jnp.cumsum(g.reshape(b, h, n, c), axis=-1)
    causal = jnp.tril(jnp.ones((c, c), bool))
    strict = jnp.tril(jnp.ones((c, c), bool), -1)
    decay = jnp.exp(jnp.where(causal, G[..., :, None] - G[..., None, :], -jnp.inf))
    kb = k * beta[..., None]
    m = jnp.where(strict, jnp.einsum('bhnrd,bhnsd->bhnrs', kb, k) * decay, 0.0)
    t_mat = m + jnp.eye(c, dtype=m.dtype)
    w = lax.linalg.triangular_solve(t_mat, kb * jnp.exp(G)[..., None],
                                    left_side=True, lower=True, unit_diagonal=True)
    u = lax.linalg.triangular_solve(t_mat, v * beta[..., None],
                                    left_side=True, lower=True, unit_diagonal=True)
    a_qk = jnp.where(causal, jnp.einsum('bhnrd,bhnsd->bhnrs', q, k) * decay, 0.0)
    q_in = q * jnp.exp(G)[..., None]
    k_out = k * jnp.exp(G[..., -1:] - G)[..., None]
    a_chunk = jnp.exp(G[..., -1])

    def step(state, inp):
        qi, ki, wi, ui, ai_qk, ai = inp
        v_new = ui - jnp.einsum('bhcd,bhde->bhce', wi, state)
        o = jnp.einsum('bhcd,bhde->bhce', qi, state) + jnp.einsum('bhrs,bhse->bhre', ai_qk, v_new)
        state = state * ai[..., None, None] + jnp.einsum('bhcd,bhce->bhde', ki, v_new)
        return state, o

    xs = tuple(jnp.moveaxis(t, 2, 0) for t in (q_in, k_out, w, u, a_qk, a_chunk))
    _, o = lax.scan(step, jnp.zeros((b, h, dk, dv), q.dtype), xs)
    return jnp.moveaxis(o, 0, 2).reshape(b, h, s, dv)


def gla_chunked(q, k, v, log_a, scale):
    b, h, s, dk = q.shape
    dv = v.shape[-1]
    c = LA_BLOCK
    n = s // c
    q = (q * scale).reshape(b, h, n, c, dk)
    k = k.reshape(b, h, n, c, dk)
    v = v.reshape(b, h, n, c, dv)
    G = jnp.cumsum(log_a.reshape(b, h, n, c, dk), axis=3)
    causal = jnp.tril(jnp.ones((c, c), bool))
    rel = jnp.where(causal[:, :, None], G[:, :, :, :, None, :] - G[:, :, :, None, :, :], -jnp.inf)
    a_intra = jnp.einsum('bhnrd,bhnsd,bhnrsd->bhnrs', q, k, jnp.exp(rel))
    o_intra = jnp.einsum('bhnrs,bhnse->bhnre', a_intra, v)
    g_last = G[:, :, :, -1]
    q_in = q * jnp.exp(G)
    k_out = k * jnp.exp(g_last[:, :, :, None, :] - G)
    a_chunk = jnp.exp(g_last)

    def step(state, inp):
        qi, ki, vi, ai = inp
        o = jnp.einsum('bhcd,bhde->bhce', qi, state)
        state = state * ai[..., None] + jnp.einsum('bhcd,bhce->bhde', ki, vi)
        return state, o

    xs = tuple(jnp.moveaxis(t, 2, 0) for t in (q_in, k_out, v, a_chunk))
    _, o_inter = lax.scan(step, jnp.zeros((b, h, dk, dv), q.dtype), xs)
    return (o_intra + jnp.moveaxis(o_inter, 0, 2)).reshape(b, h, s, dv)


def hgrn_lower_bounds(lb_param):
    cs = jnp.cumsum(jax.nn.softmax(lb_param.astype(jnp.float32), axis=0), axis=0)
    return cs - cs[0:1]


def token_mix(h, w_in, fox_qn_g, fox_kn_g, fox_b_f, fox_on_g, gdn_conv_w, gdn_a_log,
              gdn_dt_bias, gdn_on_g, lb, hg_on_g, gla_w_gk, gla_b_gk, gla_on_g):
    p = (h @ w_in).astype(jnp.float32)
    (fox_qkv, fox_f, gdn_qkv, gdn_b, gdn_a, gdn_z, hg_q, hg_f, hg_i, hg_g,
     gla_qk, gla_v, gla_gk, gla_g) = jnp.split(p, _cut_points(IN_SIZES), axis=-1)

    q, k, v = jnp.split(fox_qkv, 3, axis=-1)
    q = rms_norm(split_heads(q, FOX_HEADS), fox_qn_g)
    k = rms_norm(split_heads(k, FOX_HEADS), fox_kn_g)
    log_f = jax.nn.log_sigmoid(fox_f + fox_b_f).transpose(0, 2, 1)
    o_a = rms_norm(fox_attention(q, k, split_heads(v, FOX_HEADS), log_f), fox_on_g)

    qkv = jax.nn.silu(causal_dwconv(gdn_qkv, gdn_conv_w))
    q, k, v = jnp.split(qkv, 3, axis=-1)
    beta = jax.nn.sigmoid(gdn_b).transpose(0, 2, 1)
    g = (-jnp.exp(gdn_a_log) * jax.nn.softplus(gdn_a + gdn_dt_bias)).transpose(0, 2, 1)
    o_b = gated_delta_chunked(l2norm(split_heads(q, GDN_HEADS)), l2norm(split_heads(k, GDN_HEADS)),
                              split_heads(v, GDN_HEADS), g, beta)
    o_b = rms_norm(o_b, gdn_on_g) * jax.nn.silu(split_heads(gdn_z, GDN_HEADS))

    lbh = lb.reshape(HG_HEADS, 1, HG_DK)
    f_logit = split_heads(hg_f, HG_HEADS)
    log_forget = jnp.logaddexp(jnp.log(lbh), jnp.log1p(-lbh) + jax.nn.log_sigmoid(f_logit))
    k_in = (1.0 - lbh) * jax.nn.sigmoid(-f_logit)
    o_c = gla_chunked(jax.nn.silu(split_heads(hg_q, HG_HEADS)), k_in, split_heads(hg_i, HG_HEADS),
                      log_forget, HG_DK ** -0.5)
    o_c = rms_norm(o_c, hg_on_g) * jax.nn.silu(split_heads(hg_g, HG_HEADS))

    q, k = jnp.split(gla_qk, 2, axis=-1)
    log_a = jax.nn.log_sigmoid(gla_gk @ gla_w_gk + gla_b_gk) / GLA_NORM
    o_d = gla_chunked(split_heads(q, GLA_HEADS), split_heads(k, GLA_HEADS), split_heads(gla_v, GLA_HEADS),
                      split_heads(log_a, GLA_HEADS), GLA_DK ** -0.5)
    o_d = rms_norm(o_d, gla_on_g) * jax.nn.silu(split_heads(gla_g, GLA_HEADS))

    return jnp.concatenate([merge_heads(o_a), merge_heads(o_b), merge_heads(o_c), merge_heads(o_d)], axis=-1)


def conv_glu_ffn(h, w_up, conv_w, conv_b, w_down):
    u = causal_dwconv(h @ w_up, conv_w) + conv_b
    gate, up = jnp.split(u, 2, axis=-1)
    return (jax.nn.silu(gate) * up) @ w_down


def setup_inputs(seed: int = 0) -> dict:
    key = jax.random.key(seed)
    ks = jax.random.split(key, 24)
    f32 = jnp.float32

    def nrm(k, shape, scale):
        return scale * jax.random.normal(k, shape, f32)

    def gain(k, n):
        return 1.0 + 0.1 * jax.random.normal(k, (DEPTH, n), f32)

    dt = jnp.exp(jax.random.uniform(ks[8], (DEPTH, GDN_HEADS), f32, jnp.log(1e-3), jnp.log(1e-1)))
    return {
        'x': nrm(ks[0], (BATCH, SEQ, D_MODEL), 1.0),
        'norm1_g': gain(ks[1], D_MODEL),
        'w_in': nrm(ks[2], (DEPTH, D_MODEL, IN_COLS), D_MODEL ** -0.5),
        'fox_qn_g': gain(ks[3], FOX_DH),
        'fox_kn_g': gain(ks[4], FOX_DH),
        'fox_b_f': FOX_BIAS_INIT + nrm(ks[5], (DEPTH, FOX_HEADS), 0.1),
        'fox_on_g': gain(ks[6], FOX_DH),
        'gdn_conv_w': nrm(ks[7], (DEPTH, GDN_CONV, 3 * GROUP_W), GDN_CONV ** -0.5),
        'gdn_a_log': jnp.log(jax.random.uniform(ks[9], (DEPTH, GDN_HEADS), f32, 1.0, 16.0)),
        'gdn_dt_bias': dt + jnp.log(-jnp.expm1(-dt)),
        'gdn_on_g': gain(ks[10], GDN_DV),
        'hg_lb': nrm(ks[11], (DEPTH, HG_KW), 0.1),
        'hg_on_g': gain(ks[12], HG_DV),
        'gla_w_gk': nrm(ks[13], (DEPTH, GLA_RANK, GLA_KW), GLA_RANK ** -0.5),
        'gla_b_gk': nrm(ks[14], (DEPTH, GLA_KW), 0.1),
        'gla_on_g': gain(ks[15], GLA_DV),
        'w_out': nrm(ks[16], (DEPTH, D_MIX, D_MODEL), D_MIX ** -0.5),
        'norm2_g': gain(ks[17], D_MODEL),
        'w_up': nrm(ks[18], (DEPTH, D_MODEL, 2 * D_FF), D_MODEL ** -0.5),
        'ffn_conv_w': nrm(ks[19], (DEPTH, FFN_CONV, 2 * D_FF), FFN_CONV ** -0.5),
        'ffn_conv_b': nrm(ks[20], (DEPTH, 2 * D_FF), 0.02),
        'w_down': nrm(ks[21], (DEPTH, D_FF, D_MODEL), D_FF ** -0.5),
    }


def reference(x, norm1_g, w_in, fox_qn_g, fox_kn_g, fox_b_f, fox_on_g, gdn_conv_w, gdn_a_log,
              gdn_dt_bias, gdn_on_g, hg_lb, hg_on_g, gla_w_gk, gla_b_gk, gla_on_g, w_out,
              norm2_g, w_up, ffn_conv_w, ffn_conv_b, w_down):
    lower_bounds = hgrn_lower_bounds(hg_lb)
    for l in range(DEPTH):
        mixed = token_mix(rms_norm(x, norm1_g[l]), w_in[l], fox_qn_g[l], fox_kn_g[l], fox_b_f[l],
                          fox_on_g[l], gdn_conv_w[l], gdn_a_log[l], gdn_dt_bias[l], gdn_on_g[l],
                          lower_bounds[l], hg_on_g[l], gla_w_gk[l], gla_b_gk[l], gla_on_g[l])
        x = x + mixed.astype(x.dtype) @ w_out[l]
        x = x + conv_glu_ffn(rms_norm(x, norm2_g[l]), w_up[l], ffn_conv_w[l], ffn_conv_b[l], w_down[l])
    return x
```

```cpp
#include <hip/hip_runtime.h>
#include <hip/hip_cooperative_groups.h>
#include <cstdio>
#include <cstdint>
namespace cg = cooperative_groups;
constexpr float RMS_EPS = 1e-6f;

namespace pg8 {
#define PG8_LAS __attribute__((address_space(3)))
typedef unsigned short bf16_t;
typedef short bf16x8 __attribute__((ext_vector_type(8)));
typedef float f32x4 __attribute__((ext_vector_type(4)));
typedef unsigned u32x4 __attribute__((ext_vector_type(4)));
constexpr int BM = 256, BK = 64, HALF = 128, HTB = HALF * BK * 2  , STAGE_BYTES = 8 * HTB, NXCD = 8, WGM = 8;

__host__ __device__ __forceinline__ int lds_byte(int r, int c) { const int st = (r >> 4) * 2 + (c >> 5), rr = r & 15, cc = c & 31, ob = rr * 64 + cc * 2; return st * 1024 + (ob ^ (((ob >> 9) & 1) << 5)); }
__host__ __device__ __forceinline__ void stage_rc(int b, int& R, int& C) { const int st = b / 1024, sb = b % 1024, swz = sb ^ (((sb >> 9) & 1) << 5); R = (st >> 1) * 16 + swz / 64; C = (st & 1) * 32 + (swz % 64) / 2; }
__host__ __device__ __forceinline__ int perm32(int rho) { const int n = rho >> 4, i = rho & 15; return 8 * (i >> 2) + 4 * n + (i & 3); }

struct Unit { int pm, pn; };
struct Gemm { const bf16_t* A; const bf16_t* Bt; int M, N, K; };

struct StaticOrder {
    int nM, nN, nwg, G, c;
    __host__ __device__ void init(int M, int N, int G_, int c_) { nM = M / BM; nN = N / BM; nwg = nM * nN; G = G_; c = c_; }
    __host__ __device__ bool next(int i, Unit& u) const {
        const long L = (long)i * G + c; if (L >= nwg) return false;
        int wgid = (int)L; { const int q = nwg / NXCD, r = nwg % NXCD, xcd = wgid % NXCD, off = wgid / NXCD; wgid = (xcd < r ? xcd * (q + 1) : r * (q + 1) + (xcd - r) * q) + off; }
        const int nig = WGM * nN, gid = wgid / nig, fm = gid * WGM, gsz = (nM - fm) < WGM ? (nM - fm) : WGM;
        u.pm = fm + ((wgid % nig) % gsz); u.pn = (wgid % nig) / gsz; return true;
    }
    __device__ __forceinline__ void a_ready(const Unit&) const {}
    __device__ __forceinline__ void done(const Unit&) const {}
};
__device__ __forceinline__ unsigned cvt_pk_bf16(float lo, float hi) { unsigned r; asm volatile("v_cvt_pk_bf16_f32 %0, %1, %2" : "=v"(r) : "v"(lo), "v"(hi)); return r; }
typedef float f32x2 __attribute__((ext_vector_type(2)));

typedef unsigned u32x2 __attribute__((ext_vector_type(2)));
struct EpiP {
    static constexpr bool PERM = true, AFTER_DRAIN = false, PROBE_DUP = true;
    bf16_t* P; float* PS; const float* ss;
    __device__ __forceinline__ void operator()(const f32x4 (&acc)[2][2][4][2], const Unit& u, int wr, int wc, int fr, int fq) const {
        const int row0 = u.pm * BM + wr * 64 + fr;
        float rs[2][4];
#pragma unroll
        for (int ai = 0; ai < 2; ++ai)
#pragma unroll
            for (int m = 0; m < 4; ++m) rs[ai][m] = ss[row0 + ai * HALF + m * 16];
#pragma unroll
        for (int ai = 0; ai < 2; ++ai)
#pragma unroll
            for (int m = 0; m < 4; ++m) {
                const int row = row0 + ai * HALF + m * 16;
                const float rstd = __builtin_amdgcn_rsqf(rs[ai][m] * (1.0f / 1024.0f) + RMS_EPS);
                if (u.pn < 14) {
                    bf16_t* rowp = P + (size_t)row * 3584 + u.pn * BM + wc * 32 + 8 * fq;
#pragma unroll
                    for (int bj = 0; bj < 2; ++bj) { const f32x4 v0 = acc[ai][bj][m][0] * rstd, v1 = acc[ai][bj][m][1] * rstd;
                        u32x4 w; w.x = cvt_pk_bf16(v0[0], v0[1]); w.y = cvt_pk_bf16(v0[2], v0[3]); w.z = cvt_pk_bf16(v1[0], v1[1]); w.w = cvt_pk_bf16(v1[2], v1[3]);
                        __builtin_nontemporal_store(w, (u32x4*)(rowp + bj * HALF)); }
                } else if (wc == 0) {
                    float* rowp = PS + (size_t)row * 32 + 8 * fq;
                    *(f32x4*)(rowp) = acc[ai][0][m][0] * rstd; *(f32x4*)(rowp + 4) = acc[ai][0][m][1] * rstd;
                }
            }
    }
};
template <bool LAST> struct EpiRes {
    static constexpr bool PERM = false, AFTER_DRAIN = false, PROBE_DUP = false;
    bf16_t* xb; float* out; float* ssq;
    __device__ __forceinline__ void operator()(const f32x4 (&acc)[2][2][4][2], const Unit& u, int wr, int wc, int fr, int fq) const {
        const int row0 = u.pm * BM + wr * 64 + fr, col0 = u.pn * BM + wc * 32 + 4 * fq;
#pragma unroll
        for (int ai = 0; ai < 2; ++ai) {
            u32x2 bv[4][2][2];
#pragma unroll
            for (int m = 0; m < 4; ++m)
#pragma unroll
                for (int bj = 0; bj < 2; ++bj)
#pragma unroll
                    for (int n = 0; n < 2; ++n) bv[m][bj][n] = *(const u32x2*)(xb + (size_t)(row0 + ai * HALF + m * 16) * 1024 + col0 + bj * HALF + n * 16);
#pragma unroll
            for (int m = 0; m < 4; ++m) {
                const int row = row0 + ai * HALF + m * 16; float s = 0.f;
#pragma unroll
                for (int bj = 0; bj < 2; ++bj)
#pragma unroll
                    for (int n = 0; n < 2; ++n) { const size_t off = (size_t)row * 1024 + col0 + bj * HALF + n * 16; const u32x2 b = bv[m][bj][n];
                        f32x4 o = acc[ai][bj][m][n];
                        o[0] += __uint_as_float(b.x << 16); o[1] += __uint_as_float(b.x & 0xffff0000u); o[2] += __uint_as_float(b.y << 16); o[3] += __uint_as_float(b.y & 0xffff0000u);
                        if (LAST) *(f32x4*)(out + off) = o;
                        else { s += (o[0] * o[0] + o[1] * o[1]) + (o[2] * o[2] + o[3] * o[3]);
                            u32x2 w; w.x = cvt_pk_bf16(o[0], o[1]); w.y = cvt_pk_bf16(o[2], o[3]); *(u32x2*)(xb + off) = w; } }
                if (!LAST) { s += __shfl_xor(s, 16); s += __shfl_xor(s, 32);
                    if (fq == 0) atomicAdd(ssq + row, s); }
            }
        }
    }
};
struct EpiConv {
    static constexpr bool PERM = true, AFTER_DRAIN = false, PROBE_DUP = false;
    bf16_t* ACT; float* HALO; const float* ss; const float* cw; const float* cb; PG8_LAS float* xl;
    template <int CTRL> static __device__ __forceinline__ float dpp(float old, float src) {
        return __builtin_bit_cast(float, __builtin_amdgcn_update_dpp(__builtin_bit_cast(int, old), __builtin_bit_cast(int, src), CTRL, 0xf, 0xf, false)); }
    __device__ __forceinline__ void operator()(const f32x4 (&acc)[2][2][4][2], const Unit& u, int wr, int wc, int fr, int fq) const {
        const int row0 = u.pm * BM + wr * 64 + fr;
        float rs[2][4];
#pragma unroll
        for (int ai = 0; ai < 2; ++ai)
#pragma unroll
            for (int m = 0; m < 4; ++m) rs[ai][m] = __builtin_amdgcn_rsqf(ss[row0 + ai * HALF + m * 16] * (1.0f / 1024.0f) + RMS_EPS);
        const int colg = u.pn * HALF + wc * 32 + 8 * fq;
        f32x4 wn[1][2][3], bn[1][2];
#define EPC_LOADW(n_) do { _Pragma("unroll") for (int bj = 0; bj < 2; ++bj) { const int c = bj * 2816 + colg + 4 * (n_); bn[0][bj] = *(const f32x4*)(cb + c); \
            _Pragma("unroll") for (int j = 0; j < 3; ++j) wn[0][bj][j] = *(const f32x4*)(cw + j * 5632 + c); } } while (0)
        EPC_LOADW(0);
        if (fr >= 14) {
#pragma unroll
            for (int ai = 0; ai < 2; ++ai) { PG8_LAS float* xp = xl + ((((ai * 2 + wr) * 4 + wc) * 2 + (fr - 14)) * 64) + 8 * fq;
#pragma unroll
                for (int bj = 0; bj < 2; ++bj)
#pragma unroll
                    for (int n = 0; n < 2; ++n) *(PG8_LAS f32x4*)(xp + bj * 32 + 4 * n) = acc[ai][bj][3][n] * rs[ai][3]; }
            if (wr == 1) { float* hp = HALO + ((size_t)(u.pm * 22 + u.pn) * 4 + 2 + (fr - 14)) * 256 + wc * 32 + 8 * fq;
#pragma unroll
                for (int bj = 0; bj < 2; ++bj)
#pragma unroll
                    for (int n = 0; n < 2; ++n) *(f32x4*)(hp + bj * HALF + 4 * n) = acc[1][bj][3][n] * rs[1][3]; }
        }
        if (fr < 2 && wr == 0) { float* hp = HALO + ((size_t)(u.pm * 22 + u.pn) * 4 + fr) * 256 + wc * 32 + 8 * fq;
#pragma unroll
            for (int bj = 0; bj < 2; ++bj)
#pragma unroll
                for (int n = 0; n < 2; ++n) *(f32x4*)(hp + bj * HALF + 4 * n) = acc[0][bj][0][n] * rs[0][0]; }
        asm volatile("s_waitcnt lgkmcnt(0)" ::: "memory"); __builtin_amdgcn_s_barrier(); asm volatile("" ::: "memory");
        const bool seq_start = (u.pm & 7) == 0;
#ifdef DUP_EPC
        for (int rep_ = 0; rep_ < 2; ++rep_) { asm volatile("" ::: "memory"); EPC_LOADW(0);
#endif
#pragma unroll
        for (int n = 0; n < 2; ++n) {
            if (n == 1) EPC_LOADW(1);
            f32x4 (&w)[2][3] = wn[0]; f32x4 (&bb)[2] = bn[0];
#pragma unroll
            for (int ai = 0; ai < 2; ++ai) {
                f32x4 prev[2];
                f32x4 h1[2], h2[2];
                const int pg = ai * 2 + wr - 1;
#pragma unroll
                for (int bj = 0; bj < 2; ++bj) {
                    if (pg >= 0) { const PG8_LAS float* xp = xl + (((pg * 4 + wc) * 2) * 64) + 8 * fq + bj * 32 + 4 * n;
                        const f32x4 r14 = *(const PG8_LAS f32x4*)xp, r15 = *(const PG8_LAS f32x4*)(xp + 64); h1[bj] = r15; h2[bj] = fr == 0 ? r14 : r15; }
                    else { h1[bj] = (f32x4){0.f, 0.f, 0.f, 0.f}; h2[bj] = h1[bj]; }
                }
#pragma unroll
                for (int m = 0; m < 4; ++m) {
                    f32x4 cur[2], uo[2];
#pragma unroll
                    for (int bj = 0; bj < 2; ++bj) { cur[bj] = acc[ai][bj][m][n] * rs[ai][m];
#pragma unroll
                        for (int k = 0; k < 4; ++k) {
                            const float r1 = m == 0 ? h1[bj][k] : dpp<0x121>(0.f, prev[bj][k]), r2 = m == 0 ? h2[bj][k] : dpp<0x122>(0.f, prev[bj][k]);
                            const float t1 = dpp<0x111>(r1, cur[bj][k]), t2 = dpp<0x112>(r2, cur[bj][k]);
                            uo[bj][k] = w[bj][0][k] * t2 + w[bj][1][k] * t1 + w[bj][2][k] * cur[bj][k] + bb[bj][k]; }
                        prev[bj] = cur[bj]; }
                    f32x4 a;
#pragma unroll
                    for (int k = 0; k < 4; ++k) a[k] = uo[0][k] * __builtin_amdgcn_rcpf(1.0f + __expf(-uo[0][k])) * uo[1][k];
                    u32x2 o; o.x = cvt_pk_bf16(a[0], a[1]); o.y = cvt_pk_bf16(a[2], a[3]);
                    *(u32x2*)(ACT + (size_t)(row0 + ai * HALF + m * 16) * 2816 + colg + 4 * n) = o;
                }
            }
        }
#ifdef DUP_EPC
        }
#endif
        (void)seq_start;
#undef EPC_LOADW
    }
};
template <class Epi, class Sched, bool ALIGN_EPI = false, bool SP2 = false>
__device__ __forceinline__ void gemm_phase(PG8_LAS unsigned char* lds, const Gemm g, const Sched& S, const Epi& E) {
    int tid_ = threadIdx.x; asm volatile("" : "+v"(tid_));
    const int tid = tid_, wid = __builtin_amdgcn_readfirstlane(tid >> 6), lane = tid & 63, wr = wid >> 2, wc = wid & 3, fr = lane & 15, fq = lane >> 4;
    const int K = g.K, nt = K / BK;
    unsigned voffA[2], voffB[2];
#pragma unroll
    for (int i = 0; i < 2; ++i) { int R, C; stage_rc(tid * 16 + i * 8192, R, C); const int Rb = Epi::PERM ? ((R & ~31) + perm32(R & 31)) : R;
        voffA[i] = (unsigned)(R * K + C) * 2u; voffB[i] = (unsigned)(Rb * K + C) * 2u; }
    const size_t kstep = (size_t)(BK * 2);
    const size_t hstep = (size_t)HALF * K * 2;
    const size_t tstep = 2 * hstep;
    const unsigned ldsw = (unsigned)wid * 1024u;
    const int aoff = lds_byte(wr * 64 + fr, fq * 8), boff = lds_byte(wc * 32 + fr, fq * 8);
#define PG8_SA(b, h) (((b) * 2 + (h)) * HTB)
#define PG8_SB(b, h) ((4 + (b) * 2 + (h)) * HTB)
#define PG8_STAGE(bufoff, gbase, voff) do { _Pragma("unroll") for (int _i = 0; _i < 2; ++_i) \
        __builtin_amdgcn_global_load_lds((const unsigned*)((const char*)(gbase) + (voff)[_i]), (PG8_LAS unsigned*)(lds + (bufoff) + ldsw + _i * 8192), 16, 0, 0); } while (0)
#define PG8_LDA(dst, b, h) do { _Pragma("unroll") for (int m = 0; m < 4; ++m) _Pragma("unroll") for (int k = 0; k < 2; ++k) dst[m][k] = *(const PG8_LAS bf16x8*)(lds + PG8_SA(b, h) + aoff + m * 2048 + k * 1024); } while (0)
#define PG8_LDB(dst, b, h) do { _Pragma("unroll") for (int n = 0; n < 2; ++n) _Pragma("unroll") for (int k = 0; k < 2; ++k) dst[n][k] = *(const PG8_LAS bf16x8*)(lds + PG8_SB(b, h) + boff + n * 2048 + k * 1024); } while (0)
#define PG8_MMA(ai, bj, At, Bt) do { __builtin_amdgcn_s_setprio(1); _Pragma("unroll") for (int m = 0; m < 4; ++m) _Pragma("unroll") for (int n = 0; n < 2; ++n) _Pragma("unroll") for (int k = 0; k < 2; ++k) \
        acc[ai][bj][m][n] = __builtin_amdgcn_mfma_f32_16x16x32_bf16(Bt[n][k], At[m][k], acc[ai][bj][m][n], 0, 0, 0); __builtin_amdgcn_s_setprio(0); } while (0)
#define PG8_WAIT_V(n) asm volatile("s_waitcnt vmcnt(" #n ")" ::: "memory")
#define PG8_WAIT_L(n) asm volatile("s_waitcnt lgkmcnt(" #n ")" ::: "memory")
#define PG8_BAR __builtin_amdgcn_s_barrier()
#define PG8_SCHED __builtin_amdgcn_sched_barrier(0)
    Unit cur, nxt; int ui = 0;
    if (!S.next(0, cur)) return;
    f32x4 acc[2][2][4][2];
#pragma unroll
    for (int a = 0; a < 2; ++a)
#pragma unroll
        for (int b = 0; b < 2; ++b)
#pragma unroll
            for (int m = 0; m < 4; ++m)
#pragma unroll
                for (int n = 0; n < 2; ++n) acc[a][b][m][n] = (f32x4){0.f, 0.f, 0.f, 0.f};
    bf16x8 At[4][2], B0[2][2], B1[2][2];
    const char* cA = (const char*)g.A + (size_t)cur.pm * tstep; const char* cB = (const char*)g.Bt + (size_t)cur.pn * tstep;
    S.a_ready(cur);
    if constexpr (SP2) {
        PG8_STAGE(PG8_SB(0, 0), cB, voffB); PG8_STAGE(PG8_SB(0, 1), cB + hstep, voffB); PG8_STAGE(PG8_SA(0, 0), cA, voffA); PG8_STAGE(PG8_SA(0, 1), cA + hstep, voffA);
        if (wr == 1) PG8_BAR;
        PG8_WAIT_V(2); PG8_BAR;
        PG8_STAGE(PG8_SB(1, 0), cB + kstep, voffB); PG8_STAGE(PG8_SA(1, 0), cA + kstep, voffA); PG8_STAGE(PG8_SB(1, 1), cB + hstep + kstep, voffB);
        PG8_WAIT_V(6); PG8_BAR;
    } else {
        PG8_STAGE(PG8_SB(0, 0), cB, voffB); PG8_STAGE(PG8_SA(0, 0), cA, voffA); PG8_STAGE(PG8_SB(0, 1), cB + hstep, voffB); PG8_STAGE(PG8_SA(0, 1), cA + hstep, voffA);
        if (wr == 1) PG8_BAR;
        PG8_WAIT_V(4); PG8_BAR;
        PG8_STAGE(PG8_SB(1, 0), cB + kstep, voffB); PG8_STAGE(PG8_SA(1, 0), cA + kstep, voffA); PG8_STAGE(PG8_SB(1, 1), cB + hstep + kstep, voffB);
        PG8_WAIT_V(6); PG8_BAR;
    }
    for (;;) {
        const bool has_next = S.next(ui + 1, nxt);
        const char* nA = has_next ? (const char*)g.A + (size_t)nxt.pm * tstep : cA; const char* nB = has_next ? (const char*)g.Bt + (size_t)nxt.pn * tstep : cB;
        for (int t = 0; t < nt; t += 2) {
            const bool last = (t == nt - 2);
            const char* a1 = cA + (size_t)(t + 1) * kstep;
            const char* a2 = last ? nA : cA + (size_t)(t + 2) * kstep; const char* b2 = last ? nB : cB + (size_t)(t + 2) * kstep;
            const char* a3 = a2 + kstep; const char* b3 = b2 + kstep;
            if (last && has_next) S.a_ready(nxt);
            if constexpr (SP2) {
            PG8_LDB(B0, 0, 0); PG8_LDB(B1, 0, 1); PG8_SCHED; PG8_LDA(At, 0, 0); PG8_STAGE(PG8_SA(1, 1), a1 + hstep, voffA);
            PG8_WAIT_V(8); PG8_WAIT_L(0); PG8_BAR; PG8_MMA(0, 0, At, B0); PG8_MMA(0, 1, At, B1); PG8_BAR; PG8_SCHED;
            PG8_LDA(At, 0, 1); PG8_STAGE(PG8_SB(0, 0), b2, voffB); PG8_STAGE(PG8_SB(0, 1), b2 + hstep, voffB); PG8_STAGE(PG8_SA(0, 0), a2, voffA);
            PG8_WAIT_V(8); PG8_WAIT_L(0); PG8_BAR; PG8_MMA(1, 0, At, B0); PG8_MMA(1, 1, At, B1); PG8_BAR; PG8_SCHED;
            PG8_LDB(B0, 1, 0); PG8_LDB(B1, 1, 1); PG8_SCHED; PG8_LDA(At, 1, 0); PG8_STAGE(PG8_SA(0, 1), a2 + hstep, voffA);
            PG8_WAIT_V(8); PG8_WAIT_L(0); PG8_BAR; PG8_MMA(0, 0, At, B0); PG8_MMA(0, 1, At, B1); PG8_BAR; PG8_SCHED;
            PG8_LDA(At, 1, 1); PG8_STAGE(PG8_SB(1, 0), b3, voffB); PG8_STAGE(PG8_SB(1, 1), b3 + hstep, voffB); PG8_STAGE(PG8_SA(1, 0), a3, voffA);
            PG8_WAIT_V(8); PG8_WAIT_L(0); PG8_BAR; PG8_MMA(1, 0, At, B0); PG8_MMA(1, 1, At, B1); PG8_BAR; PG8_SCHED;
            } else {
            PG8_LDB(B0, 0, 0); PG8_SCHED; PG8_LDA(At, 0, 0); PG8_STAGE(PG8_SA(1, 1), a1 + hstep, voffA);
            PG8_WAIT_L(8); PG8_BAR; PG8_WAIT_L(0); PG8_MMA(0, 0, At, B0); PG8_BAR; PG8_SCHED;
            PG8_LDB(B1, 0, 1); PG8_STAGE(PG8_SB(0, 0), b2, voffB);
            PG8_BAR; PG8_WAIT_L(0); PG8_MMA(0, 1, At, B1); PG8_BAR;
            PG8_LDA(At, 0, 1); PG8_STAGE(PG8_SA(0, 0), a2, voffA);
            PG8_BAR; PG8_WAIT_L(0); PG8_MMA(1, 0, At, B0); PG8_BAR; PG8_SCHED;
            PG8_STAGE(PG8_SB(0, 1), b2 + hstep, voffB);
            PG8_WAIT_V(6); PG8_BAR; PG8_MMA(1, 1, At, B1); PG8_BAR;
            PG8_LDB(B0, 1, 0); PG8_SCHED; PG8_LDA(At, 1, 0); PG8_STAGE(PG8_SA(0, 1), a2 + hstep, voffA);
            PG8_WAIT_L(8); PG8_BAR; PG8_WAIT_L(0); PG8_MMA(0, 0, At, B0); PG8_BAR; PG8_SCHED;
            PG8_LDB(B1, 1, 1); PG8_STAGE(PG8_SB(1, 0), b3, voffB);
            PG8_BAR; PG8_WAIT_L(0); PG8_MMA(0, 1, At, B1); PG8_BAR;
            PG8_LDA(At, 1, 1); PG8_STAGE(PG8_SA(1, 0), a3, voffA);
            PG8_BAR; PG8_WAIT_L(0); PG8_MMA(1, 0, At, B0); PG8_BAR; PG8_SCHED;
            PG8_STAGE(PG8_SB(1, 1), b3 + hstep, voffB);
            PG8_WAIT_V(6); PG8_BAR; PG8_MMA(1, 1, At, B1); PG8_BAR;
            }
        }
        if constexpr (ALIGN_EPI) { if (wr == 0) PG8_BAR; }
        if constexpr (!Epi::AFTER_DRAIN) { E(acc, cur, wr, wc, fr, fq);
#ifdef DUP_EPI
            if constexpr (Epi::PROBE_DUP) { asm volatile("" ::: "memory"); E(acc, cur, wr, wc, fr, fq); }
#endif
            S.done(cur); }
        if (!has_next) break;
#pragma unroll
        for (int a = 0; a < 2; ++a)
#pragma unroll
            for (int b = 0; b < 2; ++b)
#pragma unroll
                for (int m = 0; m < 4; ++m)
#pragma unroll
                    for (int n = 0; n < 2; ++n) acc[a][b][m][n] = (f32x4){0.f, 0.f, 0.f, 0.f};
        cur = nxt; cA = nA; cB = nB; ++ui;
        if constexpr (ALIGN_EPI) { if (wr == 1) PG8_BAR; }
    }
    PG8_WAIT_V(0);
    if constexpr (!ALIGN_EPI) { if (wr == 0) PG8_BAR; }
    PG8_BAR;
    if constexpr (Epi::AFTER_DRAIN) { E.fused(acc, cur, wr, wc, fr, fq, lds, wid, lane); S.done(cur); }
#undef PG8_SA
#undef PG8_SB
#undef PG8_STAGE
#undef PG8_LDA
#undef PG8_LDB
#undef PG8_MMA
#undef PG8_WAIT_V
#undef PG8_WAIT_L
#undef PG8_BAR
#undef PG8_SCHED
}
}
constexpr int BATCH = 16, SEQ = 2048, DM = 1024, MTOK = BATCH * SEQ, DEPTH = 2;
constexpr int IN_COLS = 3612, NP = 3584, N1 = 3840, DFF = 2816, NUP = 5632;
constexpr int NWAVES = 8, NTHREADS = 512;
constexpr int LDS_BYTES = 163840;
#define GAS __attribute__((address_space(1)))
#define LAS __attribute__((address_space(3)))
typedef unsigned short bf16;
typedef float f32x4 __attribute__((ext_vector_type(4)));
typedef unsigned v4u __attribute__((ext_vector_type(4)));
typedef unsigned v2u __attribute__((ext_vector_type(2)));
#define LDS_WAIT() asm volatile("s_waitcnt lgkmcnt(0)" ::: "memory")

constexpr size_t MiB = 1u << 20;
constexpr size_t WS_SS = 0;
constexpr size_t WS_BAR = 1536 * 1024;
constexpr size_t WS_CF = 1 * MiB;
constexpr size_t WS_W1T = 2 * MiB;
constexpr size_t WS_WOT = 17 * MiB;
constexpr size_t WS_WUT = 21 * MiB;
constexpr size_t WS_WDT = 43 * MiB;
constexpr size_t WS_XB = 56 * MiB;
constexpr size_t WS_P = 120 * MiB;
constexpr size_t WS_PS = 344 * MiB;
constexpr size_t WS_O = 348 * MiB;
constexpr size_t WS_GQ = 412 * MiB;
constexpr size_t WS_HALO = 476 * MiB;
constexpr size_t WS_ACT = 296 * MiB;
constexpr size_t WS_END = 508 * MiB;

__device__ __forceinline__ float bf2f(unsigned u) { return __uint_as_float(u << 16); }
__device__ __forceinline__ unsigned f2bf(float f) { unsigned u = __float_as_uint(f); return (u + 0x7fffu + ((u >> 16) & 1u)) >> 16; }
typedef float f32x2_t __attribute__((ext_vector_type(2))); typedef __bf16 bf16x2_t __attribute__((ext_vector_type(2)));
__device__ __forceinline__ unsigned pk2(float lo, float hi) { f32x2_t v = {lo, hi}; bf16x2_t r = __builtin_convertvector(v, bf16x2_t); return __builtin_bit_cast(unsigned, r); }
__device__ __forceinline__ float xsum16(float x) { const auto a = __builtin_amdgcn_permlane16_swap(__float_as_uint(x), __float_as_uint(x), false, false); return __uint_as_float(a[0]) + __uint_as_float(a[1]); }
__device__ __forceinline__ float xsum32(float x) { const auto a = __builtin_amdgcn_permlane32_swap(__float_as_uint(x), __float_as_uint(x), false, false); return __uint_as_float(a[0]) + __uint_as_float(a[1]); }
__device__ __forceinline__ float xmax16(float x) { const auto a = __builtin_amdgcn_permlane16_swap(__float_as_uint(x), __float_as_uint(x), false, false); return fmaxf(__uint_as_float(a[0]), __uint_as_float(a[1])); }
__device__ __forceinline__ float xmax32(float x) { const auto a = __builtin_amdgcn_permlane32_swap(__float_as_uint(x), __float_as_uint(x), false, false); return fmaxf(__uint_as_float(a[0]), __uint_as_float(a[1])); }
__device__ __forceinline__ float wave_sum(float v) {
#pragma unroll
    for (int o = 1; o < 64; o <<= 1) v += __shfl_xor(v, o);
    return v;
}
__device__ __forceinline__ float rcpf_(float x) { return __builtin_amdgcn_rcpf(x); }
__device__ __forceinline__ float rsqf_(float x) { return __builtin_amdgcn_rsqf(x); }
__device__ __forceinline__ float sigmoidf_(float x) { return rcpf_(1.0f + __expf(-x)); }
__device__ __forceinline__ float siluf_(float x) { return x * rcpf_(1.0f + __expf(-x)); }
__device__ __forceinline__ float softplusf_(float x) { return x > 20.f ? x : log1pf(__expf(x)); }
__device__ __forceinline__ float logsigmoidf_(float x) { return fminf(x, 0.f) - log1pf(__expf(-fabsf(x))); }
__device__ __forceinline__ void unpack8(const v4u w, float* f) {
    f[0] = __uint_as_float(w.x << 16); f[1] = __uint_as_float(w.x & 0xffff0000u); f[2] = __uint_as_float(w.y << 16); f[3] = __uint_as_float(w.y & 0xffff0000u);
    f[4] = __uint_as_float(w.z << 16); f[5] = __uint_as_float(w.z & 0xffff0000u); f[6] = __uint_as_float(w.w << 16); f[7] = __uint_as_float(w.w & 0xffff0000u);
}

__device__ __forceinline__ int map_w1(int j) {
    const int t = j >> 8, i = j & 255;
    if (t < 3) return j;
    if (t < 6) return 772 + (t - 3) * 256 + i;
    if (t == 6) return 1548 + i;
    if (t < 12) return 1804 + (t - 7) * 256 + i;
    if (t == 12) return 3084 + i;
    if (t == 13) return 3356 + i;
    if (i < 4) return 768 + i;
    if (i < 8) return 1540 + (i - 4);
    if (i < 12) return 1544 + (i - 8);
    if (i < 28) return 3340 + (i - 12);
    return -1;
}
template <int MAPKIND>
__device__ __forceinline__ void transpose_item(const float* W, int K, int N, bf16* WT, const float* gk, LAS float* scr, int item, int nblk, int lane) {
    const int kb = item / nblk, nb = item % nblk, k0 = 64 * kb, n0 = 32 * nb;
    const int jn = n0 + (lane & 31);
    const int src = MAPKIND == 1 ? map_w1(jn) : MAPKIND == 2 ? ((jn >> 8) * 128 + (jn & 127) + ((jn & 128) ? DFF : 0)) : jn;
    const int srcc = src >= 0 ? src : 0; const float keep = src >= 0 ? 1.f : 0.f;
    float wv[32], gv[32];
#pragma unroll
    for (int i = 0; i < 32; ++i) { const int kk = 2 * i + (lane >> 5); wv[i] = W[(size_t)(k0 + kk) * N + srcc]; gv[i] = gk ? gk[k0 + kk] : 1.f; }
#pragma unroll
    for (int i = 0; i < 32; ++i) { const int kk = 2 * i + (lane >> 5); scr[kk * 33 + (lane & 31)] = wv[i] * gv[i] * keep; }
    LDS_WAIT();
    const int c = lane & 7;
#pragma unroll
    for (int j = 0; j < 4; ++j) { const int n = (lane >> 3) + 8 * j; const LAS float* s = scr + (8 * c) * 33 + n;
        v4u o; o.x = pk2(s[0 * 33], s[1 * 33]); o.y = pk2(s[2 * 33], s[3 * 33]); o.z = pk2(s[4 * 33], s[5 * 33]); o.w = pk2(s[6 * 33], s[7 * 33]);
        *(v4u*)(WT + (size_t)(n0 + n) * K + k0 + 8 * c) = o; }
    LDS_WAIT();
}

#define CAS __attribute__((address_space(4)))
struct KArgs { const float* in[22]; float* out; unsigned char* ws; };
struct Ctx {
    const CAS KArgs* ka; float* out; unsigned char* ws;
    LAS unsigned char* lds;
    int tid, lane, wave, gw, ngw;
};

__device__ __forceinline__ void p0_prologue(Ctx& C) {
    LAS float* scr = (LAS float*)(C.lds + C.wave * 16384);
    constexpr int I1 = 16 * 120, I2 = 16 * 32, I3 = 16 * 176, I4 = 44 * 32, IL = I1 + I2 + I3 + I4;
    for (int it = C.gw; it < 2 * IL; it += C.ngw) {
        const int l = it / IL; int r = it % IL;
        if (r < I1) { transpose_item<1>(C.ka->in[2] + (size_t)l * DM * IN_COLS, DM, IN_COLS, (bf16*)(C.ws + WS_W1T) + (size_t)l * N1 * DM, C.ka->in[1] + l * DM, scr, r, 120, C.lane); continue; } r -= I1;
        if (r < I2) { transpose_item<0>(C.ka->in[16] + (size_t)l * DM * DM, DM, DM, (bf16*)(C.ws + WS_WOT) + (size_t)l * DM * DM, nullptr, scr, r, 32, C.lane); continue; } r -= I2;
        if (r < I3) { transpose_item<2>(C.ka->in[18] + (size_t)l * DM * NUP, DM, NUP, (bf16*)(C.ws + WS_WUT) + (size_t)l * NUP * DM, C.ka->in[17] + l * DM, scr, r, 176, C.lane); continue; } r -= I3;
        transpose_item<0>(C.ka->in[21] + (size_t)l * DFF * DM, DFF, DM, (bf16*)(C.ws + WS_WDT) + (size_t)l * DM * DFF, nullptr, scr, r, 32, C.lane);
    }
    float* ss = (float*)(C.ws + WS_SS);
    bf16* XB = (bf16*)(C.ws + WS_XB);
    for (int m0 = C.gw * 4; m0 < MTOK; m0 += C.ngw * 4) {
        f32x4 v[4][4];
#pragma unroll
        for (int r = 0; r < 4; ++r) { const f32x4* xr = (const f32x4*)(C.ka->in[0] + (size_t)(m0 + r) * DM) + C.lane;
#pragma unroll
            for (int j = 0; j < 4; ++j) v[r][j] = xr[64 * j]; }
#pragma unroll
        for (int r = 0; r < 4; ++r) { unsigned long long* o8 = (unsigned long long*)(XB + (size_t)(m0 + r) * DM) + C.lane; float s = 0.f;
#pragma unroll
            for (int j = 0; j < 4; ++j) { const f32x4 w = v[r][j]; s += (w.x * w.x + w.y * w.y) + (w.z * w.z + w.w * w.w);
                o8[64 * j] = (unsigned long long)pk2(w.x, w.y) | ((unsigned long long)pk2(w.z, w.w) << 32); }
            s = wave_sum(s);
            if (C.lane == 0) ss[m0 + r] = s; }
    }
    for (int i = blockIdx.x * NTHREADS + C.tid; i < 3 * MTOK; i += gridDim.x * NTHREADS) ss[MTOK + i] = 0.f;
}

__device__ __forceinline__ void m0_prep(Ctx& C, int l) {
    bf16* P = (bf16*)(C.ws + WS_P); const float* PS = (const float*)(C.ws + WS_PS); float* CF = (float*)(C.ws + WS_CF);
    const float* qn_g = C.ka->in[3] + l * 64; const float* kn_g = C.ka->in[4] + l * 64; const float* b_f = C.ka->in[5] + l * 4; const float* cw = C.ka->in[7] + l * 4 * 768;
    const int lane = C.lane;
    for (int bh = C.gw; bh < 64; bh += C.ngw) {
        const int b = bh >> 2, h = bh & 3; const float bias = b_f[h];
        const size_t r0 = (size_t)b * SEQ + lane * 32;
        float v[32];
#pragma unroll
        for (int i = 0; i < 32; ++i) v[i] = PS[(r0 + i) * 32 + h];
        float run = 0.f;
#pragma unroll
        for (int i = 0; i < 32; ++i) { run += logsigmoidf_(v[i] + bias); v[i] = run; }
        float inc = run;
#pragma unroll
        for (int o = 1; o < 64; o <<= 1) { const float t = __shfl_up(inc, o); if (lane >= o) inc += t; }
        const float ex = inc - run;
        float* cf = CF + (size_t)bh * SEQ + lane * 32;
#pragma unroll
        for (int i = 0; i < 32; i += 4) *(f32x4*)(cf + i) = (f32x4){ex + v[i], ex + v[i + 1], ex + v[i + 2], ex + v[i + 3]} * 1.4426950408889634f;
    }
    for (int m0 = C.gw * 4; m0 < MTOK; m0 += C.ngw * 4) {
        v4u w4[4];
#pragma unroll
        for (int r = 0; r < 4; ++r) w4[r] = *(const v4u*)(P + (size_t)(m0 + r) * NP + lane * 8);
        const float* g = (lane < 32 ? qn_g : kn_g) + (lane & 7) * 8;
        const f32x4 g0 = *(const f32x4*)g, g1 = *(const f32x4*)(g + 4);
#pragma unroll
        for (int r = 0; r < 4; ++r) {
            float f[8]; unpack8(w4[r], f);
            float s = 0.f;
#pragma unroll
            for (int i = 0; i < 8; ++i) s += f[i] * f[i];
            s += __shfl_xor(s, 1); s += __shfl_xor(s, 2); s += __shfl_xor(s, 4);
            const float rr = rsqf_(s * (1.0f / 64.0f) + RMS_EPS);
            const float sc = lane < 32 ? 0.18033688011112042f * rr : rr;
            v4u o; o.x = pk2(f[0] * sc * g0.x, f[1] * sc * g0.y); o.y = pk2(f[2] * sc * g0.z, f[3] * sc * g0.w); o.z = pk2(f[4] * sc * g1.x, f[5] * sc * g1.y); o.w = pk2(f[6] * sc * g1.z, f[7] * sc * g1.w);
            *(v4u*)(P + (size_t)(m0 + r) * NP + lane * 8) = o;
        }
    }
}
#define XB_TMO      128
#define XB_XCNT(j)  (256  + 64 * (j))
#define XB_XSUB(j)  (1280 + 64 * (j))
#define XB_XGEN(j)  (2304 + 64 * (j))
#define XB_TOP      3328
#define XB_TOPGEN   3392
#define XCD_BAR_WORDS 3456
#define XB_SPIN_CAP (1u << 18)

__device__ __forceinline__ unsigned xb_ld(unsigned* p)              { return __hip_atomic_load(p, __ATOMIC_RELAXED, __HIP_MEMORY_SCOPE_AGENT); }
__device__ __forceinline__ unsigned xb_add(unsigned* p, unsigned v) { return __hip_atomic_fetch_add(p, v, __ATOMIC_RELAXED, __HIP_MEMORY_SCOPE_AGENT); }
__device__ __forceinline__ unsigned xb_xcc_id() { return (unsigned)__builtin_amdgcn_s_getreg((3 << 11) | 20) & 0xFu; }
#define XB_SPIN(cond, bar) do { unsigned _sp = 0; while (cond) { __builtin_amdgcn_s_sleep(1); \
    if ((++_sp & 255u) == 0u) { if (xb_ld(&(bar)[XB_TMO])) break; if (_sp > XB_SPIN_CAP) { atomicAdd(&(bar)[XB_TMO], 1u); break; } } } } while (0)

struct XcdBarrier {
    unsigned* bar; unsigned x;
    volatile LAS unsigned* st;
};

__device__ __forceinline__ XcdBarrier xcd_barrier_post(unsigned* bar, volatile LAS unsigned* st) {
    XcdBarrier b; b.bar = bar; b.x = xb_xcc_id(); b.st = st;
    if (threadIdx.x == 0) (void)xb_add(&bar[XB_XCNT(b.x)], 1u);
    return b;
}
__device__ __forceinline__ void xcd_barrier_complete(unsigned* bar, unsigned x, unsigned& nloc, unsigned& nx) {
    const unsigned G = gridDim.x * gridDim.y * gridDim.z;
    unsigned sum, cnt, mine, sp = 0u;
    for (;;) {
        sum = 0u; cnt = 0u; mine = 0u;
#pragma unroll
        for (unsigned j = 0; j < 16; ++j) { const unsigned c = xb_ld(&bar[XB_XCNT(j)]); sum += c; cnt += (c > 0u) ? 1u : 0u; mine = (j == x) ? c : mine; }
        if (sum == G) break;
        __builtin_amdgcn_s_sleep(1);
        if ((++sp & 255u) == 0u) { if (xb_ld(&bar[XB_TMO])) break; if (sp > XB_SPIN_CAP) { atomicAdd(&bar[XB_TMO], 1u); break; } }
    }
    nloc = mine > 0u ? mine : 1u; nx = cnt > 0u ? cnt : 1u;
}

__device__ __forceinline__ void xcd_barrier(const XcdBarrier& b) {
    asm volatile("s_waitcnt vmcnt(0)" ::: "memory");
    __syncthreads();
    if (threadIdx.x == 0) {
        unsigned* bar = b.bar;
        __builtin_amdgcn_s_waitcnt(0);
        unsigned nloc = b.st[0], nx = b.st[1];
        if (nloc == 0u) { xcd_barrier_complete(bar, b.x, nloc, nx); b.st[0] = nloc; b.st[1] = nx; }
        const unsigned old = xb_add(&bar[XB_XSUB(b.x)], 1u);
        const unsigned gen = old / nloc;
        if (old + 1u == (gen + 1u) * nloc) {
            __builtin_amdgcn_fence(__ATOMIC_RELEASE, "agent");
            asm volatile("s_waitcnt vmcnt(0)" ::: "memory");
            const unsigned og = xb_add(&bar[XB_TOP], 1u);
            const unsigned tg = og / nx;
            if (og + 1u == (tg + 1u) * nx) xb_add(&bar[XB_TOPGEN], 1u);
            else XB_SPIN(xb_ld(&bar[XB_TOPGEN]) == tg, bar);
            __builtin_amdgcn_fence(__ATOMIC_ACQUIRE, "agent");
            xb_add(&bar[XB_XGEN(b.x)], 1u);
            asm volatile("s_waitcnt vmcnt(0)" ::: "memory");
        } else {
            XB_SPIN(xb_ld(&bar[XB_XGEN(b.x)]) == gen, bar);
            __builtin_amdgcn_fence(__ATOMIC_ACQUIRE, "agent");
            asm volatile("s_waitcnt vmcnt(0)" ::: "memory");
        }
    }
    __syncthreads();
}
typedef short s16x4 __attribute__((ext_vector_type(4)));
constexpr size_t OS_VTH = 0 * MiB, OS_VTG = 16 * MiB, OS_KTH = 32 * MiB, OS_KTG = 48 * MiB, OS_ADH = 56 * MiB, OS_ADG = 58 * MiB;
__device__ __forceinline__ f32x4 mfma16(s16x4 a, s16x4 b, f32x4 c) { return __builtin_amdgcn_mfma_f32_16x16x16bf16_1k(a, b, c, 0, 0, 0); }
__device__ __forceinline__ s16x4 ld8(const bf16* p) { return *(const s16x4*)p; }
__device__ __forceinline__ s16x4 cvt4(f32x4 v) { v2u w; w.x = pk2(v.x, v.y); w.y = pk2(v.z, v.w); return __builtin_bit_cast(s16x4, w); }

struct LinRaw { unsigned short v[16], q[16], k[16]; f32x4 gk4; };
template <int MODE>
__device__ __forceinline__ void lin_stage1_load(Ctx& C, int item, LinRaw& R) {
    const int lane = C.lane, bh = item >> 7, blk = item & 127, b = bh >> 2, h = bh & 3;
    const bf16* P = (const bf16*)(C.ws + WS_P); const size_t row0 = (size_t)b * SEQ + blk * 16;
    const bf16* vp = P + row0 * NP + (MODE == 0 ? 9 : 12) * 256 + h * 64 + lane;
    const bf16* qp = MODE == 0 ? P + row0 * NP + 7 * 256 + h * 64 + lane : P + row0 * NP + 11 * 256 + h * 32 + (lane & 31);
    const bf16* kp = qp + (MODE == 0 ? 256 : 128);
#pragma unroll
    for (int t = 0; t < 16; ++t) { R.v[t] = vp[(size_t)t * NP]; R.q[t] = qp[(size_t)t * NP]; R.k[t] = kp[(size_t)t * NP]; }
    if (MODE == 1) R.gk4 = *(const f32x4*)((const float*)(C.ws + WS_PS) + (row0 + (lane >> 2)) * 32 + 12 + 4 * (lane & 3));
}
template <int MODE>
__device__ __forceinline__ void lin_stage1_finish(Ctx& C, int l, int item, const LinRaw& R, LAS float* gl) {
    constexpr int DK = MODE == 0 ? 64 : 32;
    const int lane = C.lane, bh = item >> 7, blk = item & 127, b = bh >> 2, h = bh & 3;
    bf16* P = (bf16*)(C.ws + WS_P);
    const size_t row0 = (size_t)b * SEQ + blk * 16;
    bf16* Kt = (bf16*)((unsigned char*)C.out + (MODE == 0 ? OS_KTH : OS_KTG)) + (size_t)item * DK * 16;
    bf16* Vt = (bf16*)((unsigned char*)C.out + (MODE == 0 ? OS_VTH : OS_VTG)) + (size_t)item * 64 * 16;
    float* Ad = (float*)((unsigned char*)C.out + (MODE == 0 ? OS_ADH : OS_ADG)) + (size_t)item * DK;
    { unsigned w[8];
#pragma unroll
      for (int t = 0; t < 16; t += 2) w[t >> 1] = (unsigned)R.v[t] | ((unsigned)R.v[t + 1] << 16);
      v4u* o = (v4u*)(Vt + lane * 16); o[0] = (v4u){w[0], w[1], w[2], w[3]}; o[1] = (v4u){w[4], w[5], w[6], w[7]}; }
    const int d = lane;
    float la[16], kk[16], qq[16];
    bf16* qp; bf16* kp;
    if (MODE == 0) {
        float lb = 0.f;
        if (l == 1) { const float a0 = C.ka->in[11][h * 64 + d], a1 = C.ka->in[11][256 + h * 64 + d]; lb = rcpf_(1.0f + __expf(a0 - a1)); }
        qp = P + row0 * NP + 7 * 256 + h * 64 + d; kp = qp + 256;
#pragma unroll
        for (int t = 0; t < 16; ++t) { const float qv = bf2f(R.q[t]), fv = bf2f(R.k[t]); const float sg = sigmoidf_(fv);
            la[t] = __logf(lb + (1.0f - lb) * sg); kk[t] = (1.0f - lb) * (1.0f - sg); qq[t] = siluf_(qv) * 0.125f; }
    } else {
        const float* Wg = C.ka->in[13] + l * 16 * 128 + h * 32 + (d & 31); const float bg = C.ka->in[14][l * 128 + h * 32 + (d & 31)];
        float wg[16];
#pragma unroll
        for (int r = 0; r < 16; ++r) wg[r] = Wg[r * 128];
        qp = P + row0 * NP + 11 * 256 + h * 32 + (d & 31); kp = qp + 128;
        *(LAS f32x4*)(gl + lane * 4) = R.gk4;
        LDS_WAIT();
#pragma unroll
        for (int t = 0; t < 16; ++t) { float gk[16];
#pragma unroll
            for (int r4 = 0; r4 < 4; ++r4) { const f32x4 q4 = *(const LAS f32x4*)(gl + t * 16 + 4 * r4); gk[4 * r4] = q4.x; gk[4 * r4 + 1] = q4.y; gk[4 * r4 + 2] = q4.z; gk[4 * r4 + 3] = q4.w; }
            float zz = bg;
#pragma unroll
            for (int r = 0; r < 16; ++r) zz += gk[r] * wg[r];
            la[t] = logsigmoidf_(zz) * (1.0f / 16.0f); kk[t] = bf2f(R.k[t]); qq[t] = bf2f(R.q[t]) * 0.17677669529663687f; }
    }
    if (MODE == 0 || lane < 32) {
        float g = 0.f;
#pragma unroll
        for (int t = 0; t < 16; ++t) { g += la[t]; la[t] = g; }
        unsigned w[8];
#pragma unroll
        for (int t = 0; t < 16; ++t) {
            qp[(size_t)t * NP] = (bf16)f2bf(qq[t] * __expf(la[t]));
            kp[(size_t)t * NP] = (bf16)f2bf(kk[t] * __expf(fminf(-la[t], 80.f)));
            const unsigned kt = f2bf(kk[t] * __expf(g - la[t]));
            if (t & 1) w[t >> 1] |= kt << 16; else w[t >> 1] = kt;
        }
        { v4u* o = (v4u*)(Kt + d * 16); o[0] = (v4u){w[0], w[1], w[2], w[3]}; o[1] = (v4u){w[4], w[5], w[6], w[7]}; }
        Ad[d] = __expf(g);
    }
}
template <int MODE>
__device__ __forceinline__ void lin_stage1_pair(Ctx& C, int l, int itemA, int itemB, LAS unsigned char* wl) {
    LinRaw A, B; lin_stage1_load<MODE>(C, itemA, A); lin_stage1_load<MODE>(C, itemB, B);
    lin_stage1_finish<MODE>(C, l, itemA, A, (LAS float*)wl); lin_stage1_finish<MODE>(C, l, itemB, B, (LAS float*)(wl + 1024));
}
template <int MODE>
__device__ __forceinline__ void lin_stage1_quad(Ctx& C, int l, int item, int stride, LAS unsigned char* wl) {
    LinRaw A, B, D, E; lin_stage1_load<MODE>(C, item, A); lin_stage1_load<MODE>(C, item + stride, B); lin_stage1_load<MODE>(C, item + 2 * stride, D); lin_stage1_load<MODE>(C, item + 3 * stride, E);
    lin_stage1_finish<MODE>(C, l, item, A, (LAS float*)wl); lin_stage1_finish<MODE>(C, l, item + stride, B, (LAS float*)(wl + 1024));
    lin_stage1_finish<MODE>(C, l, item + 2 * stride, D, (LAS float*)(wl + 2048)); lin_stage1_finish<MODE>(C, l, item + 3 * stride, E, (LAS float*)(wl + 3072));
}

struct ScanSeg { const unsigned char* g; unsigned gstride, gstep; int nch, rowch, lpitch, loff; };
constexpr int SCAN_BH_LDS = 11520, SCAN_BUF = 2 * SCAN_BH_LDS, SCAN_XS = 2 * SCAN_BUF;
struct ScanCopy { const unsigned char* gp[3]; unsigned gstep[3]; int loff[3]; };
__device__ __forceinline__ void scan_copy_init(ScanCopy& cp, const ScanSeg (&segs)[2][6], int tid) {
    int per = 0;
#pragma unroll
    for (int s = 0; s < 6; ++s) per += segs[0][s].nch;
#pragma unroll
    for (int j = 0; j < 3; ++j) {
        const int c = tid + 512 * j; cp.gp[j] = nullptr; cp.gstep[j] = 0; cp.loff[j] = 0;
        if (c < 2 * per) {
            const int bhl = c >= per ? 1 : 0; int r = c - bhl * per;
#pragma unroll
            for (int s = 0; s < 6; ++s) {
                const ScanSeg& sg = segs[bhl][s];
                if (r >= 0 && r < sg.nch) {
                    const int row = sg.rowch ? r / sg.rowch : 0, ch = sg.rowch ? r % sg.rowch : r;
                    cp.gp[j] = sg.g + (size_t)row * sg.gstride + ch * 16; cp.gstep[j] = sg.gstep; cp.loff[j] = bhl * SCAN_BH_LDS + sg.loff + row * sg.lpitch + ch * 16;
                }
                r -= sg.nch;
            }
        } else { cp.gp[j] = cp.gp[0]; cp.gstep[j] = cp.gstep[0]; cp.loff[j] = cp.loff[0]; }
    }
}
__device__ __forceinline__ void scan_copy_load(const ScanCopy& cp, v4u (&R)[3], int step) {
#pragma unroll
    for (int j = 0; j < 3; ++j) R[j] = *(const v4u*)(cp.gp[j] + (size_t)step * cp.gstep[j]);
}
__device__ __forceinline__ void scan_copy_store(const ScanCopy& cp, const v4u (&R)[3], LAS unsigned char* buf) {
#pragma unroll
    for (int j = 0; j < 3; ++j) *(LAS v4u*)(buf + cp.loff[j]) = R[j];
}

template <int MODE>
__device__ __forceinline__ void lin_scan(Ctx& C, int l, int bh0) {
    constexpr int DK = MODE == 0 ? 64 : 32, ND = DK / 16, PQ = DK * 2 + 16;
    constexpr int OQ = 0, OK = 16 * PQ, OZ = 2 * 16 * PQ, OKT = OZ + 2304, OVT = OKT + DK * 32, OAD = OVT + 2048;
    static_assert(OAD + DK * 4 <= SCAN_BH_LDS, "scan LDS map");
    const int lane = C.lane, n = lane & 15, g = lane >> 4, et = C.wave & 3, bhl = C.wave >> 2, bh = bh0 + bhl, b = bh >> 2, h = bh & 3;
    const unsigned char* P = C.ws + WS_P; bf16* O = (bf16*)(C.ws + WS_O);
    const float* gain = (MODE == 0 ? C.ka->in[12] : C.ka->in[15]) + l * 64;
    const int ocol = (MODE == 0 ? 512 : 768) + h * 64;
    ScanSeg segs[2][6];
#pragma unroll
    for (int q = 0; q < 2; ++q) {
        const int bq = bh0 + q, hq = bq & 3; const size_t rb = (size_t)(bq >> 2) * SEQ;
        const int qcol = MODE == 0 ? 7 * 256 + hq * 64 : 11 * 256 + hq * 32, kcol = MODE == 0 ? 8 * 256 + hq * 64 : 11 * 256 + 128 + hq * 32, zcol = (MODE == 0 ? 10 : 13) * 256 + hq * 64;
        segs[q][0] = ScanSeg{P + (rb * NP + qcol) * 2, NP * 2, 16 * NP * 2, 16 * (DK / 8), DK / 8, PQ, OQ};
        segs[q][1] = ScanSeg{P + (rb * NP + kcol) * 2, NP * 2, 16 * NP * 2, 16 * (DK / 8), DK / 8, PQ, OK};
        segs[q][2] = ScanSeg{P + (rb * NP + zcol) * 2, NP * 2, 16 * NP * 2, 128, 8, 144, OZ};
        segs[q][3] = ScanSeg{(unsigned char*)C.out + (MODE == 0 ? OS_KTH : OS_KTG) + (size_t)bq * 128 * DK * 32, 0, DK * 32, DK * 2, 0, 0, OKT};
        segs[q][4] = ScanSeg{(unsigned char*)C.out + (MODE == 0 ? OS_VTH : OS_VTG) + (size_t)bq * 128 * 2048, 0, 2048, 128, 0, 0, OVT};
        segs[q][5] = ScanSeg{(unsigned char*)C.out + (MODE == 0 ? OS_ADH : OS_ADG) + (size_t)bq * 128 * DK * 4, 0, DK * 4, DK / 4, 0, 0, OAD};
    }
    ScanCopy cp; scan_copy_init(cp, segs, C.tid);
    LAS unsigned char* lds = C.lds; LAS float* xs = (LAS float*)(lds + SCAN_XS);
    f32x4 S[ND];
#pragma unroll
    for (int i = 0; i < ND; ++i) S[i] = (f32x4){0.f, 0.f, 0.f, 0.f};
    const f32x4 gn = *(const f32x4*)(gain + 16 * et + 4 * g);
    const size_t rowb = (size_t)b * SEQ;
    v4u R[4][3];
    scan_copy_load(cp, R[0], 0); scan_copy_store(cp, R[0], lds);
    scan_copy_load(cp, R[1], 1); scan_copy_load(cp, R[2], 2); scan_copy_load(cp, R[3], 3); scan_copy_load(cp, R[0], 4);
    __syncthreads();
#pragma unroll 1
    for (int blk0 = 0; blk0 < 128; blk0 += 4) {
#pragma unroll
        for (int u = 0; u < 4; ++u) {
            const int blk = blk0 + u;
            scan_copy_store(cp, R[(u + 1) & 3], lds + ((blk + 1) & 1) * SCAN_BUF);
            scan_copy_load(cp, R[(u + 1) & 3], blk + 5 < 128 ? blk + 5 : 127);
            const LAS unsigned char* base = lds + (blk & 1) * SCAN_BUF + bhl * SCAN_BH_LDS;
            s16x4 qf[ND], khf[ND], ktf[ND]; f32x4 ad[ND];
#pragma unroll
            for (int i = 0; i < ND; ++i) { qf[i] = *(const LAS s16x4*)(base + OQ + n * PQ + (16 * i + 4 * g) * 2); khf[i] = *(const LAS s16x4*)(base + OK + n * PQ + (16 * i + 4 * g) * 2);
                ktf[i] = *(const LAS s16x4*)(base + OKT + ((16 * i + n) * 16 + 4 * g) * 2); ad[i] = *(const LAS f32x4*)(base + OAD + (16 * i + 4 * g) * 4); }
            const s16x4 vtf = *(const LAS s16x4*)(base + OVT + ((16 * et + n) * 16 + 4 * g) * 2), zf = *(const LAS s16x4*)(base + OZ + n * 144 + (16 * et + 4 * g) * 2);
            f32x4 at = (f32x4){0.f, 0.f, 0.f, 0.f};
#pragma unroll
            for (int i = 0; i < ND; ++i) at = mfma16(khf[i], qf[i], at);
#pragma unroll
            for (int j = 0; j < 4; ++j) if (4 * g + j > n) at[j] = 0.f;
            f32x4 oT = mfma16(vtf, cvt4(at), (f32x4){0.f, 0.f, 0.f, 0.f});
#pragma unroll
            for (int i = 0; i < ND; ++i) oT = mfma16(cvt4(S[i]), qf[i], oT);
#pragma unroll
            for (int i = 0; i < ND; ++i) S[i] = mfma16(ktf[i], vtf, S[i] * ad[i]);
            float ss = (oT.x * oT.x + oT.y * oT.y) + (oT.z * oT.z + oT.w * oT.w);
            ss = xsum32(xsum16(ss));
            LAS float* xp = xs + (blk & 1) * 128 + bhl * 64;
            if (g == 0) xp[et * 16 + n] = ss;
            __syncthreads();
            ss = (xp[n] + xp[16 + n]) + (xp[32 + n] + xp[48 + n]);
            const float r = rsqf_(ss * (1.0f / 64.0f) + RMS_EPS);
            { const v2u zw = __builtin_bit_cast(v2u, zf);
              const float z0 = bf2f(zw.x & 0xffffu), z1 = bf2f(zw.x >> 16), z2 = bf2f(zw.y & 0xffffu), z3 = bf2f(zw.y >> 16);
              v2u w; w.x = pk2(oT.x * r * gn.x * siluf_(z0), oT.y * r * gn.y * siluf_(z1)); w.y = pk2(oT.z * r * gn.z * siluf_(z2), oT.w * r * gn.w * siluf_(z3));
              *(v2u*)(O + (rowb + blk * 16 + n) * DM + ocol + 16 * et + 4 * g) = w; }
        }
    }
    __syncthreads();
}
constexpr size_t WS_GD_Q = 412 * MiB, WS_GD_W = 428 * MiB, WS_GD_KT = 444 * MiB, WS_GD_UT = 460 * MiB, WS_GD_AQ = 476 * MiB, WS_GD_AB = 480 * MiB;
struct GdnRaw { unsigned short r[3][19]; float pb, pa; };
__device__ __forceinline__ void gdn_stage1_load(Ctx& C, int item, GdnRaw& R) {
    const int lane = C.lane, bh = item >> 7, blk = item & 127, b = bh >> 2, h = bh & 3;
    const bf16* P = (const bf16*)(C.ws + WS_P); const float* PS = (const float*)(C.ws + WS_PS);
    const size_t row0 = (size_t)b * SEQ + blk * 16;
#pragma unroll
    for (int part = 0; part < 3; ++part) { const bf16* rp = P + row0 * NP + 768 + part * 256 + h * 64 + lane;
#pragma unroll
        for (int i = 0; i < 19; ++i) R.r[part][i] = rp[(long)((blk * 16 + i - 3 >= 0) ? i - 3 : 0) * NP]; }
    const float* ps = PS + (row0 + (lane & 15)) * 32; R.pb = ps[4 + h]; R.pa = ps[8 + h];
}
__device__ __forceinline__ void gdn_stage1_finish(Ctx& C, int l, int item, const GdnRaw& R, LAS unsigned char* wl) {
    const int lane = C.lane, bh = item >> 7, blk = item & 127, b = bh >> 2, h = bh & 3, n = lane & 15, g = lane >> 4;
    const size_t row0 = (size_t)b * SEQ + blk * 16;
    bf16* Qg = (bf16*)(C.ws + WS_GD_Q) + row0 * 256 + h * 64; bf16* Wg = (bf16*)(C.ws + WS_GD_W) + row0 * 256 + h * 64;
    bf16* Ktg = (bf16*)(C.ws + WS_GD_KT) + (size_t)item * 1024; bf16* Utg = (bf16*)(C.ws + WS_GD_UT) + (size_t)item * 1024;
    bf16* Aqg = (bf16*)(C.ws + WS_GD_AQ) + (size_t)item * 256; float* Abg = (float*)(C.ws + WS_GD_AB);
    LAS bf16* qh = (LAS bf16*)wl; LAS bf16* kh = qh + 1024; LAS bf16* kT = kh + 1024; LAS bf16* vT = kT + 1024;
    LAS float* Ms = (LAS float*)(wl + 8192); LAS bf16* Xw = (LAS bf16*)(wl + 9216); LAS bf16* Xu = Xw + 256; LAS float* sc = (LAS float*)(wl + 10240);
    {
        const float Acoef = -__expf(C.ka->in[8][l * 4 + h]), dtb = C.ka->in[9][l * 4 + h];
        const float beta = sigmoidf_(R.pb); float gc = Acoef * softplusf_(R.pa + dtb);
#pragma unroll
        for (int o = 1; o < 16; o <<= 1) { const float t = __shfl_up(gc, o); if (n >= o) gc += t; }
        if (lane < 16) { sc[lane] = beta; sc[16 + lane] = gc; }
    }
    LDS_WAIT();
    float gc[16];
#pragma unroll
    for (int t = 0; t < 16; t += 4) { const f32x4 v = *(const LAS f32x4*)(sc + 16 + t); gc[t] = v.x; gc[t + 1] = v.y; gc[t + 2] = v.z; gc[t + 3] = v.w; }
    const float glast = gc[15];
    const float* cw = C.ka->in[7] + l * 4 * 768 + h * 64 + lane;
    float raw[3][19];
#pragma unroll
    for (int part = 0; part < 3; ++part)
#pragma unroll
        for (int i = 0; i < 19; ++i) raw[part][i] = (i >= 3 || blk > 0) ? bf2f(R.r[part][i]) : 0.f;
    float kraw[16];
#pragma unroll
    for (int part = 0; part < 3; ++part) {
        const float w0 = cw[part * 256], w1 = cw[768 + part * 256], w2 = cw[2 * 768 + part * 256], w3 = cw[3 * 768 + part * 256];
        float y[16];
#pragma unroll
        for (int t = 0; t < 16; ++t) y[t] = siluf_(w0 * raw[part][t] + w1 * raw[part][t + 1] + w2 * raw[part][t + 2] + w3 * raw[part][t + 3]);
        if (part == 0) {
#pragma unroll
            for (int t = 0; t < 16; ++t) qh[t * 64 + lane] = (bf16)f2bf(y[t]);
        } else if (part == 1) {
            unsigned w[8];
#pragma unroll
            for (int t = 0; t < 16; ++t) { kh[t * 64 + lane] = (bf16)f2bf(y[t]); kraw[t] = y[t]; }
#pragma unroll
            for (int t = 0; t < 16; t += 2) w[t >> 1] = pk2(y[t], y[t + 1]);
            LAS v4u* o = (LAS v4u*)(kT + lane * 16); o[0] = (v4u){w[0], w[1], w[2], w[3]}; o[1] = (v4u){w[4], w[5], w[6], w[7]};
        } else {
            unsigned w[8];
#pragma unroll
            for (int t = 0; t < 16; t += 2) w[t >> 1] = pk2(y[t], y[t + 1]);
            LAS v4u* o = (LAS v4u*)(vT + lane * 16); o[0] = (v4u){w[0], w[1], w[2], w[3]}; o[1] = (v4u){w[4], w[5], w[6], w[7]};
        }
    }
    LDS_WAIT();
    f32x4 ckk = (f32x4){0.f, 0.f, 0.f, 0.f}, cqk = ckk, cqq = ckk;
#pragma unroll
    for (int i = 0; i < 4; ++i) { const s16x4 kf = *(const LAS s16x4*)(kh + n * 64 + 16 * i + 4 * g), qf = *(const LAS s16x4*)(qh + n * 64 + 16 * i + 4 * g);
        ckk = mfma16(kf, kf, ckk); cqk = mfma16(kf, qf, cqk); cqq = mfma16(qf, qf, cqq); }
    if (g == (n >> 2)) { const int j = n & 3; sc[32 + n] = rsqf_(ckk[j] + RMS_EPS); sc[48 + n] = rsqf_(cqq[j] + RMS_EPS) * 0.125f; }
    LDS_WAIT();
    float rnk[16], rnq[16];
#pragma unroll
    for (int t = 0; t < 16; t += 4) { const f32x4 a = *(const LAS f32x4*)(sc + 32 + t), c2 = *(const LAS f32x4*)(sc + 48 + t);
        rnk[t] = a.x; rnk[t + 1] = a.y; rnk[t + 2] = a.z; rnk[t + 3] = a.w; rnq[t] = c2.x; rnq[t + 1] = c2.y; rnq[t + 2] = c2.z; rnq[t + 3] = c2.w; }
    {
#pragma unroll
        for (int t = 0; t < 16; ++t) Qg[(size_t)t * 256 + lane] = (bf16)f2bf(bf2f(qh[t * 64 + lane]) * rnq[t] * __expf(gc[t]));
        unsigned wk[8];
#pragma unroll
        for (int t = 0; t < 16; t += 2) wk[t >> 1] = pk2(kraw[t] * rnk[t] * __expf(glast - gc[t]), kraw[t + 1] * rnk[t + 1] * __expf(glast - gc[t + 1]));
        v4u* og = (v4u*)(Ktg + lane * 16); og[0] = (v4u){wk[0], wk[1], wk[2], wk[3]}; og[1] = (v4u){wk[4], wk[5], wk[6], wk[7]};
    }
    { const float rkr = sc[32 + n], rqr = sc[48 + n]; const f32x4 rks = *(const LAS f32x4*)(sc + 32 + 4 * g);
#pragma unroll
      for (int j = 0; j < 4; ++j) { ckk[j] *= rks[j] * rkr; cqk[j] *= rks[j] * rqr; } }
    const float Gr = sc[16 + n], beta_r = sc[n];
    const f32x4 Gs = *(const LAS f32x4*)(sc + 16 + 4 * g);
    f32x4 mv, av;
#pragma unroll
    for (int j = 0; j < 4; ++j) { const int s = 4 * g + j; const float dec = __expf(Gr - Gs[j]); mv[j] = s < n ? beta_r * ckk[j] * dec : 0.f; av[j] = s <= n ? cqk[j] * dec : 0.f; }
    *(LAS f32x4*)(Ms + n * 16 + 4 * g) = mv;
    *(s16x4*)(Aqg + n * 16 + 4 * g) = cvt4(av);
    LDS_WAIT();
    float X[16];
    X[0] = (n == 0) ? 1.f : 0.f;
#pragma unroll
    for (int r = 1; r < 16; ++r) {
        float a0 = (n == r) ? 1.f : 0.f, a1 = 0.f;
#pragma unroll
        for (int s4 = 0; s4 < r; s4 += 4) { const f32x4 m4 = *(const LAS f32x4*)(Ms + r * 16 + s4);
            a0 -= m4.x * X[s4]; if (s4 + 1 < r) a1 -= m4.y * X[s4 + 1]; if (s4 + 2 < r) a0 -= m4.z * X[s4 + 2]; if (s4 + 3 < r) a1 -= m4.w * X[s4 + 3]; }
        X[r] = a0 + a1;
    }
    { const float bu = sc[n], bw = bu * __expf(sc[16 + n]) * sc[32 + n];
      if (lane < 16) {
#pragma unroll
          for (int r = 0; r < 16; ++r) { Xw[r * 16 + n] = (bf16)f2bf(X[r] * bw); Xu[r * 16 + n] = (bf16)f2bf(X[r] * bu); } } }
    LDS_WAIT();
    const s16x4 xwf = *(const LAS s16x4*)(Xw + n * 16 + 4 * g), xuf = *(const LAS s16x4*)(Xu + n * 16 + 4 * g);
#pragma unroll
    for (int i = 0; i < 4; ++i) {
        const f32x4 cwt = mfma16(*(const LAS s16x4*)(kT + (16 * i + n) * 16 + 4 * g), xwf, (f32x4){0.f, 0.f, 0.f, 0.f});
        *(s16x4*)(Wg + (size_t)n * 256 + 16 * i + 4 * g) = cvt4(cwt);
        const f32x4 cut = mfma16(xuf, *(const LAS s16x4*)(vT + (16 * i + n) * 16 + 4 * g), (f32x4){0.f, 0.f, 0.f, 0.f});
        *(s16x4*)(Utg + (16 * i + n) * 16 + 4 * g) = cvt4(cut);
    }
    if (lane == 0) Abg[item] = __expf(glast);
    LDS_WAIT();
}

__device__ __forceinline__ void gdn_scan(Ctx& C, int l, int bh0) {
    constexpr int OQ = 0, OW = 2304, OZ = 4608, OKT = 6912, OUT = 8960, OAQ = 11008;
    const int lane = C.lane, n = lane & 15, g = lane >> 4, et = C.wave & 3, bhl = C.wave >> 2, bh = bh0 + bhl, b = bh >> 2, h = bh & 3;
    bf16* O = (bf16*)(C.ws + WS_O);
    const float* Abg = (const float*)(C.ws + WS_GD_AB) + bh * 128;
    const float* gain = C.ka->in[10] + l * 64;
    ScanSeg segs[2][6];
#pragma unroll
    for (int q = 0; q < 2; ++q) {
        const int bq = bh0 + q, hq = bq & 3; const size_t rb = (size_t)(bq >> 2) * SEQ;
        segs[q][0] = ScanSeg{C.ws + WS_GD_Q + (rb * 256 + hq * 64) * 2, 512, 16 * 512, 128, 8, 144, OQ};
        segs[q][1] = ScanSeg{C.ws + WS_GD_W + (rb * 256 + hq * 64) * 2, 512, 16 * 512, 128, 8, 144, OW};
        segs[q][2] = ScanSeg{C.ws + WS_P + (rb * NP + 1536 + hq * 64) * 2, NP * 2, 16 * NP * 2, 128, 8, 144, OZ};
        segs[q][3] = ScanSeg{C.ws + WS_GD_KT + (size_t)bq * 128 * 2048, 0, 2048, 128, 0, 0, OKT};
        segs[q][4] = ScanSeg{C.ws + WS_GD_UT + (size_t)bq * 128 * 2048, 0, 2048, 128, 0, 0, OUT};
        segs[q][5] = ScanSeg{C.ws + WS_GD_AQ + (size_t)bq * 128 * 512, 0, 512, 32, 0, 0, OAQ};
    }
    ScanCopy cp; scan_copy_init(cp, segs, C.tid);
    LAS unsigned char* lds = C.lds; LAS float* xs = (LAS float*)(lds + SCAN_XS);
    f32x4 S[4];
#pragma unroll
    for (int i = 0; i < 4; ++i) S[i] = (f32x4){0.f, 0.f, 0.f, 0.f};
    const f32x4 gn = *(const f32x4*)(gain + 16 * et + 4 * g);
    const size_t rowb = (size_t)b * SEQ;
    v4u R[4][3]; float abr[4];
    scan_copy_load(cp, R[0], 0); scan_copy_store(cp, R[0], lds);
    scan_copy_load(cp, R[1], 1); scan_copy_load(cp, R[2], 2); scan_copy_load(cp, R[3], 3); scan_copy_load(cp, R[0], 4);
#pragma unroll
    for (int u = 0; u < 4; ++u) abr[u] = Abg[u];
    __syncthreads();
#pragma unroll 1
    for (int blk0 = 0; blk0 < 128; blk0 += 4) {
#pragma unroll
        for (int u = 0; u < 4; ++u) {
            const int blk = blk0 + u;
            scan_copy_store(cp, R[(u + 1) & 3], lds + ((blk + 1) & 1) * SCAN_BUF);
            scan_copy_load(cp, R[(u + 1) & 3], blk + 5 < 128 ? blk + 5 : 127);
            const float ab = abr[u]; abr[u] = Abg[blk + 4 < 128 ? blk + 4 : 127];
            const LAS unsigned char* base = lds + (blk & 1) * SCAN_BUF + bhl * SCAN_BH_LDS;
            s16x4 qf[4], wf[4], ktf[4];
#pragma unroll
            for (int i = 0; i < 4; ++i) { qf[i] = *(const LAS s16x4*)(base + OQ + n * 144 + (16 * i + 4 * g) * 2); wf[i] = *(const LAS s16x4*)(base + OW + n * 144 + (16 * i + 4 * g) * 2);
                ktf[i] = *(const LAS s16x4*)(base + OKT + ((16 * i + n) * 16 + 4 * g) * 2); }
            const s16x4 utf = *(const LAS s16x4*)(base + OUT + ((16 * et + n) * 16 + 4 * g) * 2), zf = *(const LAS s16x4*)(base + OZ + n * 144 + (16 * et + 4 * g) * 2);
            const s16x4 aqf = *(const LAS s16x4*)(base + OAQ + (n * 16 + 4 * g) * 2);
            s16x4 Sb[4];
#pragma unroll
            for (int i = 0; i < 4; ++i) Sb[i] = cvt4(S[i]);
            f32x4 acc = (f32x4){0.f, 0.f, 0.f, 0.f};
#pragma unroll
            for (int i = 0; i < 4; ++i) acc = mfma16(wf[i], Sb[i], acc);
            const v2u uw = __builtin_bit_cast(v2u, utf);
            f32x4 vn; vn.x = bf2f(uw.x & 0xffffu) - acc.x; vn.y = bf2f(uw.x >> 16) - acc.y; vn.z = bf2f(uw.y & 0xffffu) - acc.z; vn.w = bf2f(uw.y >> 16) - acc.w;
            const s16x4 vb = cvt4(vn);
            f32x4 oT = mfma16(vb, aqf, (f32x4){0.f, 0.f, 0.f, 0.f});
#pragma unroll
            for (int i = 0; i < 4; ++i) oT = mfma16(Sb[i], qf[i], oT);
#pragma unroll
            for (int i = 0; i < 4; ++i) S[i] = mfma16(ktf[i], vb, S[i] * ab);
            float ss = (oT.x * oT.x + oT.y * oT.y) + (oT.z * oT.z + oT.w * oT.w);
            ss = xsum32(xsum16(ss));
            LAS float* xp = xs + (blk & 1) * 128 + bhl * 64;
            if (g == 0) xp[et * 16 + n] = ss;
            __syncthreads();
            ss = (xp[n] + xp[16 + n]) + (xp[32 + n] + xp[48 + n]);
            const float r = rsqf_(ss * (1.0f / 64.0f) + RMS_EPS);
            { const v2u zw = __builtin_bit_cast(v2u, zf);
              const float z0 = bf2f(zw.x & 0xffffu), z1 = bf2f(zw.x >> 16), z2 = bf2f(zw.y & 0xffffu), z3 = bf2f(zw.y >> 16);
              v2u w; w.x = pk2(oT.x * r * gn.x * siluf_(z0), oT.y * r * gn.y * siluf_(z1)); w.y = pk2(oT.z * r * gn.z * siluf_(z2), oT.w * r * gn.w * siluf_(z3));
              *(v2u*)(O + (rowb + blk * 16 + n) * DM + 256 + h * 64 + 16 * et + 4 * g) = w; }
        }
    }
    __syncthreads();
}
typedef short bf16x8 __attribute__((ext_vector_type(8)));
constexpr size_t WS_FVT = 484 * MiB;
constexpr int FOX_KP = 72, FOX_BUF = 64 * FOX_KP * 2 * 2 + 256;
__device__ __forceinline__ void fox_vt_item(Ctx& C, int item) {
    const int lane = C.lane, bh = item >> 7, blk = item & 127, b = bh >> 2, h = bh & 3;
    const bf16* vp = (const bf16*)(C.ws + WS_P) + ((size_t)b * SEQ + blk * 16) * NP + 512 + h * 64 + lane; unsigned w[8];
#pragma unroll
    for (int t = 0; t < 16; t += 2) w[t >> 1] = (unsigned)vp[(size_t)t * NP] | ((unsigned)vp[(size_t)(t + 1) * NP] << 16);
    v4u* o = (v4u*)((bf16*)(C.ws + WS_FVT) + ((size_t)item * 64 + lane) * 16); o[0] = (v4u){w[0], w[1], w[2], w[3]}; o[1] = (v4u){w[4], w[5], w[6], w[7]};
}
__device__ __forceinline__ void fox_unit(Ctx& C, int l, int bh, int qb) {
    const int tid = C.tid, lane = C.lane, wave = C.wave, n = lane & 15, g = lane >> 4, b = bh >> 2, h = bh & 3;
    const bf16* P = (const bf16*)(C.ws + WS_P); const float* CF = (const float*)(C.ws + WS_CF) + (size_t)bh * SEQ; bf16* O = (bf16*)(C.ws + WS_O);
    const bf16* Vtf = (const bf16*)(C.ws + WS_FVT) + (size_t)bh * 128 * 1024;
    const size_t rowb = (size_t)b * SEQ;
    const int q0 = qb * 256 + wave * 32;
    bf16x8 qf[2][2]; float ct[2];
#pragma unroll
    for (int qs = 0; qs < 2; ++qs) { ct[qs] = CF[q0 + 16 * qs + n];
#pragma unroll
        for (int ks = 0; ks < 2; ++ks) qf[qs][ks] = *(const bf16x8*)(P + (rowb + q0 + 16 * qs + n) * NP + h * 64 + 32 * ks + 8 * g); }
    f32x4 OT[2][4];
#pragma unroll
    for (int qs = 0; qs < 2; ++qs)
#pragma unroll
        for (int dt = 0; dt < 4; ++dt) OT[qs][dt] = (f32x4){0.f, 0.f, 0.f, 0.f};
    float mx[2] = {-INFINITY, -INFINITY}, lsum[2] = {0.f, 0.f};
    const int ntiles = 4 * (qb + 1);
    const int kkey = tid >> 3, kch = tid & 7, vb4 = tid >> 7, vd = (tid >> 1) & 63, vh = tid & 1;
    const bf16* kptr = P + (rowb + kkey) * NP + 256 + h * 64 + 8 * kch;
    const bf16* vptr = Vtf + ((size_t)vb4 * 64 + vd) * 16 + 8 * vh;
    const int kw = kkey * FOX_KP + 8 * kch, vw = 64 * FOX_KP + vd * FOX_KP + 16 * vb4 + 8 * vh;
    LAS unsigned char* lds = C.lds;
    v4u kr[4], vr[4]; float cr[4];
#define FOX_LOAD(set, t) do { const int t_ = (t) < ntiles ? (t) : ntiles - 1; kr[set] = *(const v4u*)(kptr + (size_t)t_ * 64 * NP); vr[set] = *(const v4u*)(vptr + (size_t)t_ * 4 * 1024); cr[set] = CF[t_ * 64 + (tid & 63)]; } while (0)
#define FOX_STORE(set, buf) do { *(LAS v4u*)((LAS bf16*)(buf) + kw) = kr[set]; *(LAS v4u*)((LAS bf16*)(buf) + vw) = vr[set]; if (tid < 64) ((LAS float*)((buf) + 64 * FOX_KP * 4))[tid] = cr[set]; } while (0)
    FOX_LOAD(0, 0); FOX_STORE(0, lds);
    FOX_LOAD(1, 1); FOX_LOAD(2, 2); FOX_LOAD(3, 3); FOX_LOAD(0, 4);
    __syncthreads();
#pragma unroll 1
    for (int kt0 = 0; kt0 < ntiles; kt0 += 4) {
#pragma unroll
      for (int u = 0; u < 4; ++u) {
        const int kt = kt0 + u;
        LAS unsigned char* cur = lds + (kt & 1) * FOX_BUF; LAS unsigned char* nxt = lds + ((kt & 1) ^ 1) * FOX_BUF;
        FOX_STORE((u + 1) & 3, nxt);
        FOX_LOAD((u + 1) & 3, kt + 5);
        if (64 * kt <= q0 + 31) {
            const bool diag = 64 * kt + 63 > q0;
            const LAS bf16* Ks = (const LAS bf16*)cur; const LAS bf16* Vs = Ks + 64 * FOX_KP; const LAS float* Cs = (const LAS float*)(cur + 64 * FOX_KP * 4);
            bf16x8 kf[4][2]; f32x4 c4[4];
#pragma unroll
            for (int mt = 0; mt < 4; ++mt) { c4[mt] = *(const LAS f32x4*)(Cs + 16 * mt + 4 * g);
#pragma unroll
                for (int ks = 0; ks < 2; ++ks) kf[mt][ks] = *(const LAS bf16x8*)(Ks + (16 * mt + n) * FOX_KP + 32 * ks + 8 * g); }
            __builtin_amdgcn_sched_barrier(0);
            f32x4 sv[2][4];
#pragma unroll
            for (int qs = 0; qs < 2; ++qs)
#pragma unroll
                for (int mt = 0; mt < 4; ++mt) {
                    f32x4 a = (f32x4){0.f, 0.f, 0.f, 0.f};
#pragma unroll
                    for (int ks = 0; ks < 2; ++ks) a = __builtin_amdgcn_mfma_f32_16x16x32_bf16(kf[mt][ks], qf[qs][ks], a, 0, 0, 0);
                    sv[qs][mt] = a;
                }
            s16x4 pb[2][4]; float corr[2];
#pragma unroll
            for (int qs = 0; qs < 2; ++qs) {
                float mloc = -INFINITY;
#pragma unroll
                for (int mt = 0; mt < 4; ++mt) { sv[qs][mt] = sv[qs][mt] + (ct[qs] - c4[mt]);
                    if (diag) {
#pragma unroll
                        for (int j = 0; j < 4; ++j) if (64 * kt + 16 * mt + 4 * g + j > q0 + 16 * qs + n) sv[qs][mt][j] = -INFINITY; }
                    mloc = fmaxf(fmaxf(mloc, fmaxf(sv[qs][mt][0], sv[qs][mt][1])), fmaxf(sv[qs][mt][2], sv[qs][mt][3])); }
                mloc = xmax32(xmax16(mloc));
                const float mn = fmaxf(mx[qs], mloc); corr[qs] = __builtin_amdgcn_exp2f(mx[qs] - mn);
                mx[qs] = mn; lsum[qs] *= corr[qs];
#pragma unroll
                for (int mt = 0; mt < 4; ++mt) { f32x4 p;
#pragma unroll
                    for (int j = 0; j < 4; ++j) { p[j] = __builtin_amdgcn_exp2f(sv[qs][mt][j] - mn); lsum[qs] += p[j]; }
                    pb[qs][mt] = cvt4(p); }
            }
#pragma unroll
            for (int dt = 0; dt < 4; ++dt) {
                bf16x8 vf2[2];
#pragma unroll
                for (int a = 0; a < 2; ++a) { const s16x4 lo = *(const LAS s16x4*)(Vs + (16 * dt + n) * FOX_KP + 32 * a + 4 * g), hi = *(const LAS s16x4*)(Vs + (16 * dt + n) * FOX_KP + 32 * a + 16 + 4 * g);
                    vf2[a] = (bf16x8){lo[0], lo[1], lo[2], lo[3], hi[0], hi[1], hi[2], hi[3]}; }
#pragma unroll
                for (int qs = 0; qs < 2; ++qs) { OT[qs][dt] = OT[qs][dt] * corr[qs];
#pragma unroll
                    for (int a = 0; a < 2; ++a) { const s16x4 lo = pb[qs][2 * a], hi = pb[qs][2 * a + 1];
                        OT[qs][dt] = __builtin_amdgcn_mfma_f32_16x16x32_bf16(vf2[a], (bf16x8){lo[0], lo[1], lo[2], lo[3], hi[0], hi[1], hi[2], hi[3]}, OT[qs][dt], 0, 0, 0); } }
            }
        }
        __syncthreads();
      }
    }
#undef FOX_LOAD
#undef FOX_STORE
    const float* on_g = C.ka->in[6] + l * 64;
#pragma unroll
    for (int qs = 0; qs < 2; ++qs) {
        float ls = xsum32(xsum16(lsum[qs]));
        const float inv = rcpf_(ls); float ss = 0.f;
#pragma unroll
        for (int dt = 0; dt < 4; ++dt) { OT[qs][dt] = OT[qs][dt] * inv; ss += (OT[qs][dt].x * OT[qs][dt].x + OT[qs][dt].y * OT[qs][dt].y) + (OT[qs][dt].z * OT[qs][dt].z + OT[qs][dt].w * OT[qs][dt].w); }
        ss = xsum32(xsum16(ss));
        const float r = rsqf_(ss * (1.0f / 64.0f) + RMS_EPS);
#pragma unroll
        for (int dt = 0; dt < 4; ++dt) { const f32x4 gg = *(const f32x4*)(on_g + 16 * dt + 4 * g);
            v2u w; w.x = pk2(OT[qs][dt].x * r * gg.x, OT[qs][dt].y * r * gg.y); w.y = pk2(OT[qs][dt].z * r * gg.z, OT[qs][dt].w * r * gg.w);
            *(v2u*)(O + (rowb + q0 + 16 * qs + n) * DM + h * 64 + 16 * dt + 4 * g) = w; }
    }
}
constexpr int SCAN_BLOCKS = 96;
__device__ __forceinline__ void m1_mixers(Ctx& C, int l) {
    const int bx = (int)blockIdx.x;
    if (bx < SCAN_BLOCKS) {
        if (bx < 32) gdn_scan(C, l, 2 * bx);
        else if (bx < 64) lin_scan<0>(C, l, 2 * (bx - 32));
        else lin_scan<1>(C, l, 2 * (bx - 64));
#ifdef DUP_SCAN
        __syncthreads();
        if (bx < 32) gdn_scan(C, l, 2 * bx);
        else if (bx < 64) lin_scan<0>(C, l, 2 * (bx - 32));
        else lin_scan<1>(C, l, 2 * (bx - 64));
#endif
    }
    {
        unsigned* ctr = (unsigned*)(C.ws + WS_BAR) + 3584 + 64 * l;
        LAS unsigned* slot = (LAS unsigned*)(C.lds + LDS_BYTES - 32);
        for (;;) {
            __syncthreads();
            if (C.tid == 0) *slot = __hip_atomic_fetch_add(ctr, 1u, __ATOMIC_RELAXED, __HIP_MEMORY_SCOPE_AGENT);
            __syncthreads();
            const unsigned u = *slot;
            if (u >= 512u) break;
            fox_unit(C, l, (int)(u & 63u), 7 - (int)(u >> 6));
        }
#ifdef DUP_FOX
        { const int G2 = (int)gridDim.x - SCAN_BLOCKS, j = (int)blockIdx.x - SCAN_BLOCKS;
          if (j >= 0) for (int r = 0; r * G2 < 512; ++r) { const int u = r * G2 + ((r & 1) ? (G2 - 1 - j) : j); if (u < 512) fox_unit(C, l, u & 63, 7 - (u >> 6)); } }
#endif
    }
}

__device__ __forceinline__ void cv_fixup(Ctx& C, int l) {
    const float* H = (const float*)(C.ws + WS_HALO); bf16* ACT = (bf16*)(C.ws + WS_ACT);
    const float* cw = C.ka->in[19] + (size_t)l * 3 * NUP; const float* cb = C.ka->in[20] + (size_t)l * NUP;
    for (int i = blockIdx.x * NTHREADS + C.tid; i < 128 * 22 * 2 * 128; i += gridDim.x * NTHREADS) {
        const int j = i & 127, rr = (i >> 7) & 1, t = i >> 8, pn = t % 22, pm = t / 22;
        if ((pm & 7) == 0) continue;
        const float* h0 = H + (size_t)(pm * 22 + pn) * 1024; const float* hp = H + (size_t)((pm - 1) * 22 + pn) * 1024;
        float uo[2];
#pragma unroll
        for (int bj = 0; bj < 2; ++bj) { const int c = bj * 128 + j, col = bj * DFF + pn * 128 + j;
            const float y0 = h0[rr * 256 + c], y1 = rr == 0 ? hp[3 * 256 + c] : h0[c], y2 = rr == 0 ? hp[2 * 256 + c] : hp[3 * 256 + c];
            uo[bj] = cw[col] * y2 + cw[NUP + col] * y1 + cw[2 * NUP + col] * y0 + cb[col]; }
        ACT[(size_t)(pm * 256 + rr) * DFF + pn * 128 + j] = (bf16)f2bf(siluf_(uo[0]) * uo[1]);
    }
}

struct Args { const float* in[22]; float* out; unsigned char* ws; };
__global__ void __launch_bounds__(NTHREADS, 2) fwd_megakernel(Args args) {
    extern __shared__ __attribute__((aligned(16))) unsigned char lds_raw[];
    cg::grid_group grid = cg::this_grid();
    Ctx C;
    C.ka = (const CAS KArgs*)__builtin_amdgcn_kernarg_segment_ptr();
    C.out = args.out; C.ws = args.ws;
    C.lds = (LAS unsigned char*)lds_raw;
    C.tid = threadIdx.x; C.lane = C.tid & 63; C.wave = __builtin_amdgcn_readfirstlane(C.tid >> 6);
    C.gw = blockIdx.x * NWAVES + C.wave; C.ngw = gridDim.x * NWAVES;
    const int G = gridDim.x;
    volatile LAS unsigned* bst = (volatile LAS unsigned*)(C.lds + LDS_BYTES - 16);
    if (threadIdx.x < 4) bst[threadIdx.x] = 0u;
    __syncthreads();
    const XcdBarrier xbar = xcd_barrier_post((unsigned*)(args.ws + WS_BAR), bst);
#define GRID_SYNC() xcd_barrier(xbar)
    unsigned char* const ws0 = args.ws; float* const out0 = args.out;
#define PHASE_BEGIN() do { size_t z_ = 0; const CAS KArgs* k_ = (const CAS KArgs*)__builtin_amdgcn_kernarg_segment_ptr(); int t_ = threadIdx.x; asm volatile("" : "+s"(z_), "+s"(k_), "+v"(t_)); \
        unsigned char* w_ = ws0 + z_; float* o_ = out0 + z_;     \
        C.ws = w_; C.out = o_; C.ka = k_; C.tid = t_; C.lane = t_ & 63; C.wave = __builtin_amdgcn_readfirstlane(t_ >> 6); C.gw = blockIdx.x * NWAVES + C.wave; ss = (float*)(w_ + WS_SS); XB = (bf16*)(w_ + WS_XB); } while (0)
    float* ss; bf16* XB;

#ifndef NO_P0
    p0_prologue(C);
#ifdef DUP_P0
    grid.sync(); p0_prologue(C);
#endif
#endif
    GRID_SYNC();
    if (gridDim.x > 65536u) grid.sync();
    for (int l = 0; l < DEPTH; ++l) {
        PHASE_BEGIN();
        {
            pg8::Gemm g{XB, (const bf16*)(C.ws + WS_W1T) + (size_t)l * N1 * DM, MTOK, N1, DM}; pg8::StaticOrder S; S.init(MTOK, N1, G, (int)blockIdx.x);
            pg8::EpiP E{(bf16*)(C.ws + WS_P), (float*)(C.ws + WS_PS), ss + (size_t)l * MTOK};
#ifndef NO_G1
            pg8::gemm_phase<pg8::EpiP, pg8::StaticOrder, true, true>(C.lds, g, S, E);
#ifdef DUP_G1
            GRID_SYNC(); pg8::gemm_phase<pg8::EpiP, pg8::StaticOrder, true, true>(C.lds, g, S, E);
#endif
#endif
        }
        GRID_SYNC();
        PHASE_BEGIN();
#ifndef NO_M0
        m0_prep(C, l);
#endif
        for (int it = C.gw; it < 8192; it += C.ngw) { GdnRaw ga; gdn_stage1_load(C, it, ga); gdn_stage1_finish(C, l, it, ga, C.lds + C.wave * 20480); }
        for (int it = C.gw; it < 4096; it += C.ngw) lin_stage1_pair<0>(C, l, it, it + 4096, C.lds + C.wave * 20480);
        for (int it = C.gw; it < 4096; it += C.ngw) lin_stage1_pair<1>(C, l, it, it + 4096, C.lds + C.wave * 20480);
        for (int it = C.gw; it < 8192; it += C.ngw) fox_vt_item(C, it);
#ifdef DUP_GDN1
        { GdnRaw ga, gb; int it = C.gw;
          if (it < 8192) gdn_stage1_load(C, it, ga);
          for (; it < 8192; it += 2 * C.ngw) {
              if (it + C.ngw < 8192) gdn_stage1_load(C, it + C.ngw, gb);
              gdn_stage1_finish(C, l, it, ga, C.lds + C.wave * 20480);
              if (it + C.ngw < 8192) { if (it + 2 * C.ngw < 8192) gdn_stage1_load(C, it + 2 * C.ngw, ga); gdn_stage1_finish(C, l, it + C.ngw, gb, C.lds + C.wave * 20480); }
          } }
#endif
#ifdef DUP_FVT
        for (int r_ = 0; r_ < 4; ++r_) for (int it = C.gw; it < 8192; it += C.ngw) fox_vt_item(C, it);
#endif
        GRID_SYNC();
        PHASE_BEGIN();
#ifndef NO_M1
        m1_mixers(C, l);
#ifdef DUP_M1
        GRID_SYNC(); m1_mixers(C, l);
#endif
#endif
        GRID_SYNC();
        PHASE_BEGIN();
        {
            pg8::Gemm g{(const bf16*)(C.ws + WS_O), (const bf16*)(C.ws + WS_WOT) + (size_t)l * DM * DM, MTOK, DM, DM}; pg8::StaticOrder S; S.init(MTOK, DM, G, (int)blockIdx.x);
            pg8::EpiRes<false> E{XB, nullptr, ss + (size_t)(2 + l) * MTOK};
#ifndef NO_G2
            pg8::gemm_phase<pg8::EpiRes<false>, pg8::StaticOrder, true, true>(C.lds, g, S, E);
#ifdef DUP_G2_OLD
            if (l == 0) { GRID_SYNC(); pg8::EpiRes E2{C.ka->in[0], C.out, XB, (float*)(C.ws + WS_HALO)}; pg8::gemm_phase<pg8::EpiRes, pg8::StaticOrder, true, true>(C.lds, g, S, E2); }
#endif
#endif
        }
        GRID_SYNC();
        PHASE_BEGIN();
        {
            pg8::Gemm g{XB, (const bf16*)(C.ws + WS_WUT) + (size_t)l * NUP * DM, MTOK, NUP, DM}; pg8::StaticOrder S; S.init(MTOK, NUP, G, (int)blockIdx.x);
            pg8::EpiConv E{(bf16*)(C.ws + WS_ACT), (float*)(C.ws + WS_HALO), ss + (size_t)(2 + l) * MTOK, C.ka->in[19] + (size_t)l * 3 * NUP, C.ka->in[20] + (size_t)l * NUP, (LAS float*)(C.lds + 131072)};
#ifndef NO_G3
            pg8::gemm_phase<pg8::EpiConv, pg8::StaticOrder, true, true>(C.lds, g, S, E);
#ifdef DUP_G3
            GRID_SYNC(); pg8::gemm_phase<pg8::EpiConv, pg8::StaticOrder, true, true>(C.lds, g, S, E);
#endif
#endif
        }
        GRID_SYNC();
        PHASE_BEGIN();
        cv_fixup(C, l);
#ifdef DUP_FIX
        GRID_SYNC(); cv_fixup(C, l);
#endif
#ifdef DUP_SYNC
        for (int q = 0; q < 10; ++q) GRID_SYNC();
#endif
        GRID_SYNC();
        PHASE_BEGIN();
        {
            pg8::Gemm g{(const bf16*)(C.ws + WS_ACT), (const bf16*)(C.ws + WS_WDT) + (size_t)l * DM * DFF, MTOK, DM, DFF}; pg8::StaticOrder S; S.init(MTOK, DM, G, (int)blockIdx.x);
            if (l + 1 < DEPTH) { pg8::EpiRes<false> E{XB, nullptr, ss + (size_t)(l + 1) * MTOK};
                pg8::gemm_phase<pg8::EpiRes<false>, pg8::StaticOrder, true, true>(C.lds, g, S, E);
            } else { pg8::EpiRes<true> E{XB, C.out, nullptr};
                pg8::gemm_phase<pg8::EpiRes<true>, pg8::StaticOrder, true, true>(C.lds, g, S, E); }
        }
        GRID_SYNC();
    }
}

extern "C" void kernel_launch(void* const* d_in, const int* in_sizes, int n_in, void* d_out, int out_size, void* d_ws, size_t ws_size, hipStream_t stream) {
    static int grid = 0;
    if (grid == 0) {
        if (n_in != 22 || in_sizes[0] != MTOK * DM || out_size != MTOK * DM || ws_size < WS_END) {
            fprintf(stderr, "kernel_launch: unexpected problem (n_in %d, in0 %d, out %d, ws %zu < %zu)\n", n_in, n_in > 0 ? in_sizes[0] : -1, out_size, ws_size, (size_t)WS_END); grid = -1; return; }
        int dev = 0, cus = 0, per_cu = 0;
        (void)hipGetDevice(&dev); (void)hipDeviceGetAttribute(&cus, hipDeviceAttributeMultiprocessorCount, dev);
        if (hipFuncSetAttribute((const void*)fwd_megakernel, hipFuncAttributeMaxDynamicSharedMemorySize, LDS_BYTES) != hipSuccess) { fprintf(stderr, "kernel_launch: hipFuncSetAttribute failed\n"); grid = -1; return; }
        if (hipOccupancyMaxActiveBlocksPerMultiprocessor(&per_cu, (const void*)fwd_megakernel, NTHREADS, LDS_BYTES) != hipSuccess || per_cu < 1) { fprintf(stderr, "kernel_launch: occupancy query says %d blocks per CU\n", per_cu); per_cu = 1; }
        (void)hipGetLastError();
        grid = cus;
    }
    if (grid < 0) return;
    if (hipMemsetAsync((char*)d_ws + WS_BAR, 0, 16384, stream) != hipSuccess) { fprintf(stderr, "kernel_launch: memset of the barrier words failed\n"); return; }
    Args a{};
    for (int i = 0; i < 22; ++i) a.in[i] = (const float*)d_in[i];
    a.out = (float*)d_out; a.ws = (unsigned char*)d_ws;
    void* kargs[] = {&a};
    hipError_t e = hipLaunchCooperativeKernel((const void*)fwd_megakernel, dim3(grid), dim3(NTHREADS), kargs, LDS_BYTES, stream);
    if (e != hipSuccess) fprintf(stderr, "kernel_launch: cooperative launch failed: %s (grid %d)\n", hipGetErrorString(e), grid);
}
```

```cpp
#include <hip/hip_runtime.h>
#include <hip/hip_cooperative_groups.h>
#include <cstdio>
#include <cstdint>
namespace cg = cooperative_groups;
constexpr float RMS_EPS = 1e-6f;

namespace pg8 {
#define PG8_LAS __attribute__((address_space(3)))
typedef unsigned short bf16_t;
typedef short bf16x8 __attribute__((ext_vector_type(8)));
typedef float f32x4 __attribute__((ext_vector_type(4)));
typedef unsigned u32x4 __attribute__((ext_vector_type(4)));
constexpr int BM = 256, BK = 64, HALF = 128, HTB = HALF * BK * 2  , STAGE_BYTES = 8 * HTB, NXCD = 8, WGM = 8;

__host__ __device__ __forceinline__ int lds_byte(int r, int c) { const int st = (r >> 4) * 2 + (c >> 5), rr = r & 15, cc = c & 31, ob = rr * 64 + cc * 2; return st * 1024 + (ob ^ (((ob >> 9) & 1) << 5)); }
__host__ __device__ __forceinline__ void stage_rc(int b, int& R, int& C) { const int st = b / 1024, sb = b % 1024, swz = sb ^ (((sb >> 9) & 1) << 5); R = (st >> 1) * 16 + swz / 64; C = (st & 1) * 32 + (swz % 64) / 2; }
__host__ __device__ __forceinline__ int perm32(int rho) { const int n = rho >> 4, i = rho & 15; return 8 * (i >> 2) + 4 * n + (i & 3); }

struct Unit { int pm, pn; };
struct Gemm { const bf16_t* A; const bf16_t* Bt; int M, N, K; };

struct StaticOrder {
    int nM, nN, nwg, G, c;
    __host__ __device__ void init(int M, int N, int G_, int c_) { nM = M / BM; nN = N / BM; nwg = nM * nN; G = G_; c = c_; }
    __host__ __device__ bool next(int i, Unit& u) const {
        const long L = (long)i * G + c; if (L >= nwg) return false;
        int wgid = (int)L; { const int q = nwg / NXCD, r = nwg % NXCD, xcd = wgid % NXCD, off = wgid / NXCD; wgid = (xcd < r ? xcd * (q + 1) : r * (q + 1) + (xcd - r) * q) + off; }
        const int nig = WGM * nN, gid = wgid / nig, fm = gid * WGM, gsz = (nM - fm) < WGM ? (nM - fm) : WGM;
        u.pm = fm + ((wgid % nig) % gsz); u.pn = (wgid % nig) / gsz; return true;
    }
    __device__ __forceinline__ void a_ready(const Unit&) const {}
    __device__ __forceinline__ void done(const Unit&) const {}
};
__device__ __forceinline__ unsigned cvt_pk_bf16(float lo, float hi) { unsigned r; asm volatile("v_cvt_pk_bf16_f32 %0, %1, %2" : "=v"(r) : "v"(lo), "v"(hi)); return r; }
typedef float f32x2 __attribute__((ext_vector_type(2)));

typedef unsigned u32x2 __attribute__((ext_vector_type(2)));
struct EpiP {
    static constexpr bool PERM = true, AFTER_DRAIN = false, PROBE_DUP = true;
    bf16_t* P; float* PS; const float* ss; float* FF; const float* qg; const float* kg; bf16_t* FVT;
    __device__ __forceinline__ void operator()(const f32x4 (&acc)[2][2][4][2], const Unit& u, int wr, int wc, int fr, int fq) const {
        const int row0 = u.pm * BM + wr * 64 + fr;
        float rs[2][4];
#pragma unroll
        for (int ai = 0; ai < 2; ++ai)
#pragma unroll
            for (int m = 0; m < 4; ++m) rs[ai][m] = ss[row0 + ai * HALF + m * 16];
#pragma unroll
        for (int ai = 0; ai < 2; ++ai)
#pragma unroll
            for (int m = 0; m < 4; ++m) {
                const int row = row0 + ai * HALF + m * 16;
                const float rstd = __builtin_amdgcn_rsqf(rs[ai][m] * (1.0f / 1024.0f) + RMS_EPS);
                if (u.pn < 2) {
                    const float* gp = u.pn == 0 ? qg : kg;
                    f32x4 p[2][2]; float sq = 0.f;
#pragma unroll
                    for (int bj = 0; bj < 2; ++bj)
#pragma unroll
                        for (int n = 0; n < 2; ++n) { p[bj][n] = acc[ai][bj][m][n] * rstd; sq += (p[bj][n][0] * p[bj][n][0] + p[bj][n][1] * p[bj][n][1]) + (p[bj][n][2] * p[bj][n][2] + p[bj][n][3] * p[bj][n][3]); }
                    sq += __shfl_xor(sq, 16); sq += __shfl_xor(sq, 32);
                                        const float r = __builtin_amdgcn_rsqf(sq * (1.0f / 64.0f) + RMS_EPS) * (u.pn == 0 ? 0.18033688011112042f : 1.0f);
                    bf16_t* rowp = P + (size_t)row * 3584 + u.pn * BM + wc * 64 + 8 * fq;
#pragma unroll
                    for (int bj = 0; bj < 2; ++bj) { const f32x4 g0 = *(const f32x4*)(gp + 32 * bj + 8 * fq), g1 = *(const f32x4*)(gp + 32 * bj + 8 * fq + 4);
                                                const f32x4 v0 = p[bj][0] * g0 * r, v1 = p[bj][1] * g1 * r;
                        u32x4 w; w.x = cvt_pk_bf16(v0[0], v0[1]); w.y = cvt_pk_bf16(v0[2], v0[3]); w.z = cvt_pk_bf16(v1[0], v1[1]); w.w = cvt_pk_bf16(v1[2], v1[3]);
                        *(u32x4*)(rowp + 32 * bj) = w; }
                } else if (u.pn == 2) {
                    bf16_t* vp = FVT + (((size_t)(row >> 11) * 4 * 128 + ((row & 2047) >> 4)) * 64) * 16 + fr;
#pragma unroll
                    for (int bj = 0; bj < 2; ++bj)
#pragma unroll
                        for (int n = 0; n < 2; ++n) { const f32x4 v = acc[ai][bj][m][n] * rstd;
#pragma unroll
                            for (int k = 0; k < 4; ++k) { const int c = 128 * bj + 32 * wc + 8 * fq + 4 * n + k;
                                vp[((size_t)(c >> 6) * 128 * 64 + (c & 63)) * 16] = (bf16_t)(cvt_pk_bf16(v[k], 0.f) & 0xffffu); } }
                } else if (u.pn < 14) {
                    bf16_t* rowp = P + (size_t)row * 3584 + u.pn * BM + wc * 32 + 8 * fq;
#pragma unroll
                    for (int bj = 0; bj < 2; ++bj) { const f32x4 v0 = acc[ai][bj][m][0] * rstd, v1 = acc[ai][bj][m][1] * rstd;
                        u32x4 w; w.x = cvt_pk_bf16(v0[0], v0[1]); w.y = cvt_pk_bf16(v0[2], v0[3]); w.z = cvt_pk_bf16(v1[0], v1[1]); w.w = cvt_pk_bf16(v1[2], v1[3]);
                        __builtin_nontemporal_store(w, (u32x4*)(rowp + bj * HALF)); }
                } else if (wc == 0) {
                    float* rowp = PS + (size_t)row * 32 + 8 * fq;
                    const f32x4 v0 = acc[ai][0][m][0] * rstd;
                    *(f32x4*)(rowp) = v0; *(f32x4*)(rowp + 4) = acc[ai][0][m][1] * rstd;
                    if (fq == 0) { float* fp = FF + (size_t)(row >> 11) * 4 * 2048 + (row & 2047);
                        fp[0] = v0[0]; fp[2048] = v0[1]; fp[2 * 2048] = v0[2]; fp[3 * 2048] = v0[3]; }
                }
            }
    }
};
template <bool LAST> struct EpiRes {
    static constexpr bool PERM = false, AFTER_DRAIN = false, PROBE_DUP = false;
    bf16_t* xb; float* out; float* ssq; bf16_t* xbw = nullptr;
    __device__ __forceinline__ void operator()(const f32x4 (&acc)[2][2][4][2], const Unit& u, int wr, int wc, int fr, int fq) const {
        const int row0 = u.pm * BM + wr * 64 + fr, col0 = u.pn * BM + wc * 32 + 4 * fq;
        u32x2 bv[2][2][2][2];
#define EPR_LOADQ(q_) do { _Pragma("unroll") for (int mm = 0; mm < 2; ++mm) _Pragma("unroll") for (int bj = 0; bj < 2; ++bj) _Pragma("unroll") for (int n = 0; n < 2; ++n) \
            bv[(q_) & 1][mm][bj][n] = *(const u32x2*)(xb + (size_t)(row0 + ((q_) >> 1) * HALF + (2 * ((q_) & 1) + mm) * 16) * 1024 + col0 + bj * HALF + n * 16); } while (0)
        EPR_LOADQ(0); EPR_LOADQ(1);
#pragma unroll
        for (int q = 0; q < 4; ++q) {
            const int ai = q >> 1;
#pragma unroll
            for (int mm = 0; mm < 2; ++mm) {
                const int m = 2 * (q & 1) + mm;
                const int row = row0 + ai * HALF + m * 16; float s = 0.f;
#pragma unroll
                for (int bj = 0; bj < 2; ++bj)
#pragma unroll
                    for (int n = 0; n < 2; ++n) { const size_t off = (size_t)row * 1024 + col0 + bj * HALF + n * 16; const u32x2 b = bv[q & 1][mm][bj][n];
                        f32x4 o = acc[ai][bj][m][n];
                        o[0] += __uint_as_float(b.x << 16); o[1] += __uint_as_float(b.x & 0xffff0000u); o[2] += __uint_as_float(b.y << 16); o[3] += __uint_as_float(b.y & 0xffff0000u);
                        if (LAST) *(f32x4*)(out + off) = o;
                        else { s += (o[0] * o[0] + o[1] * o[1]) + (o[2] * o[2] + o[3] * o[3]);
                            u32x2 w; w.x = cvt_pk_bf16(o[0], o[1]); w.y = cvt_pk_bf16(o[2], o[3]); *(u32x2*)((xbw ? xbw : xb) + off) = w; } }
                if (!LAST) { s += __shfl_xor(s, 16); s += __shfl_xor(s, 32);
                    if (fq == 0) atomicAdd(ssq + row, s); }
            }
            if (q == 0) EPR_LOADQ(2);
            if (q == 1) EPR_LOADQ(3);
        }
#undef EPR_LOADQ
    }
};
struct EpiConv {
    static constexpr bool PERM = true, AFTER_DRAIN = false, PROBE_DUP = false;
    bf16_t* ACT; float* HALO; const float* ss; const float* cw; const float* cb; PG8_LAS float* xl;
    template <int CTRL> static __device__ __forceinline__ float dpp(float old, float src) {
        return __builtin_bit_cast(float, __builtin_amdgcn_update_dpp(__builtin_bit_cast(int, old), __builtin_bit_cast(int, src), CTRL, 0xf, 0xf, false)); }
    __device__ __forceinline__ void operator()(const f32x4 (&acc)[2][2][4][2], const Unit& u, int wr, int wc, int fr, int fq) const {
        const int row0 = u.pm * BM + wr * 64 + fr;
        float rs[2][4];
#pragma unroll
        for (int ai = 0; ai < 2; ++ai)
#pragma unroll
            for (int m = 0; m < 4; ++m) rs[ai][m] = __builtin_amdgcn_rsqf(ss[row0 + ai * HALF + m * 16] * (1.0f / 1024.0f) + RMS_EPS);
        const int colg = u.pn * HALF + wc * 32 + 8 * fq;
        f32x4 wn[1][2][3], bn[1][2];
#define EPC_LOADW(n_) do { _Pragma("unroll") for (int bj = 0; bj < 2; ++bj) { const int c = bj * 2816 + colg + 4 * (n_); bn[0][bj] = *(const f32x4*)(cb + c); \
            _Pragma("unroll") for (int j = 0; j < 3; ++j) wn[0][bj][j] = *(const f32x4*)(cw + j * 5632 + c); } } while (0)
        EPC_LOADW(0);
        if (fr >= 14) {
#pragma unroll
            for (int ai = 0; ai < 2; ++ai) { PG8_LAS float* xp = xl + ((((ai * 2 + wr) * 4 + wc) * 2 + (fr - 14)) * 64) + 8 * fq;
#pragma unroll
                for (int bj = 0; bj < 2; ++bj)
#pragma unroll
                    for (int n = 0; n < 2; ++n) *(PG8_LAS f32x4*)(xp + bj * 32 + 4 * n) = acc[ai][bj][3][n] * rs[ai][3]; }
            if (wr == 1) { float* hp = HALO + ((size_t)(u.pm * 22 + u.pn) * 4 + 2 + (fr - 14)) * 256 + wc * 32 + 8 * fq;
#pragma unroll
                for (int bj = 0; bj < 2; ++bj)
#pragma unroll
                    for (int n = 0; n < 2; ++n) *(f32x4*)(hp + bj * HALF + 4 * n) = acc[1][bj][3][n] * rs[1][3]; }
        }
        if (fr < 2 && wr == 0) { float* hp = HALO + ((size_t)(u.pm * 22 + u.pn) * 4 + fr) * 256 + wc * 32 + 8 * fq;
#pragma unroll
            for (int bj = 0; bj < 2; ++bj)
#pragma unroll
                for (int n = 0; n < 2; ++n) *(f32x4*)(hp + bj * HALF + 4 * n) = acc[0][bj][0][n] * rs[0][0]; }
        asm volatile("s_waitcnt lgkmcnt(0)" ::: "memory"); __builtin_amdgcn_s_barrier(); asm volatile("" ::: "memory");
        const bool seq_start = (u.pm & 7) == 0;
#ifdef DUP_EPC
        for (int rep_ = 0; rep_ < 2; ++rep_) { asm volatile("" ::: "memory"); EPC_LOADW(0);
#endif
#pragma unroll
        for (int n = 0; n < 2; ++n) {
            if (n == 1) EPC_LOADW(1);
            f32x4 (&w)[2][3] = wn[0]; f32x4 (&bb)[2] = bn[0];
#pragma unroll
            for (int ai = 0; ai < 2; ++ai) {
                f32x4 prev[2];
                f32x4 h1[2], h2[2];
                const int pg = ai * 2 + wr - 1;
#pragma unroll
                for (int bj = 0; bj < 2; ++bj) {
                    if (pg >= 0) { const PG8_LAS float* xp = xl + (((pg * 4 + wc) * 2) * 64) + 8 * fq + bj * 32 + 4 * n;
                        const f32x4 r14 = *(const PG8_LAS f32x4*)xp, r15 = *(const PG8_LAS f32x4*)(xp + 64); h1[bj] = r15; h2[bj] = fr == 0 ? r14 : r15; }
                    else { h1[bj] = (f32x4){0.f, 0.f, 0.f, 0.f}; h2[bj] = h1[bj]; }
                }
#pragma unroll
                for (int m = 0; m < 4; ++m) {
                    f32x4 cur[2], uo[2];
#pragma unroll
                    for (int bj = 0; bj < 2; ++bj) { cur[bj] = acc[ai][bj][m][n] * rs[ai][m];
#pragma unroll
                        for (int k = 0; k < 4; ++k) {
                            const float r1 = m == 0 ? h1[bj][k] : dpp<0x121>(0.f, prev[bj][k]), r2 = m == 0 ? h2[bj][k] : dpp<0x122>(0.f, prev[bj][k]);
                            const float t1 = dpp<0x111>(r1, cur[bj][k]), t2 = dpp<0x112>(r2, cur[bj][k]);
                            uo[bj][k] = w[bj][0][k] * t2 + w[bj][1][k] * t1 + w[bj][2][k] * cur[bj][k] + bb[bj][k]; }
                        prev[bj] = cur[bj]; }
                    f32x4 a;
#pragma unroll
                    for (int k = 0; k < 4; ++k) a[k] = uo[0][k] * __builtin_amdgcn_rcpf(1.0f + __expf(-uo[0][k])) * uo[1][k];
                    u32x2 o; o.x = cvt_pk_bf16(a[0], a[1]); o.y = cvt_pk_bf16(a[2], a[3]);
                    *(u32x2*)(ACT + (size_t)(row0 + ai * HALF + m * 16) * 2816 + colg + 4 * n) = o;
                }
            }
        }
#ifdef DUP_EPC
        }
#endif
        (void)seq_start;
#undef EPC_LOADW
    }
};
template <class Epi, class Sched, bool ALIGN_EPI = false, bool SP2 = false>
__device__ __forceinline__ void gemm_phase(PG8_LAS unsigned char* lds, const Gemm g, const Sched& S, const Epi& E) {
    int tid_ = threadIdx.x; asm volatile("" : "+v"(tid_));
    const int tid = tid_, wid = __builtin_amdgcn_readfirstlane(tid >> 6), lane = tid & 63, wr = wid >> 2, wc = wid & 3, fr = lane & 15, fq = lane >> 4;
    const int K = g.K, nt = K / BK;
    unsigned voffA[2], voffB[2];
#pragma unroll
    for (int i = 0; i < 2; ++i) { int R, C; stage_rc(tid * 16 + i * 8192, R, C); const int Rb = Epi::PERM ? ((R & ~31) + perm32(R & 31)) : R;
        voffA[i] = (unsigned)(R * K + C) * 2u; voffB[i] = (unsigned)(Rb * K + C) * 2u; }
    const size_t kstep = (size_t)(BK * 2);
    const size_t hstep = (size_t)HALF * K * 2;
    const size_t tstep = 2 * hstep;
    const unsigned ldsw = (unsigned)wid * 1024u;
    const int aoff = lds_byte(wr * 64 + fr, fq * 8), boff = lds_byte(wc * 32 + fr, fq * 8);
#define PG8_SA(b, h) (((b) * 2 + (h)) * HTB)
#define PG8_SB(b, h) ((4 + (b) * 2 + (h)) * HTB)
#define PG8_STAGE(bufoff, gbase, voff) do { _Pragma("unroll") for (int _i = 0; _i < 2; ++_i) \
        __builtin_amdgcn_global_load_lds((const unsigned*)((const char*)(gbase) + (voff)[_i]), (PG8_LAS unsigned*)(lds + (bufoff) + ldsw + _i * 8192), 16, 0, 0); } while (0)
#define PG8_LDA(dst, b, h) do { _Pragma("unroll") for (int m = 0; m < 4; ++m) _Pragma("unroll") for (int k = 0; k < 2; ++k) dst[m][k] = *(const PG8_LAS bf16x8*)(lds + PG8_SA(b, h) + aoff + m * 2048 + k * 1024); } while (0)
#define PG8_LDB(dst, b, h) do { _Pragma("unroll") for (int n = 0; n < 2; ++n) _Pragma("unroll") for (int k = 0; k < 2; ++k) dst[n][k] = *(const PG8_LAS bf16x8*)(lds + PG8_SB(b, h) + boff + n * 2048 + k * 1024); } while (0)
#define PG8_MMA(ai, bj, At, Bt) do { __builtin_amdgcn_s_setprio(1); _Pragma("unroll") for (int m = 0; m < 4; ++m) _Pragma("unroll") for (int n = 0; n < 2; ++n) _Pragma("unroll") for (int k = 0; k < 2; ++k) \
        acc[ai][bj][m][n] = __builtin_amdgcn_mfma_f32_16x16x32_bf16(Bt[n][k], At[m][k], acc[ai][bj][m][n], 0, 0, 0); __builtin_amdgcn_s_setprio(0); } while (0)
#define PG8_WAIT_V(n) asm volatile("s_waitcnt vmcnt(" #n ")" ::: "memory")
#define PG8_WAIT_L(n) asm volatile("s_waitcnt lgkmcnt(" #n ")" ::: "memory")
#define PG8_BAR __builtin_amdgcn_s_barrier()
#define PG8_SCHED __builtin_amdgcn_sched_barrier(0)
    Unit cur, nxt; int ui = 0;
    if (!S.next(0, cur)) return;
    f32x4 acc[2][2][4][2];
#pragma unroll
    for (int a = 0; a < 2; ++a)
#pragma unroll
        for (int b = 0; b < 2; ++b)
#pragma unroll
            for (int m = 0; m < 4; ++m)
#pragma unroll
                for (int n = 0; n < 2; ++n) acc[a][b][m][n] = (f32x4){0.f, 0.f, 0.f, 0.f};
    bf16x8 At[4][2], B0[2][2], B1[2][2];
    const char* cA = (const char*)g.A + (size_t)cur.pm * tstep; const char* cB = (const char*)g.Bt + (size_t)cur.pn * tstep;
    S.a_ready(cur);
    if constexpr (SP2) {
        PG8_STAGE(PG8_SB(0, 0), cB, voffB); PG8_STAGE(PG8_SB(0, 1), cB + hstep, voffB); PG8_STAGE(PG8_SA(0, 0), cA, voffA); PG8_STAGE(PG8_SA(0, 1), cA + hstep, voffA);
        if (wr == 1) PG8_BAR;
        PG8_WAIT_V(2); PG8_BAR;
        PG8_STAGE(PG8_SB(1, 0), cB + kstep, voffB); PG8_STAGE(PG8_SA(1, 0), cA + kstep, voffA); PG8_STAGE(PG8_SB(1, 1), cB + hstep + kstep, voffB);
        PG8_WAIT_V(6); PG8_BAR;
    } else {
        PG8_STAGE(PG8_SB(0, 0), cB, voffB); PG8_STAGE(PG8_SA(0, 0), cA, voffA); PG8_STAGE(PG8_SB(0, 1), cB + hstep, voffB); PG8_STAGE(PG8_SA(0, 1), cA + hstep, voffA);
        if (wr == 1) PG8_BAR;
        PG8_WAIT_V(4); PG8_BAR;
        PG8_STAGE(PG8_SB(1, 0), cB + kstep, voffB); PG8_STAGE(PG8_SA(1, 0), cA + kstep, voffA); PG8_STAGE(PG8_SB(1, 1), cB + hstep + kstep, voffB);
        PG8_WAIT_V(6); PG8_BAR;
    }
    for (;;) {
        const bool has_next = S.next(ui + 1, nxt);
        const char* nA = has_next ? (const char*)g.A + (size_t)nxt.pm * tstep : cA; const char* nB = has_next ? (const char*)g.Bt + (size_t)nxt.pn * tstep : cB;
        for (int t = 0; t < nt; t += 2) {
            const bool last = (t == nt - 2);
            const char* a1 = cA + (size_t)(t + 1) * kstep;
            const char* a2 = last ? nA : cA + (size_t)(t + 2) * kstep; const char* b2 = last ? nB : cB + (size_t)(t + 2) * kstep;
            const char* a3 = a2 + kstep; const char* b3 = b2 + kstep;
            if (last && has_next) S.a_ready(nxt);
            if constexpr (SP2) {
            PG8_LDB(B0, 0, 0); PG8_LDB(B1, 0, 1); PG8_SCHED; PG8_LDA(At, 0, 0); PG8_STAGE(PG8_SA(1, 1), a1 + hstep, voffA);
            PG8_WAIT_V(8); PG8_WAIT_L(0); PG8_BAR; PG8_MMA(0, 0, At, B0); PG8_MMA(0, 1, At, B1); PG8_BAR; PG8_SCHED;
            PG8_LDA(At, 0, 1); PG8_STAGE(PG8_SB(0, 0), b2, voffB); PG8_STAGE(PG8_SB(0, 1), b2 + hstep, voffB); PG8_STAGE(PG8_SA(0, 0), a2, voffA);
            PG8_WAIT_V(8); PG8_WAIT_L(0); PG8_BAR; PG8_MMA(1, 0, At, B0); PG8_MMA(1, 1, At, B1); PG8_BAR; PG8_SCHED;
            PG8_LDB(B0, 1, 0); PG8_LDB(B1, 1, 1); PG8_SCHED; PG8_LDA(At, 1, 0); PG8_STAGE(PG8_SA(0, 1), a2 + hstep, voffA);
            PG8_WAIT_V(8); PG8_WAIT_L(0); PG8_BAR; PG8_MMA(0, 0, At, B0); PG8_MMA(0, 1, At, B1); PG8_BAR; PG8_SCHED;
            PG8_LDA(At, 1, 1); PG8_STAGE(PG8_SB(1, 0), b3, voffB); PG8_STAGE(PG8_SB(1, 1), b3 + hstep, voffB); PG8_STAGE(PG8_SA(1, 0), a3, voffA);
            PG8_WAIT_V(8); PG8_WAIT_L(0); PG8_BAR; PG8_MMA(1, 0, At, B0); PG8_MMA(1, 1, At, B1); PG8_BAR; PG8_SCHED;
            } else {
            PG8_LDB(B0, 0, 0); PG8_SCHED; PG8_LDA(At, 0, 0); PG8_STAGE(PG8_SA(1, 1), a1 + hstep, voffA);
            PG8_WAIT_L(8); PG8_BAR; PG8_WAIT_L(0); PG8_MMA(0, 0, At, B0); PG8_BAR; PG8_SCHED;
            PG8_LDB(B1, 0, 1); PG8_STAGE(PG8_SB(0, 0), b2, voffB);
            PG8_BAR; PG8_WAIT_L(0); PG8_MMA(0, 1, At, B1); PG8_BAR;
            PG8_LDA(At, 0, 1); PG8_STAGE(PG8_SA(0, 0), a2, voffA);
            PG8_BAR; PG8_WAIT_L(0); PG8_MMA(1, 0, At, B0); PG8_BAR; PG8_SCHED;
            PG8_STAGE(PG8_SB(0, 1), b2 + hstep, voffB);
            PG8_WAIT_V(6); PG8_BAR; PG8_MMA(1, 1, At, B1); PG8_BAR;
            PG8_LDB(B0, 1, 0); PG8_SCHED; PG8_LDA(At, 1, 0); PG8_STAGE(PG8_SA(0, 1), a2 + hstep, voffA);
            PG8_WAIT_L(8); PG8_BAR; PG8_WAIT_L(0); PG8_MMA(0, 0, At, B0); PG8_BAR; PG8_SCHED;
            PG8_LDB(B1, 1, 1); PG8_STAGE(PG8_SB(1, 0), b3, voffB);
            PG8_BAR; PG8_WAIT_L(0); PG8_MMA(0, 1, At, B1); PG8_BAR;
            PG8_LDA(At, 1, 1); PG8_STAGE(PG8_SA(1, 0), a3, voffA);
            PG8_BAR; PG8_WAIT_L(0); PG8_MMA(1, 0, At, B0); PG8_BAR; PG8_SCHED;
            PG8_STAGE(PG8_SB(1, 1), b3 + hstep, voffB);
            PG8_WAIT_V(6); PG8_BAR; PG8_MMA(1, 1, At, B1); PG8_BAR;
            }
        }
        if constexpr (ALIGN_EPI) { if (wr == 0) PG8_BAR; }
        if constexpr (!Epi::AFTER_DRAIN) { E(acc, cur, wr, wc, fr, fq);
#ifdef DUP_EPI
            if constexpr (Epi::PROBE_DUP) { asm volatile("" ::: "memory"); E(acc, cur, wr, wc, fr, fq); }
#endif
            S.done(cur); }
        if (!has_next) break;
#pragma unroll
        for (int a = 0; a < 2; ++a)
#pragma unroll
            for (int b = 0; b < 2; ++b)
#pragma unroll
                for (int m = 0; m < 4; ++m)
#pragma unroll
                    for (int n = 0; n < 2; ++n) acc[a][b][m][n] = (f32x4){0.f, 0.f, 0.f, 0.f};
        cur = nxt; cA = nA; cB = nB; ++ui;
        if constexpr (ALIGN_EPI) { if (wr == 1) PG8_BAR; }
    }
    PG8_WAIT_V(0);
    if constexpr (!ALIGN_EPI) { if (wr == 0) PG8_BAR; }
    PG8_BAR;
    if constexpr (Epi::AFTER_DRAIN) { E.fused(acc, cur, wr, wc, fr, fq, lds, wid, lane); S.done(cur); }
#undef PG8_SA
#undef PG8_SB
#undef PG8_STAGE
#undef PG8_LDA
#undef PG8_LDB
#undef PG8_MMA
#undef PG8_WAIT_V
#undef PG8_WAIT_L
#undef PG8_BAR
#undef PG8_SCHED
}
}
constexpr int BATCH = 16, SEQ = 2048, DM = 1024, MTOK = BATCH * SEQ, DEPTH = 2;
constexpr int IN_COLS = 3612, NP = 3584, N1 = 3840, DFF = 2816, NUP = 5632;
constexpr int NWAVES = 8, NTHREADS = 512;
constexpr int LDS_BYTES = 163840;
#define GAS __attribute__((address_space(1)))
#define LAS __attribute__((address_space(3)))
typedef unsigned short bf16;
typedef float f32x4 __attribute__((ext_vector_type(4)));
typedef unsigned v4u __attribute__((ext_vector_type(4)));
typedef unsigned v2u __attribute__((ext_vector_type(2)));
#define LDS_WAIT() asm volatile("s_waitcnt lgkmcnt(0)" ::: "memory")

constexpr size_t MiB = 1u << 20;
constexpr size_t WS_SS = 0;
constexpr size_t WS_BAR = 1536 * 1024;
constexpr size_t WS_CF = 1 * MiB;
constexpr size_t WS_W1T = 2 * MiB;
constexpr size_t WS_WOT = 17 * MiB;
constexpr size_t WS_WUT = 21 * MiB;
constexpr size_t WS_WDT = 43 * MiB;
constexpr size_t WS_FF = 54 * MiB;
constexpr size_t WS_XB = 56 * MiB;
constexpr size_t WS_P = 120 * MiB;
constexpr size_t WS_PS = 344 * MiB;
constexpr size_t WS_O = 348 * MiB;
constexpr size_t WS_GQ = 412 * MiB;
constexpr size_t WS_HALO = 476 * MiB;
constexpr size_t WS_ACT = 296 * MiB;
constexpr size_t WS_END = 508 * MiB;

__device__ __forceinline__ float bf2f(unsigned u) { return __uint_as_float(u << 16); }
__device__ __forceinline__ unsigned f2bf(float f) { unsigned u = __float_as_uint(f); return (u + 0x7fffu + ((u >> 16) & 1u)) >> 16; }
typedef float f32x2_t __attribute__((ext_vector_type(2))); typedef __bf16 bf16x2_t __attribute__((ext_vector_type(2)));
__device__ __forceinline__ unsigned pk2(float lo, float hi) { f32x2_t v = {lo, hi}; bf16x2_t r = __builtin_convertvector(v, bf16x2_t); return __builtin_bit_cast(unsigned, r); }
__device__ __forceinline__ float xsum16(float x) { return x + __shfl_xor(x, 16); }
__device__ __forceinline__ float xsum32(float x) { return x + __shfl_xor(x, 32); }
__device__ __forceinline__ float xmax16(float x) { return fmaxf(x, __shfl_xor(x, 16)); }
__device__ __forceinline__ float xmax32(float x) { return fmaxf(x, __shfl_xor(x, 32)); }
__device__ __forceinline__ float wave_sum(float v) {
#pragma unroll
    for (int o = 1; o < 64; o <<= 1) v += __shfl_xor(v, o);
    return v;
}
__device__ __forceinline__ float rcpf_(float x) { return __builtin_amdgcn_rcpf(x); }
__device__ __forceinline__ float rsqf_(float x) { return __builtin_amdgcn_rsqf(x); }
__device__ __forceinline__ float sigmoidf_(float x) { return rcpf_(1.0f + __expf(-x)); }
__device__ __forceinline__ float siluf_(float x) { return x * rcpf_(1.0f + __expf(-x)); }
__device__ __forceinline__ float softplusf_(float x) { return x > 20.f ? x : __logf(1.0f + __expf(x)); }
__device__ __forceinline__ float logsigmoidf_(float x) { return fminf(x, 0.f) - __logf(1.0f + __expf(-fabsf(x))); }
__device__ __forceinline__ void unpack8(const v4u w, float* f) {
    f[0] = __uint_as_float(w.x << 16); f[1] = __uint_as_float(w.x & 0xffff0000u); f[2] = __uint_as_float(w.y << 16); f[3] = __uint_as_float(w.y & 0xffff0000u);
    f[4] = __uint_as_float(w.z << 16); f[5] = __uint_as_float(w.z & 0xffff0000u); f[6] = __uint_as_float(w.w << 16); f[7] = __uint_as_float(w.w & 0xffff0000u);
}

__device__ __forceinline__ int map_w1(int j) {
    const int t = j >> 8, i = j & 255;
    if (t < 2) return t * 256 + 64 * ((i >> 5) & 3) + 32 * (i >> 7) + (i & 31);
    if (t < 3) return j;
    if (t < 6) return 772 + (t - 3) * 256 + i;
    if (t == 6) return 1548 + i;
    if (t < 12) return 1804 + (t - 7) * 256 + i;
    if (t == 12) return 3084 + i;
    if (t == 13) return 3356 + i;
    if (i < 4) return 768 + i;
    if (i < 8) return 1540 + (i - 4);
    if (i < 12) return 1544 + (i - 8);
    if (i < 28) return 3340 + (i - 12);
    return -1;
}
template <int MAPKIND>
__device__ __forceinline__ void transpose_item(const float* W, int K, int N, bf16* WT, const float* gk, LAS float* scr, int item, int nblk, int lane) {
    const int kb = item / nblk, nb = item % nblk, k0 = 64 * kb, n0 = 32 * nb;
    const int jn = n0 + (lane & 31);
    const int src = MAPKIND == 1 ? map_w1(jn) : MAPKIND == 2 ? ((jn >> 8) * 128 + (jn & 127) + ((jn & 128) ? DFF : 0)) : jn;
    const int srcc = src >= 0 ? src : 0; const float keep = src >= 0 ? 1.f : 0.f;
    float wv[32], gv[32];
#pragma unroll
    for (int i = 0; i < 32; ++i) { const int kk = 2 * i + (lane >> 5); wv[i] = W[(size_t)(k0 + kk) * N + srcc]; gv[i] = gk ? gk[k0 + kk] : 1.f; }
#pragma unroll
    for (int i = 0; i < 32; ++i) { const int kk = 2 * i + (lane >> 5); scr[kk * 33 + (lane & 31)] = wv[i] * gv[i] * keep; }
    LDS_WAIT();
    const int c = lane & 7;
#pragma unroll
    for (int j = 0; j < 4; ++j) { const int n = (lane >> 3) + 8 * j; const LAS float* s = scr + (8 * c) * 33 + n;
        v4u o; o.x = pk2(s[0 * 33], s[1 * 33]); o.y = pk2(s[2 * 33], s[3 * 33]); o.z = pk2(s[4 * 33], s[5 * 33]); o.w = pk2(s[6 * 33], s[7 * 33]);
        *(v4u*)(WT + (size_t)(n0 + n) * K + k0 + 8 * c) = o; }
    LDS_WAIT();
}

#define CAS __attribute__((address_space(4)))
struct KArgs { const float* in[22]; float* out; unsigned char* ws; };
struct Ctx {
    const CAS KArgs* ka; float* out; unsigned char* ws;
    LAS unsigned char* lds;
    int tid, lane, wave, gw, ngw;
};

__device__ __forceinline__ void p0_prologue(Ctx& C) {
    LAS float* scr = (LAS float*)(C.lds + C.wave * 16384);
    constexpr int I1 = 16 * 120, I2 = 16 * 32, I3 = 16 * 176, I4 = 44 * 32, IL = I1 + I2 + I3 + I4;
    for (int it = C.gw; it < 2 * IL; it += C.ngw) {
        const int l = it / IL; int r = it % IL;
        if (r < I1) { transpose_item<1>(C.ka->in[2] + (size_t)l * DM * IN_COLS, DM, IN_COLS, (bf16*)(C.ws + WS_W1T) + (size_t)l * N1 * DM, C.ka->in[1] + l * DM, scr, r, 120, C.lane); continue; } r -= I1;
        if (r < I2) { transpose_item<0>(C.ka->in[16] + (size_t)l * DM * DM, DM, DM, (bf16*)(C.ws + WS_WOT) + (size_t)l * DM * DM, nullptr, scr, r, 32, C.lane); continue; } r -= I2;
        if (r < I3) { transpose_item<2>(C.ka->in[18] + (size_t)l * DM * NUP, DM, NUP, (bf16*)(C.ws + WS_WUT) + (size_t)l * NUP * DM, C.ka->in[17] + l * DM, scr, r, 176, C.lane); continue; } r -= I3;
        transpose_item<0>(C.ka->in[21] + (size_t)l * DFF * DM, DFF, DM, (bf16*)(C.ws + WS_WDT) + (size_t)l * DM * DFF, nullptr, scr, r, 32, C.lane);
    }
    float* ss = (float*)(C.ws + WS_SS);
    bf16* XB = (bf16*)(C.ws + WS_XB);
    for (int m0 = C.gw * 4; m0 < MTOK; m0 += C.ngw * 4) {
        f32x4 v[4][4];
#pragma unroll
        for (int r = 0; r < 4; ++r) { const f32x4* xr = (const f32x4*)(C.ka->in[0] + (size_t)(m0 + r) * DM) + C.lane;
#pragma unroll
            for (int j = 0; j < 4; ++j) v[r][j] = xr[64 * j]; }
#pragma unroll
        for (int r = 0; r < 4; ++r) { unsigned long long* o8 = (unsigned long long*)(XB + (size_t)(m0 + r) * DM) + C.lane; float s = 0.f;
#pragma unroll
            for (int j = 0; j < 4; ++j) { const f32x4 w = v[r][j]; s += (w.x * w.x + w.y * w.y) + (w.z * w.z + w.w * w.w);
                o8[64 * j] = (unsigned long long)pk2(w.x, w.y) | ((unsigned long long)pk2(w.z, w.w) << 32); }
            s = wave_sum(s);
            if (C.lane == 0) ss[m0 + r] = s; }
    }
    for (int i = blockIdx.x * NTHREADS + C.tid; i < 3 * MTOK; i += gridDim.x * NTHREADS) ss[MTOK + i] = 0.f;
}

__device__ __forceinline__ void m0_prep(Ctx& C, int l) {
    bf16* P = (bf16*)(C.ws + WS_P); const float* PS = (const float*)(C.ws + WS_PS); float* CF = (float*)(C.ws + WS_CF);
    const float* qn_g = C.ka->in[3] + l * 64; const float* kn_g = C.ka->in[4] + l * 64; const float* b_f = C.ka->in[5] + l * 4; const float* cw = C.ka->in[7] + l * 4 * 768;
    const int lane = C.lane;
    for (int bh = C.gw; bh < 64; bh += C.ngw) {
        const int b = bh >> 2, h = bh & 3; const float bias = b_f[h];
        const size_t r0 = (size_t)b * SEQ + lane * 32;
        float v[32]; (void)r0;
        { const f32x4* fp = (const f32x4*)((const float*)(C.ws + WS_FF) + (size_t)bh * SEQ + lane * 32);
#pragma unroll
          for (int i = 0; i < 8; ++i) { const f32x4 q4 = fp[i]; v[4 * i] = q4.x; v[4 * i + 1] = q4.y; v[4 * i + 2] = q4.z; v[4 * i + 3] = q4.w; } }
        float run = 0.f;
#pragma unroll
        for (int i = 0; i < 32; ++i) { run += logsigmoidf_(v[i] + bias); v[i] = run; }
        float inc = run;
#pragma unroll
        for (int o = 1; o < 64; o <<= 1) { const float t = __shfl_up(inc, o); if (lane >= o) inc += t; }
        const float ex = inc - run;
        float* cf = CF + (size_t)bh * SEQ + lane * 32;
#pragma unroll
        for (int i = 0; i < 32; i += 4) *(f32x4*)(cf + i) = (f32x4){ex + v[i], ex + v[i + 1], ex + v[i + 2], ex + v[i + 3]} * 1.4426950408889634f;
    }
}
#define XB_TMO      128
#define XB_XCNT(j)  (256  + 64 * (j))
#define XB_XSUB(j)  (1280 + 64 * (j))
#define XB_XGEN(j)  (2304 + 64 * (j))
#define XB_TOP      3328
#define XB_TOPGEN   3392
#define XCD_BAR_WORDS 3456
#define XB_SPIN_CAP (1u << 18)

__device__ __forceinline__ unsigned xb_ld(unsigned* p)              { return __hip_atomic_load(p, __ATOMIC_RELAXED, __HIP_MEMORY_SCOPE_AGENT); }
__device__ __forceinline__ unsigned xb_add(unsigned* p, unsigned v) { return __hip_atomic_fetch_add(p, v, __ATOMIC_RELAXED, __HIP_MEMORY_SCOPE_AGENT); }
__device__ __forceinline__ unsigned xb_xcc_id() { return (unsigned)__builtin_amdgcn_s_getreg((3 << 11) | 20) & 0xFu; }
#define XB_SPIN(cond, bar) do { unsigned _sp = 0; while (cond) { __builtin_amdgcn_s_sleep(1); \
    if ((++_sp & 255u) == 0u) { if (xb_ld(&(bar)[XB_TMO])) break; if (_sp > XB_SPIN_CAP) { atomicAdd(&(bar)[XB_TMO], 1u); break; } } } } while (0)

struct XcdBarrier {
    unsigned* bar; unsigned x;
    volatile LAS unsigned* st;
};

__device__ __forceinline__ XcdBarrier xcd_barrier_post(unsigned* bar, volatile LAS unsigned* st) {
    XcdBarrier b; b.bar = bar; b.x = xb_xcc_id(); b.st = st;
    if (threadIdx.x == 0) (void)xb_add(&bar[XB_XCNT(b.x)], 1u);
    return b;
}
__device__ __forceinline__ void xcd_barrier_complete(unsigned* bar, unsigned x, unsigned& nloc, unsigned& nx) {
    const unsigned G = gridDim.x * gridDim.y * gridDim.z;
    unsigned sum, cnt, mine, sp = 0u;
    for (;;) {
        sum = 0u; cnt = 0u; mine = 0u;
#pragma unroll
        for (unsigned j = 0; j < 16; ++j) { const unsigned c = xb_ld(&bar[XB_XCNT(j)]); sum += c; cnt += (c > 0u) ? 1u : 0u; mine = (j == x) ? c : mine; }
        if (sum == G) break;
        __builtin_amdgcn_s_sleep(1);
        if ((++sp & 255u) == 0u) { if (xb_ld(&bar[XB_TMO])) break; if (sp > XB_SPIN_CAP) { atomicAdd(&bar[XB_TMO], 1u); break; } }
    }
    nloc = mine > 0u ? mine : 1u; nx = cnt > 0u ? cnt : 1u;
}

__device__ __forceinline__ void xcd_barrier(const XcdBarrier& b) {
    asm volatile("s_waitcnt vmcnt(0)" ::: "memory");
    __syncthreads();
    if (threadIdx.x == 0) {
        unsigned* bar = b.bar;
        __builtin_amdgcn_s_waitcnt(0);
        unsigned nloc = b.st[0], nx = b.st[1];
        if (nloc == 0u) { xcd_barrier_complete(bar, b.x, nloc, nx); b.st[0] = nloc; b.st[1] = nx; }
        const unsigned old = xb_add(&bar[XB_XSUB(b.x)], 1u);
        const unsigned gen = old / nloc;
        if (old + 1u == (gen + 1u) * nloc) {
            __builtin_amdgcn_fence(__ATOMIC_RELEASE, "agent");
            asm volatile("s_waitcnt vmcnt(0)" ::: "memory");
            const unsigned og = xb_add(&bar[XB_TOP], 1u);
            const unsigned tg = og / nx;
            if (og + 1u == (tg + 1u) * nx) xb_add(&bar[XB_TOPGEN], 1u);
            else XB_SPIN(xb_ld(&bar[XB_TOPGEN]) == tg, bar);
            __builtin_amdgcn_fence(__ATOMIC_ACQUIRE, "agent");
            xb_add(&bar[XB_XGEN(b.x)], 1u);
            asm volatile("s_waitcnt vmcnt(0)" ::: "memory");
        } else {
            XB_SPIN(xb_ld(&bar[XB_XGEN(b.x)]) == gen, bar);
            __builtin_amdgcn_fence(__ATOMIC_ACQUIRE, "agent");
            asm volatile("s_waitcnt vmcnt(0)" ::: "memory");
        }
    }
    __syncthreads();
}
typedef short s16x4 __attribute__((ext_vector_type(4)));
constexpr size_t OS_VTH = 0 * MiB, OS_VTG = 16 * MiB, OS_KTH = 32 * MiB, OS_KTG = 48 * MiB, OS_ADH = 56 * MiB, OS_ADG = 58 * MiB;
__device__ __forceinline__ f32x4 mfma16(s16x4 a, s16x4 b, f32x4 c) { return __builtin_amdgcn_mfma_f32_16x16x16bf16_1k(a, b, c, 0, 0, 0); }
__device__ __forceinline__ s16x4 ld8(const bf16* p) { return *(const s16x4*)p; }
__device__ __forceinline__ s16x4 cvt4(f32x4 v) { v2u w; w.x = pk2(v.x, v.y); w.y = pk2(v.z, v.w); return __builtin_bit_cast(s16x4, w); }

struct LinRaw { unsigned short v[16], q[16], k[16]; f32x4 gk4; };
template <int MODE>
__device__ __forceinline__ void lin_stage1_load(Ctx& C, int item, LinRaw& R) {
    const int lane = C.lane, bh = item >> 7, blk = item & 127, b = bh >> 2, h = bh & 3;
    const bf16* P = (const bf16*)(C.ws + WS_P); const size_t row0 = (size_t)b * SEQ + blk * 16;
    const bf16* vp = P + row0 * NP + (MODE == 0 ? 9 : 12) * 256 + h * 64 + lane;
    const bf16* qp = MODE == 0 ? P + row0 * NP + 7 * 256 + h * 64 + lane : P + row0 * NP + 11 * 256 + h * 32 + (lane & 31);
    const bf16* kp = qp + (MODE == 0 ? 256 : 128);
#pragma unroll
    for (int t = 0; t < 16; ++t) { R.v[t] = vp[(size_t)t * NP]; R.q[t] = qp[(size_t)t * NP]; R.k[t] = kp[(size_t)t * NP]; }
    if (MODE == 1) R.gk4 = *(const f32x4*)((const float*)(C.ws + WS_PS) + (row0 + (lane >> 2)) * 32 + 12 + 4 * (lane & 3));
}
template <int MODE>
__device__ __forceinline__ void lin_stage1_finish(Ctx& C, int l, int item, const LinRaw& R, LAS float* gl) {
    constexpr int DK = MODE == 0 ? 64 : 32;
    const int lane = C.lane, bh = item >> 7, blk = item & 127, b = bh >> 2, h = bh & 3;
    bf16* P = (bf16*)(C.ws + WS_P);
    const size_t row0 = (size_t)b * SEQ + blk * 16;
    bf16* Kt = (bf16*)((unsigned char*)C.out + (MODE == 0 ? OS_KTH : OS_KTG)) + (size_t)item * DK * 16;
    bf16* Vt = (bf16*)((unsigned char*)C.out + (MODE == 0 ? OS_VTH : OS_VTG)) + (size_t)item * 64 * 16;
    float* Ad = (float*)((unsigned char*)C.out + (MODE == 0 ? OS_ADH : OS_ADG)) + (size_t)item * DK;
    { unsigned w[8];
#pragma unroll
      for (int t = 0; t < 16; t += 2) w[t >> 1] = (unsigned)R.v[t] | ((unsigned)R.v[t + 1] << 16);
      v4u* o = (v4u*)(Vt + lane * 16); o[0] = (v4u){w[0], w[1], w[2], w[3]}; o[1] = (v4u){w[4], w[5], w[6], w[7]}; }
    const int d = lane;
    float la[16], kk[16], qq[16];
    bf16* qp; bf16* kp;
    if (MODE == 0) {
        float lb = 0.f;
        if (l == 1) { const float a0 = C.ka->in[11][h * 64 + d], a1 = C.ka->in[11][256 + h * 64 + d]; lb = rcpf_(1.0f + __expf(a0 - a1)); }
        qp = P + row0 * NP + 7 * 256 + h * 64 + d; kp = qp + 256;
#pragma unroll
        for (int t = 0; t < 16; ++t) { const float qv = bf2f(R.q[t]), fv = bf2f(R.k[t]); const float sg = sigmoidf_(fv);
            la[t] = __logf(lb + (1.0f - lb) * sg); kk[t] = (1.0f - lb) * (1.0f - sg); qq[t] = siluf_(qv) * 0.125f; }
    } else {
        const float* Wg = C.ka->in[13] + l * 16 * 128 + h * 32 + (d & 31); const float bg = C.ka->in[14][l * 128 + h * 32 + (d & 31)];
        float wg[16];
#pragma unroll
        for (int r = 0; r < 16; ++r) wg[r] = Wg[r * 128];
        qp = P + row0 * NP + 11 * 256 + h * 32 + (d & 31); kp = qp + 128;
        *(LAS f32x4*)(gl + lane * 4) = R.gk4;
        LDS_WAIT();
#pragma unroll
        for (int t = 0; t < 16; ++t) { float gk[16];
#pragma unroll
            for (int r4 = 0; r4 < 4; ++r4) { const f32x4 q4 = *(const LAS f32x4*)(gl + t * 16 + 4 * r4); gk[4 * r4] = q4.x; gk[4 * r4 + 1] = q4.y; gk[4 * r4 + 2] = q4.z; gk[4 * r4 + 3] = q4.w; }
            float zz = bg;
#pragma unroll
            for (int r = 0; r < 16; ++r) zz += gk[r] * wg[r];
            la[t] = logsigmoidf_(zz) * (1.0f / 16.0f); kk[t] = bf2f(R.k[t]); qq[t] = bf2f(R.q[t]) * 0.17677669529663687f; }
    }
    if (MODE == 0 || lane < 32) {
        float g = 0.f;
#pragma unroll
        for (int t = 0; t < 16; ++t) { g += la[t]; la[t] = g; }
        unsigned w[8];
#pragma unroll
        for (int t = 0; t < 16; ++t) {
            qp[(size_t)t * NP] = (bf16)f2bf(qq[t] * __expf(la[t]));
            kp[(size_t)t * NP] = (bf16)f2bf(kk[t] * __expf(fminf(-la[t], 80.f)));
            const unsigned kt = f2bf(kk[t] * __expf(g - la[t]));
            if (t & 1) w[t >> 1] |= kt << 16; else w[t >> 1] = kt;
        }
        { v4u* o = (v4u*)(Kt + d * 16); o[0] = (v4u){w[0], w[1], w[2], w[3]}; o[1] = (v4u){w[4], w[5], w[6], w[7]}; }
        Ad[d] = __expf(g);
    }
}
template <int MODE>
__device__ __forceinline__ void lin_stage1_pair(Ctx& C, int l, int itemA, int itemB, LAS unsigned char* wl) {
    LinRaw A, B; lin_stage1_load<MODE>(C, itemA, A); lin_stage1_load<MODE>(C, itemB, B);
    lin_stage1_finish<MODE>(C, l, itemA, A, (LAS float*)wl); lin_stage1_finish<MODE>(C, l, itemB, B, (LAS float*)(wl + 1024));
}
template <int MODE>
__device__ __forceinline__ void lin_stage1_quad(Ctx& C, int l, int item, int stride, LAS unsigned char* wl) {
    LinRaw A, B, D, E; lin_stage1_load<MODE>(C, item, A); lin_stage1_load<MODE>(C, item + stride, B); lin_stage1_load<MODE>(C, item + 2 * stride, D); lin_stage1_load<MODE>(C, item + 3 * stride, E);
    lin_stage1_finish<MODE>(C, l, item, A, (LAS float*)wl); lin_stage1_finish<MODE>(C, l, item + stride, B, (LAS float*)(wl + 1024));
    lin_stage1_finish<MODE>(C, l, item + 2 * stride, D, (LAS float*)(wl + 2048)); lin_stage1_finish<MODE>(C, l, item + 3 * stride, E, (LAS float*)(wl + 3072));
}

struct ScanSeg { const unsigned char* g; unsigned gstride, gstep; int nch, rowch, lpitch, loff; };
constexpr int SCAN_BH_LDS = 11520, SCAN_BUF = 2 * SCAN_BH_LDS, SCAN_XS = 2 * SCAN_BUF;
struct ScanCopy { const unsigned char* gp[3]; unsigned gstep[3]; int loff[3]; };
__device__ __forceinline__ void scan_copy_init(ScanCopy& cp, const ScanSeg (&segs)[2][6], int tid) {
    int per = 0;
#pragma unroll
    for (int s = 0; s < 6; ++s) per += segs[0][s].nch;
#pragma unroll
    for (int j = 0; j < 3; ++j) {
        const int c = tid + 512 * j; cp.gp[j] = nullptr; cp.gstep[j] = 0; cp.loff[j] = 0;
        if (c < 2 * per) {
            const int bhl = c >= per ? 1 : 0; int r = c - bhl * per;
#pragma unroll
            for (int s = 0; s < 6; ++s) {
                const ScanSeg& sg = segs[bhl][s];
                if (r >= 0 && r < sg.nch) {
                    const int row = sg.rowch ? r / sg.rowch : 0, ch = sg.rowch ? r % sg.rowch : r;
                    cp.gp[j] = sg.g + (size_t)row * sg.gstride + ch * 16; cp.gstep[j] = sg.gstep; cp.loff[j] = bhl * SCAN_BH_LDS + sg.loff + row * sg.lpitch + ch * 16;
                }
                r -= sg.nch;
            }
        } else { cp.gp[j] = cp.gp[0]; cp.gstep[j] = cp.gstep[0]; cp.loff[j] = cp.loff[0]; }
    }
}
__device__ __forceinline__ void scan_copy_load(const ScanCopy& cp, v4u (&R)[3], int step) {
#pragma unroll
    for (int j = 0; j < 3; ++j) R[j] = *(const v4u*)(cp.gp[j] + (size_t)step * cp.gstep[j]);
}
__device__ __forceinline__ void scan_copy_store(const ScanCopy& cp, const v4u (&R)[3], LAS unsigned char* buf) {
#pragma unroll
    for (int j = 0; j < 3; ++j) *(LAS v4u*)(buf + cp.loff[j]) = R[j];
}

template <int MODE>
__device__ __forceinline__ void lin_scan(Ctx& C, int l, int bh0) {
    constexpr int DK = MODE == 0 ? 64 : 32, ND = DK / 16, PQ = DK * 2 + 16;
    constexpr int OQ = 0, OK = 16 * PQ, OZ = 2 * 16 * PQ, OKT = OZ + 2304, OVT = OKT + DK * 32, OAD = OVT + 2048;
    static_assert(OAD + DK * 4 <= SCAN_BH_LDS, "scan LDS map");
    const int lane = C.lane, n = lane & 15, g = lane >> 4, et = C.wave & 3, bhl = C.wave >> 2, bh = bh0 + bhl, b = bh >> 2, h = bh & 3;
    const unsigned char* P = C.ws + WS_P; bf16* O = (bf16*)(C.ws + WS_O);
    const float* gain = (MODE == 0 ? C.ka->in[12] : C.ka->in[15]) + l * 64;
    const int ocol = (MODE == 0 ? 512 : 768) + h * 64;
    ScanSeg segs[2][6];
#pragma unroll
    for (int q = 0; q < 2; ++q) {
        const int bq = bh0 + q, hq = bq & 3; const size_t rb = (size_t)(bq >> 2) * SEQ;
        const int qcol = MODE == 0 ? 7 * 256 + hq * 64 : 11 * 256 + hq * 32, kcol = MODE == 0 ? 8 * 256 + hq * 64 : 11 * 256 + 128 + hq * 32, zcol = (MODE == 0 ? 10 : 13) * 256 + hq * 64;
        segs[q][0] = ScanSeg{P + (rb * NP + qcol) * 2, NP * 2, 16 * NP * 2, 16 * (DK / 8), DK / 8, PQ, OQ};
        segs[q][1] = ScanSeg{P + (rb * NP + kcol) * 2, NP * 2, 16 * NP * 2, 16 * (DK / 8), DK / 8, PQ, OK};
        segs[q][2] = ScanSeg{P + (rb * NP + zcol) * 2, NP * 2, 16 * NP * 2, 128, 8, 144, OZ};
        segs[q][3] = ScanSeg{(unsigned char*)C.out + (MODE == 0 ? OS_KTH : OS_KTG) + (size_t)bq * 128 * DK * 32, 0, DK * 32, DK * 2, 0, 0, OKT};
        segs[q][4] = ScanSeg{(unsigned char*)C.out + (MODE == 0 ? OS_VTH : OS_VTG) + (size_t)bq * 128 * 2048, 0, 2048, 128, 0, 0, OVT};
        segs[q][5] = ScanSeg{(unsigned char*)C.out + (MODE == 0 ? OS_ADH : OS_ADG) + (size_t)bq * 128 * DK * 4, 0, DK * 4, DK / 4, 0, 0, OAD};
    }
    ScanCopy cp; scan_copy_init(cp, segs, C.tid);
    LAS unsigned char* lds = C.lds; LAS float* xs = (LAS float*)(lds + SCAN_XS);
    f32x4 S[ND];
#pragma unroll
    for (int i = 0; i < ND; ++i) S[i] = (f32x4){0.f, 0.f, 0.f, 0.f};
    const f32x4 gn = *(const f32x4*)(gain + 16 * et + 4 * g);
    const size_t rowb = (size_t)b * SEQ;
    v4u R[4][3];
    scan_copy_load(cp, R[0], 0); scan_copy_store(cp, R[0], lds);
    scan_copy_load(cp, R[1], 1); scan_copy_load(cp, R[2], 2); scan_copy_load(cp, R[3], 3); scan_copy_load(cp, R[0], 4);
    __syncthreads();
#pragma unroll 1
    for (int blk0 = 0; blk0 < 128; blk0 += 4) {
#pragma unroll
        for (int u = 0; u < 4; ++u) {
            const int blk = blk0 + u;
            scan_copy_store(cp, R[(u + 1) & 3], lds + ((blk + 1) & 1) * SCAN_BUF);
            scan_copy_load(cp, R[(u + 1) & 3], blk + 5 < 128 ? blk + 5 : 127);
            const LAS unsigned char* base = lds + (blk & 1) * SCAN_BUF + bhl * SCAN_BH_LDS;
            s16x4 qf[ND], khf[ND], ktf[ND]; f32x4 ad[ND];
#pragma unroll
            for (int i = 0; i < ND; ++i) { qf[i] = *(const LAS s16x4*)(base + OQ + n * PQ + (16 * i + 4 * g) * 2); khf[i] = *(const LAS s16x4*)(base + OK + n * PQ + (16 * i + 4 * g) * 2);
                ktf[i] = *(const LAS s16x4*)(base + OKT + ((16 * i + n) * 16 + 4 * g) * 2); ad[i] = *(const LAS f32x4*)(base + OAD + (16 * i + 4 * g) * 4); }
            const s16x4 vtf = *(const LAS s16x4*)(base + OVT + ((16 * et + n) * 16 + 4 * g) * 2), zf = *(const LAS s16x4*)(base + OZ + n * 144 + (16 * et + 4 * g) * 2);
            f32x4 at = (f32x4){0.f, 0.f, 0.f, 0.f};
#pragma unroll
            for (int i = 0; i < ND; ++i) at = mfma16(khf[i], qf[i], at);
#pragma unroll
            for (int j = 0; j < 4; ++j) if (4 * g + j > n) at[j] = 0.f;
            f32x4 oT = mfma16(vtf, cvt4(at), (f32x4){0.f, 0.f, 0.f, 0.f});
#pragma unroll
            for (int i = 0; i < ND; ++i) oT = mfma16(cvt4(S[i]), qf[i], oT);
#pragma unroll
            for (int i = 0; i < ND; ++i) S[i] = mfma16(ktf[i], vtf, S[i] * ad[i]);
            float ss = (oT.x * oT.x + oT.y * oT.y) + (oT.z * oT.z + oT.w * oT.w);
            ss = xsum32(xsum16(ss));
            LAS float* xp = xs + (blk & 1) * 128 + bhl * 64;
            if (g == 0) xp[et * 16 + n] = ss;
            __syncthreads();
            ss = (xp[n] + xp[16 + n]) + (xp[32 + n] + xp[48 + n]);
            const float r = rsqf_(ss * (1.0f / 64.0f) + RMS_EPS);
            { const v2u zw = __builtin_bit_cast(v2u, zf);
              const float z0 = bf2f(zw.x & 0xffffu), z1 = bf2f(zw.x >> 16), z2 = bf2f(zw.y & 0xffffu), z3 = bf2f(zw.y >> 16);
              v2u w; w.x = pk2(oT.x * r * gn.x * siluf_(z0), oT.y * r * gn.y * siluf_(z1)); w.y = pk2(oT.z * r * gn.z * siluf_(z2), oT.w * r * gn.w * siluf_(z3));
              *(v2u*)(O + (rowb + blk * 16 + n) * DM + ocol + 16 * et + 4 * g) = w; }
        }
    }
    __syncthreads();
}

struct GlaRaw { unsigned short v[16], q[2][4], k[2][4]; f32x4 gk4; };
struct GlaW { s16x4 bh[2], bl[2]; float bias[2]; };
__device__ __forceinline__ void gla_w_load(Ctx& C, int l, int h, GlaW& W) {
    const int n = C.lane & 15, g = C.lane >> 4;
#pragma unroll
    for (int dt = 0; dt < 2; ++dt) { const float* wp = C.ka->in[13] + l * 16 * 128 + h * 32 + 16 * dt + n; float w[4], lo[4];
#pragma unroll
        for (int j = 0; j < 4; ++j) { w[j] = wp[(4 * g + j) * 128]; lo[j] = w[j] - bf2f(f2bf(w[j])); }
        W.bh[dt] = cvt4((f32x4){w[0], w[1], w[2], w[3]}); W.bl[dt] = cvt4((f32x4){lo[0], lo[1], lo[2], lo[3]});
        W.bias[dt] = C.ka->in[14][l * 128 + h * 32 + 16 * dt + n]; }
}
__device__ __forceinline__ void gla_stage1_load(Ctx& C, int item, GlaRaw& R) {
    const int lane = C.lane, n = lane & 15, g = lane >> 4, bh = item >> 7, blk = item & 127, b = bh >> 2, h = bh & 3;
    const bf16* P = (const bf16*)(C.ws + WS_P); const size_t row0 = (size_t)b * SEQ + blk * 16;
    const bf16* vp = P + row0 * NP + 12 * 256 + h * 64 + lane;
#pragma unroll
    for (int t = 0; t < 16; ++t) R.v[t] = vp[(size_t)t * NP];
#pragma unroll
    for (int dt = 0; dt < 2; ++dt)
#pragma unroll
        for (int j = 0; j < 4; ++j) { const bf16* qp = P + (row0 + 4 * g + j) * NP + 11 * 256 + h * 32 + 16 * dt + n; R.q[dt][j] = qp[0]; R.k[dt][j] = qp[128]; }
    R.gk4 = *(const f32x4*)((const float*)(C.ws + WS_PS) + (row0 + n) * 32 + 12 + 4 * g);
}
__device__ __forceinline__ void gla_stage1_finish(Ctx& C, int item, const GlaRaw& R, const GlaW& W) {
    const int lane = C.lane, n = lane & 15, g = lane >> 4, bh = item >> 7, blk = item & 127, b = bh >> 2, h = bh & 3;
    bf16* P = (bf16*)(C.ws + WS_P); const size_t row0 = (size_t)b * SEQ + blk * 16;
    bf16* Kt = (bf16*)((unsigned char*)C.out + OS_KTG) + (size_t)item * 32 * 16;
    bf16* Vt = (bf16*)((unsigned char*)C.out + OS_VTG) + (size_t)item * 64 * 16;
    float* Ad = (float*)((unsigned char*)C.out + OS_ADG) + (size_t)item * 32;
    { unsigned w[8];
#pragma unroll
      for (int t = 0; t < 16; t += 2) w[t >> 1] = (unsigned)R.v[t] | ((unsigned)R.v[t + 1] << 16);
      v4u* o = (v4u*)(Vt + lane * 16); o[0] = (v4u){w[0], w[1], w[2], w[3]}; o[1] = (v4u){w[4], w[5], w[6], w[7]}; }
    f32x4 alo;
#pragma unroll
    for (int j = 0; j < 4; ++j) alo[j] = R.gk4[j] - bf2f(f2bf(R.gk4[j]));
    const s16x4 ah = cvt4(R.gk4), al = cvt4(alo);
#pragma unroll
    for (int dt = 0; dt < 2; ++dt) {
        f32x4 z = mfma16(ah, W.bh[dt], (f32x4){0.f, 0.f, 0.f, 0.f}); z = mfma16(al, W.bh[dt], z); z = mfma16(ah, W.bl[dt], z);
        float gc[4]; float run = 0.f;
#pragma unroll
        for (int j = 0; j < 4; ++j) { run += logsigmoidf_(z[j] + W.bias[dt]) * (1.0f / 16.0f); gc[j] = run; }
        const float s16 = xsum16(run), p16 = s16 - run, p32 = xsum32(s16) - s16;
        const float ex = ((g & 1) ? p16 : 0.f) + ((g & 2) ? p32 : 0.f), glast = s16 + p32;
        bf16* qp = P + (row0 + 4 * g) * NP + 11 * 256 + h * 32 + 16 * dt + n;
        float kt[4];
#pragma unroll
        for (int j = 0; j < 4; ++j) { const float G = ex + gc[j], kv = bf2f(R.k[dt][j]);
            qp[(size_t)j * NP] = (bf16)f2bf(bf2f(R.q[dt][j]) * 0.17677669529663687f * __expf(G));
            qp[(size_t)j * NP + 128] = (bf16)f2bf(kv * __expf(fminf(-G, 80.f)));
            kt[j] = kv * __expf(glast - G); }
        *(s16x4*)(Kt + (16 * dt + n) * 16 + 4 * g) = cvt4((f32x4){kt[0], kt[1], kt[2], kt[3]});
        if (g == 0) Ad[16 * dt + n] = __expf(glast);
    }
}
__device__ __forceinline__ void gla_stage1_pair(Ctx& C, int itemA, int itemB, const GlaW& W) {
    GlaRaw A, B; gla_stage1_load(C, itemA, A); gla_stage1_load(C, itemB, B);
    gla_stage1_finish(C, itemA, A, W); gla_stage1_finish(C, itemB, B, W);
}
constexpr size_t WS_GD_Q = 412 * MiB, WS_GD_W = 428 * MiB, WS_GD_KT = 444 * MiB, WS_GD_UT = 460 * MiB, WS_GD_AQ = 476 * MiB, WS_GD_AB = 480 * MiB;
typedef unsigned short us2_t __attribute__((ext_vector_type(2)));
struct GdnRaw { us2_t r[3][10]; float pb, pa; };
__device__ __forceinline__ void gdn_stage1_load(Ctx& C, int item, GdnRaw& R) {
    const int lane = C.lane, bh = item >> 7, blk = item & 127, b = bh >> 2, h = bh & 3;
    const bf16* P = (const bf16*)(C.ws + WS_P); const float* PS = (const float*)(C.ws + WS_PS);
    const size_t row0 = (size_t)b * SEQ + blk * 16;
#pragma unroll
    for (int part = 0; part < 3; ++part) { const bf16* rp = P + row0 * NP + 768 + part * 256 + h * 64 + lane;
#pragma unroll
        for (int i = 0; i < 19; ++i) R.r[part][i >> 1][i & 1] = rp[(long)((blk * 16 + i - 3 >= 0) ? i - 3 : 0) * NP]; }
    const float* ps = PS + (row0 + (lane & 15)) * 32; R.pb = ps[4 + h]; R.pa = ps[8 + h];
}
__device__ __forceinline__ void gdn_stage1_finish(Ctx& C, int l, int item, const GdnRaw& R, LAS unsigned char* wl) {
    const int lane = C.lane, bh = item >> 7, blk = item & 127, b = bh >> 2, h = bh & 3, n = lane & 15, g = lane >> 4;
    const size_t row0 = (size_t)b * SEQ + blk * 16;
    bf16* Qg = (bf16*)(C.ws + WS_GD_Q) + row0 * 256 + h * 64; bf16* Wg = (bf16*)(C.ws + WS_GD_W) + row0 * 256 + h * 64;
    bf16* Ktg = (bf16*)(C.ws + WS_GD_KT) + (size_t)item * 1024; bf16* Utg = (bf16*)(C.ws + WS_GD_UT) + (size_t)item * 1024;
    bf16* Aqg = (bf16*)(C.ws + WS_GD_AQ) + (size_t)item * 256; float* Abg = (float*)(C.ws + WS_GD_AB);
    LAS bf16* qh = (LAS bf16*)wl; LAS bf16* kh = qh + 1024; LAS bf16* kT = kh + 1024; LAS bf16* vT = kT + 1024;
    LAS float* Ms = (LAS float*)(wl + 8192); LAS bf16* Xw = (LAS bf16*)(wl + 9216); LAS bf16* Xu = Xw + 256; LAS float* sc = (LAS float*)(wl + 10240);
    {
        const float Acoef = -__expf(C.ka->in[8][l * 4 + h]), dtb = C.ka->in[9][l * 4 + h];
        const float beta = sigmoidf_(R.pb); float gc = Acoef * softplusf_(R.pa + dtb);
#pragma unroll
        for (int o = 1; o < 16; o <<= 1) { const float t = __shfl_up(gc, o); if (n >= o) gc += t; }
        if (lane < 16) { sc[lane] = beta; sc[16 + lane] = gc; }
    }
    LDS_WAIT();
    float gc[16];
#pragma unroll
    for (int t = 0; t < 16; t += 4) { const f32x4 v = *(const LAS f32x4*)(sc + 16 + t); gc[t] = v.x; gc[t + 1] = v.y; gc[t + 2] = v.z; gc[t + 3] = v.w; }
    const float glast = gc[15];
    const float* cw = C.ka->in[7] + l * 4 * 768 + h * 64 + lane;
    float raw[3][19];
#pragma unroll
    for (int part = 0; part < 3; ++part)
#pragma unroll
        for (int i = 0; i < 19; ++i) raw[part][i] = (i >= 3 || blk > 0) ? bf2f(R.r[part][i >> 1][i & 1]) : 0.f;
    float kraw[16];
#pragma unroll
    for (int part = 0; part < 3; ++part) {
        const float w0 = cw[part * 256], w1 = cw[768 + part * 256], w2 = cw[2 * 768 + part * 256], w3 = cw[3 * 768 + part * 256];
        float y[16];
#pragma unroll
        for (int t = 0; t < 16; ++t) y[t] = siluf_(w0 * raw[part][t] + w1 * raw[part][t + 1] + w2 * raw[part][t + 2] + w3 * raw[part][t + 3]);
        if (part == 0) {
#pragma unroll
            for (int t = 0; t < 16; ++t) qh[t * 64 + lane] = (bf16)f2bf(y[t]);
        } else if (part == 1) {
            unsigned w[8];
#pragma unroll
            for (int t = 0; t < 16; ++t) { kh[t * 64 + lane] = (bf16)f2bf(y[t]); kraw[t] = y[t]; }
#pragma unroll
            for (int t = 0; t < 16; t += 2) w[t >> 1] = pk2(y[t], y[t + 1]);
            LAS v4u* o = (LAS v4u*)(kT + lane * 16); o[0] = (v4u){w[0], w[1], w[2], w[3]}; o[1] = (v4u){w[4], w[5], w[6], w[7]};
        } else {
            unsigned w[8];
#pragma unroll
            for (int t = 0; t < 16; t += 2) w[t >> 1] = pk2(y[t], y[t + 1]);
            LAS v4u* o = (LAS v4u*)(vT + lane * 16); o[0] = (v4u){w[0], w[1], w[2], w[3]}; o[1] = (v4u){w[4], w[5], w[6], w[7]};
        }
    }
    LDS_WAIT();
    f32x4 ckk = (f32x4){0.f, 0.f, 0.f, 0.f}, cqk = ckk, cqq = ckk;
#pragma unroll
    for (int i = 0; i < 4; ++i) { const s16x4 kf = *(const LAS s16x4*)(kh + n * 64 + 16 * i + 4 * g), qf = *(const LAS s16x4*)(qh + n * 64 + 16 * i + 4 * g);
        ckk = mfma16(kf, kf, ckk); cqk = mfma16(kf, qf, cqk); cqq = mfma16(qf, qf, cqq); }
    if (g == (n >> 2)) { const int j = n & 3; sc[32 + n] = rsqf_(ckk[j] + RMS_EPS); sc[48 + n] = rsqf_(cqq[j] + RMS_EPS) * 0.125f; }
    LDS_WAIT();
    float rnk[16], rnq[16];
#pragma unroll
    for (int t = 0; t < 16; t += 4) { const f32x4 a = *(const LAS f32x4*)(sc + 32 + t), c2 = *(const LAS f32x4*)(sc + 48 + t);
        rnk[t] = a.x; rnk[t + 1] = a.y; rnk[t + 2] = a.z; rnk[t + 3] = a.w; rnq[t] = c2.x; rnq[t + 1] = c2.y; rnq[t + 2] = c2.z; rnq[t + 3] = c2.w; }
    {
#pragma unroll
        for (int t = 0; t < 16; ++t) Qg[(size_t)t * 256 + lane] = (bf16)f2bf(bf2f(qh[t * 64 + lane]) * rnq[t] * __expf(gc[t]));
        unsigned wk[8];
#pragma unroll
        for (int t = 0; t < 16; t += 2) wk[t >> 1] = pk2(kraw[t] * rnk[t] * __expf(glast - gc[t]), kraw[t + 1] * rnk[t + 1] * __expf(glast - gc[t + 1]));
        v4u* og = (v4u*)(Ktg + lane * 16); og[0] = (v4u){wk[0], wk[1], wk[2], wk[3]}; og[1] = (v4u){wk[4], wk[5], wk[6], wk[7]};
    }
    { const float rkr = sc[32 + n], rqr = sc[48 + n]; const f32x4 rks = *(const LAS f32x4*)(sc + 32 + 4 * g);
#pragma unroll
      for (int j = 0; j < 4; ++j) { ckk[j] *= rks[j] * rkr; cqk[j] *= rks[j] * rqr; } }
    const float Gr = sc[16 + n], beta_r = sc[n];
    const f32x4 Gs = *(const LAS f32x4*)(sc + 16 + 4 * g);
    f32x4 mv, av;
#pragma unroll
    for (int j = 0; j < 4; ++j) { const int s = 4 * g + j; const float dec = __expf(Gr - Gs[j]); mv[j] = s < n ? beta_r * ckk[j] * dec : 0.f; av[j] = s <= n ? cqk[j] * dec : 0.f; }
    *(LAS f32x4*)(Ms + n * 16 + 4 * g) = mv;
    *(s16x4*)(Aqg + n * 16 + 4 * g) = cvt4(av);
    LDS_WAIT();
    float X[16];
    X[0] = (n == 0) ? 1.f : 0.f;
#pragma unroll
    for (int r = 1; r < 16; ++r) {
        float a0 = (n == r) ? 1.f : 0.f, a1 = 0.f;
#pragma unroll
        for (int s4 = 0; s4 < r; s4 += 4) { const f32x4 m4 = *(const LAS f32x4*)(Ms + r * 16 + s4);
            a0 -= m4.x * X[s4]; if (s4 + 1 < r) a1 -= m4.y * X[s4 + 1]; if (s4 + 2 < r) a0 -= m4.z * X[s4 + 2]; if (s4 + 3 < r) a1 -= m4.w * X[s4 + 3]; }
        X[r] = a0 + a1;
    }
    { const float bu = sc[n], bw = bu * __expf(sc[16 + n]) * sc[32 + n];
      if (lane < 16) {
#pragma unroll
          for (int r = 0; r < 16; ++r) { Xw[r * 16 + n] = (bf16)f2bf(X[r] * bw); Xu[r * 16 + n] = (bf16)f2bf(X[r] * bu); } } }
    LDS_WAIT();
    const s16x4 xwf = *(const LAS s16x4*)(Xw + n * 16 + 4 * g), xuf = *(const LAS s16x4*)(Xu + n * 16 + 4 * g);
#pragma unroll
    for (int i = 0; i < 4; ++i) {
        const f32x4 cwt = mfma16(*(const LAS s16x4*)(kT + (16 * i + n) * 16 + 4 * g), xwf, (f32x4){0.f, 0.f, 0.f, 0.f});
        *(s16x4*)(Wg + (size_t)n * 256 + 16 * i + 4 * g) = cvt4(cwt);
        const f32x4 cut = mfma16(xuf, *(const LAS s16x4*)(vT + (16 * i + n) * 16 + 4 * g), (f32x4){0.f, 0.f, 0.f, 0.f});
        *(s16x4*)(Utg + (16 * i + n) * 16 + 4 * g) = cvt4(cut);
    }
    if (lane == 0) Abg[item] = __expf(glast);
    LDS_WAIT();
}

__device__ __forceinline__ void gdn_scan(Ctx& C, int l, int bh0) {
    constexpr int OQ = 0, OW = 2304, OZ = 4608, OKT = 6912, OUT = 8960, OAQ = 11008;
    const int lane = C.lane, n = lane & 15, g = lane >> 4, et = C.wave & 3, bhl = C.wave >> 2, bh = bh0 + bhl, b = bh >> 2, h = bh & 3;
    bf16* O = (bf16*)(C.ws + WS_O);
    const float* Abg = (const float*)(C.ws + WS_GD_AB) + bh * 128;
    const float* gain = C.ka->in[10] + l * 64;
    ScanSeg segs[2][6];
#pragma unroll
    for (int q = 0; q < 2; ++q) {
        const int bq = bh0 + q, hq = bq & 3; const size_t rb = (size_t)(bq >> 2) * SEQ;
        segs[q][0] = ScanSeg{C.ws + WS_GD_Q + (rb * 256 + hq * 64) * 2, 512, 16 * 512, 128, 8, 144, OQ};
        segs[q][1] = ScanSeg{C.ws + WS_GD_W + (rb * 256 + hq * 64) * 2, 512, 16 * 512, 128, 8, 144, OW};
        segs[q][2] = ScanSeg{C.ws + WS_P + (rb * NP + 1536 + hq * 64) * 2, NP * 2, 16 * NP * 2, 128, 8, 144, OZ};
        segs[q][3] = ScanSeg{C.ws + WS_GD_KT + (size_t)bq * 128 * 2048, 0, 2048, 128, 0, 0, OKT};
        segs[q][4] = ScanSeg{C.ws + WS_GD_UT + (size_t)bq * 128 * 2048, 0, 2048, 128, 0, 0, OUT};
        segs[q][5] = ScanSeg{C.ws + WS_GD_AQ + (size_t)bq * 128 * 512, 0, 512, 32, 0, 0, OAQ};
    }
    ScanCopy cp; scan_copy_init(cp, segs, C.tid);
    LAS unsigned char* lds = C.lds; LAS float* xs = (LAS float*)(lds + SCAN_XS);
    f32x4 S[4];
#pragma unroll
    for (int i = 0; i < 4; ++i) S[i] = (f32x4){0.f, 0.f, 0.f, 0.f};
    const f32x4 gn = *(const f32x4*)(gain + 16 * et + 4 * g);
    const size_t rowb = (size_t)b * SEQ;
    v4u R[4][3]; float abr[4];
    scan_copy_load(cp, R[0], 0); scan_copy_store(cp, R[0], lds);
    scan_copy_load(cp, R[1], 1); scan_copy_load(cp, R[2], 2); scan_copy_load(cp, R[3], 3); scan_copy_load(cp, R[0], 4);
#pragma unroll
    for (int u = 0; u < 4; ++u) abr[u] = Abg[u];
    __syncthreads();
#pragma unroll 1
    for (int blk0 = 0; blk0 < 128; blk0 += 4) {
#pragma unroll
        for (int u = 0; u < 4; ++u) {
            const int blk = blk0 + u;
            scan_copy_store(cp, R[(u + 1) & 3], lds + ((blk + 1) & 1) * SCAN_BUF);
            scan_copy_load(cp, R[(u + 1) & 3], blk + 5 < 128 ? blk + 5 : 127);
            const float ab = abr[u]; abr[u] = Abg[blk + 4 < 128 ? blk + 4 : 127];
            const LAS unsigned char* base = lds + (blk & 1) * SCAN_BUF + bhl * SCAN_BH_LDS;
            s16x4 qf[4], wf[4], ktf[4];
#pragma unroll
            for (int i = 0; i < 4; ++i) { qf[i] = *(const LAS s16x4*)(base + OQ + n * 144 + (16 * i + 4 * g) * 2); wf[i] = *(const LAS s16x4*)(base + OW + n * 144 + (16 * i + 4 * g) * 2);
                ktf[i] = *(const LAS s16x4*)(base + OKT + ((16 * i + n) * 16 + 4 * g) * 2); }
            const s16x4 utf = *(const LAS s16x4*)(base + OUT + ((16 * et + n) * 16 + 4 * g) * 2), zf = *(const LAS s16x4*)(base + OZ + n * 144 + (16 * et + 4 * g) * 2);
            const s16x4 aqf = *(const LAS s16x4*)(base + OAQ + (n * 16 + 4 * g) * 2);
            s16x4 Sb[4];
#pragma unroll
            for (int i = 0; i < 4; ++i) Sb[i] = cvt4(S[i]);
            f32x4 acc = (f32x4){0.f, 0.f, 0.f, 0.f};
#pragma unroll
            for (int i = 0; i < 4; ++i) acc = mfma16(wf[i], Sb[i], acc);
            const v2u uw = __builtin_bit_cast(v2u, utf);
            f32x4 vn; vn.x = bf2f(uw.x & 0xffffu) - acc.x; vn.y = bf2f(uw.x >> 16) - acc.y; vn.z = bf2f(uw.y & 0xffffu) - acc.z; vn.w = bf2f(uw.y >> 16) - acc.w;
            const s16x4 vb = cvt4(vn);
            f32x4 oT = mfma16(vb, aqf, (f32x4){0.f, 0.f, 0.f, 0.f});
#pragma unroll
            for (int i = 0; i < 4; ++i) oT = mfma16(Sb[i], qf[i], oT);
#pragma unroll
            for (int i = 0; i < 4; ++i) S[i] = mfma16(ktf[i], vb, S[i] * ab);
            float ss = (oT.x * oT.x + oT.y * oT.y) + (oT.z * oT.z + oT.w * oT.w);
            ss = xsum32(xsum16(ss));
            LAS float* xp = xs + (blk & 1) * 128 + bhl * 64;
            if (g == 0) xp[et * 16 + n] = ss;
            __syncthreads();
            ss = (xp[n] + xp[16 + n]) + (xp[32 + n] + xp[48 + n]);
            const float r = rsqf_(ss * (1.0f / 64.0f) + RMS_EPS);
            { const v2u zw = __builtin_bit_cast(v2u, zf);
              const float z0 = bf2f(zw.x & 0xffffu), z1 = bf2f(zw.x >> 16), z2 = bf2f(zw.y & 0xffffu), z3 = bf2f(zw.y >> 16);
              v2u w; w.x = pk2(oT.x * r * gn.x * siluf_(z0), oT.y * r * gn.y * siluf_(z1)); w.y = pk2(oT.z * r * gn.z * siluf_(z2), oT.w * r * gn.w * siluf_(z3));
              *(v2u*)(O + (rowb + blk * 16 + n) * DM + 256 + h * 64 + 16 * et + 4 * g) = w; }
        }
    }
    __syncthreads();
}
typedef short bf16x8 __attribute__((ext_vector_type(8)));
constexpr size_t WS_FVT = 484 * MiB;
constexpr int FOX_KP = 72, FOX_BUF = 64 * FOX_KP * 2 * 2 + 256;
__device__ __forceinline__ void fox_vt_item(Ctx& C, int item) {
    const int lane = C.lane, bh = item >> 7, blk = item & 127, b = bh >> 2, h = bh & 3;
    const bf16* vp = (const bf16*)(C.ws + WS_P) + ((size_t)b * SEQ + blk * 16) * NP + 512 + h * 64 + lane; unsigned w[8];
#pragma unroll
    for (int t = 0; t < 16; t += 2) w[t >> 1] = (unsigned)vp[(size_t)t * NP] | ((unsigned)vp[(size_t)(t + 1) * NP] << 16);
    v4u* o = (v4u*)((bf16*)(C.ws + WS_FVT) + ((size_t)item * 64 + lane) * 16); o[0] = (v4u){w[0], w[1], w[2], w[3]}; o[1] = (v4u){w[4], w[5], w[6], w[7]};
}
__device__ __forceinline__ void fox_vt_pair(Ctx& C, int itemA, int itemB) {
    const int lane = C.lane; unsigned w[2][8];
#pragma unroll
    for (int q = 0; q < 2; ++q) { const int item = q ? itemB : itemA, bh = item >> 7, blk = item & 127, b = bh >> 2, h = bh & 3;
        const bf16* vp = (const bf16*)(C.ws + WS_P) + ((size_t)b * SEQ + blk * 16) * NP + 512 + h * 64 + lane;
#pragma unroll
        for (int t = 0; t < 16; t += 2) w[q][t >> 1] = (unsigned)vp[(size_t)t * NP] | ((unsigned)vp[(size_t)(t + 1) * NP] << 16); }
#pragma unroll
    for (int q = 0; q < 2; ++q) { const int item = q ? itemB : itemA;
        v4u* o = (v4u*)((bf16*)(C.ws + WS_FVT) + ((size_t)item * 64 + lane) * 16); o[0] = (v4u){w[q][0], w[q][1], w[q][2], w[q][3]}; o[1] = (v4u){w[q][4], w[q][5], w[q][6], w[q][7]}; }
}
__device__ __forceinline__ void fox_unit(Ctx& C, int l, int bh, int qb) {
    const int tid = C.tid, lane = C.lane, wave = C.wave, n = lane & 15, g = lane >> 4, b = bh >> 2, h = bh & 3;
    const bf16* P = (const bf16*)(C.ws + WS_P); const float* CF = (const float*)(C.ws + WS_CF) + (size_t)bh * SEQ; bf16* O = (bf16*)(C.ws + WS_O);
    const bf16* Vtf = (const bf16*)(C.ws + WS_FVT) + (size_t)bh * 128 * 1024;
    const size_t rowb = (size_t)b * SEQ;
    const int q0 = qb * 256 + wave * 32;
    bf16x8 qf[2][2]; float ct[2];
#pragma unroll
    for (int qs = 0; qs < 2; ++qs) { ct[qs] = CF[q0 + 16 * qs + n];
#pragma unroll
        for (int ks = 0; ks < 2; ++ks) qf[qs][ks] = *(const bf16x8*)(P + (rowb + q0 + 16 * qs + n) * NP + h * 64 + 32 * ks + 8 * g); }
    f32x4 OT[2][4];
#pragma unroll
    for (int qs = 0; qs < 2; ++qs)
#pragma unroll
        for (int dt = 0; dt < 4; ++dt) OT[qs][dt] = (f32x4){0.f, 0.f, 0.f, 0.f};
    float mx[2] = {-INFINITY, -INFINITY}, lsum[2] = {0.f, 0.f};
    const int ntiles = 4 * (qb + 1);
    const int kkey = tid >> 3, kch = tid & 7, vb4 = tid >> 7, vd = (tid >> 1) & 63, vh = tid & 1;
    const bf16* kptr = P + (rowb + kkey) * NP + 256 + h * 64 + 8 * kch;
    const bf16* vptr = Vtf + ((size_t)vb4 * 64 + vd) * 16 + 8 * vh;
    const int kw = kkey * FOX_KP + 8 * kch, vw = 64 * FOX_KP + vd * FOX_KP + 16 * vb4 + 8 * vh;
    LAS unsigned char* lds = C.lds;
    v4u kr[2], vr[2]; float cr[2];
#define FOX_LOAD(set, t) do { const int t_ = (t) < ntiles ? (t) : ntiles - 1; kr[set] = *(const v4u*)(kptr + (size_t)t_ * 64 * NP); vr[set] = *(const v4u*)(vptr + (size_t)t_ * 4 * 1024); cr[set] = CF[t_ * 64 + (tid & 63)]; } while (0)
#define FOX_STORE(set, buf) do { *(LAS v4u*)((LAS bf16*)(buf) + kw) = kr[set]; *(LAS v4u*)((LAS bf16*)(buf) + vw) = vr[set]; if (tid < 64) ((LAS float*)((buf) + 64 * FOX_KP * 4))[tid] = cr[set]; } while (0)
    FOX_LOAD(0, 0); FOX_STORE(0, lds);
    FOX_LOAD(1, 1); FOX_LOAD(0, 2);
    __syncthreads();
#pragma unroll 1
    for (int kt0 = 0; kt0 < ntiles; kt0 += 2) {
#pragma unroll
      for (int u = 0; u < 2; ++u) {
        const int kt = kt0 + u;
        LAS unsigned char* cur = lds + (kt & 1) * FOX_BUF; LAS unsigned char* nxt = lds + ((kt & 1) ^ 1) * FOX_BUF;
        FOX_STORE((u + 1) & 1, nxt);
        FOX_LOAD((u + 1) & 1, kt + 3);
        if (64 * kt <= q0 + 31) {
            const bool diag = 64 * kt + 63 > q0;
            const LAS bf16* Ks = (const LAS bf16*)cur; const LAS bf16* Vs = Ks + 64 * FOX_KP; const LAS float* Cs = (const LAS float*)(cur + 64 * FOX_KP * 4);
            bf16x8 kf[4][2]; f32x4 c4[4];
#pragma unroll
            for (int mt = 0; mt < 4; ++mt) { c4[mt] = *(const LAS f32x4*)(Cs + 16 * mt + 4 * g);
#pragma unroll
                for (int ks = 0; ks < 2; ++ks) kf[mt][ks] = *(const LAS bf16x8*)(Ks + (16 * mt + n) * FOX_KP + 32 * ks + 8 * g); }
            __builtin_amdgcn_sched_barrier(0);
            f32x4 sv[2][4];
#pragma unroll
            for (int qs = 0; qs < 2; ++qs)
#pragma unroll
                for (int mt = 0; mt < 4; ++mt) {
                    f32x4 a = (f32x4){0.f, 0.f, 0.f, 0.f};
#pragma unroll
                    for (int ks = 0; ks < 2; ++ks) a = __builtin_amdgcn_mfma_f32_16x16x32_bf16(kf[mt][ks], qf[qs][ks], a, 0, 0, 0);
                    sv[qs][mt] = a;
                }
            s16x4 pb[2][4]; float corr[2];
#pragma unroll
            for (int qs = 0; qs < 2; ++qs) {
                float mloc = -INFINITY;
#pragma unroll
                for (int mt = 0; mt < 4; ++mt) { sv[qs][mt] = sv[qs][mt] + (ct[qs] - c4[mt]);
                    if (diag) {
#pragma unroll
                        for (int j = 0; j < 4; ++j) if (64 * kt + 16 * mt + 4 * g + j > q0 + 16 * qs + n) sv[qs][mt][j] = -INFINITY; }
                    mloc = fmaxf(fmaxf(mloc, fmaxf(sv[qs][mt][0], sv[qs][mt][1])), fmaxf(sv[qs][mt][2], sv[qs][mt][3])); }
                mloc = xmax32(xmax16(mloc));
                const float mn = fmaxf(mx[qs], mloc); corr[qs] = __builtin_amdgcn_exp2f(mx[qs] - mn);
                mx[qs] = mn; lsum[qs] *= corr[qs];
#pragma unroll
                for (int mt = 0; mt < 4; ++mt) { f32x4 p;
#pragma unroll
                    for (int j = 0; j < 4; ++j) { p[j] = __builtin_amdgcn_exp2f(sv[qs][mt][j] - mn); lsum[qs] += p[j]; }
                    pb[qs][mt] = cvt4(p); }
            }
#pragma unroll
            for (int dt = 0; dt < 4; ++dt) {
                bf16x8 vf2[2];
#pragma unroll
                for (int a = 0; a < 2; ++a) { const s16x4 lo = *(const LAS s16x4*)(Vs + (16 * dt + n) * FOX_KP + 32 * a + 4 * g), hi = *(const LAS s16x4*)(Vs + (16 * dt + n) * FOX_KP + 32 * a + 16 + 4 * g);
                    vf2[a] = (bf16x8){lo[0], lo[1], lo[2], lo[3], hi[0], hi[1], hi[2], hi[3]}; }
#pragma unroll
                for (int qs = 0; qs < 2; ++qs) { OT[qs][dt] = OT[qs][dt] * corr[qs];
#pragma unroll
                    for (int a = 0; a < 2; ++a) { const s16x4 lo = pb[qs][2 * a], hi = pb[qs][2 * a + 1];
                        OT[qs][dt] = __builtin_amdgcn_mfma_f32_16x16x32_bf16(vf2[a], (bf16x8){lo[0], lo[1], lo[2], lo[3], hi[0], hi[1], hi[2], hi[3]}, OT[qs][dt], 0, 0, 0); } }
            }
        }
        __syncthreads();
      }
    }
#undef FOX_LOAD
#undef FOX_STORE
    const float* on_g = C.ka->in[6] + l * 64;
#pragma unroll
    for (int qs = 0; qs < 2; ++qs) {
        float ls = xsum32(xsum16(lsum[qs]));
        const float inv = rcpf_(ls); float ss = 0.f;
#pragma unroll
        for (int dt = 0; dt < 4; ++dt) { OT[qs][dt] = OT[qs][dt] * inv; ss += (OT[qs][dt].x * OT[qs][dt].x + OT[qs][dt].y * OT[qs][dt].y) + (OT[qs][dt].z * OT[qs][dt].z + OT[qs][dt].w * OT[qs][dt].w); }
        ss = xsum32(xsum16(ss));
        const float r = rsqf_(ss * (1.0f / 64.0f) + RMS_EPS);
#pragma unroll
        for (int dt = 0; dt < 4; ++dt) { const f32x4 gg = *(const f32x4*)(on_g + 16 * dt + 4 * g);
            v2u w; w.x = pk2(OT[qs][dt].x * r * gg.x, OT[qs][dt].y * r * gg.y); w.y = pk2(OT[qs][dt].z * r * gg.z, OT[qs][dt].w * r * gg.w);
            *(v2u*)(O + (rowb + q0 + 16 * qs + n) * DM + h * 64 + 16 * dt + 4 * g) = w; }
    }
}
#ifdef PROBE_TS
#define SUBTS(i) do { if (blockIdx.x == PROBE_BLK && threadIdx.x == 0 && l == 0) ((volatile LAS unsigned long long*)(C.lds + LDS_BYTES - 512))[16 + (i)] = __builtin_amdgcn_s_memrealtime(); } while (0)
#else
#define SUBTS(i) do { } while (0)
#endif
constexpr int SCAN_BLOCKS = 96;
__device__ __forceinline__ void m1_mixers(Ctx& C, int l) {
    const int bx = (int)blockIdx.x;
    SUBTS(6);
#ifdef PROBE_FOXW
    if (blockIdx.x == PROBE_BLK && threadIdx.x == 0 && l == 0) { volatile LAS unsigned long long* t_ = (volatile LAS unsigned long long*)(C.lds + LDS_BYTES - 512); t_[25] = 0; t_[26] = 0; }
#endif
    if (bx < SCAN_BLOCKS) {
        if (bx < 32) gdn_scan(C, l, 2 * bx);
        else if (bx < 64) lin_scan<0>(C, l, 2 * (bx - 32));
        else lin_scan<1>(C, l, 2 * (bx - 64));
        SUBTS(7);
#ifdef DUP_SCAN
        __syncthreads();
        if (bx < 32) gdn_scan(C, l, 2 * bx);
        else if (bx < 64) lin_scan<0>(C, l, 2 * (bx - 32));
        else lin_scan<1>(C, l, 2 * (bx - 64));
#endif
    } else {
        const int G2 = (int)gridDim.x - SCAN_BLOCKS, j = (int)blockIdx.x - SCAN_BLOCKS;
        for (int r = 0; r * G2 < 512; ++r) { const int u = r * G2 + ((r & 1) ? (G2 - 1 - j) : j); if (u < 512) fox_unit(C, l, u & 63, 7 - (u >> 6)); }
        SUBTS(7);
#ifdef DUP_FOX
        for (int r = 0; r * G2 < 512; ++r) { const int u = r * G2 + ((r & 1) ? (G2 - 1 - j) : j); if (u < 512) fox_unit(C, l, u & 63, 7 - (u >> 6)); }
#endif
    }
}

__device__ __forceinline__ void cv_fixup(Ctx& C, int l) {
    const float* H = (const float*)(C.ws + WS_HALO); bf16* ACT = (bf16*)(C.ws + WS_ACT);
    const float* cw = C.ka->in[19] + (size_t)l * 3 * NUP; const float* cb = C.ka->in[20] + (size_t)l * NUP;
    for (int i = blockIdx.x * NTHREADS + C.tid; i < 128 * 22 * 2 * 128; i += gridDim.x * NTHREADS) {
        const int j = i & 127, rr = (i >> 7) & 1, t = i >> 8, pn = t % 22, pm = t / 22;
        if ((pm & 7) == 0) continue;
        const float* h0 = H + (size_t)(pm * 22 + pn) * 1024; const float* hp = H + (size_t)((pm - 1) * 22 + pn) * 1024;
        float uo[2];
#pragma unroll
        for (int bj = 0; bj < 2; ++bj) { const int c = bj * 128 + j, col = bj * DFF + pn * 128 + j;
            const float y0 = h0[rr * 256 + c], y1 = rr == 0 ? hp[3 * 256 + c] : h0[c], y2 = rr == 0 ? hp[2 * 256 + c] : hp[3 * 256 + c];
            uo[bj] = cw[col] * y2 + cw[NUP + col] * y1 + cw[2 * NUP + col] * y0 + cb[col]; }
        ACT[(size_t)(pm * 256 + rr) * DFF + pn * 128 + j] = (bf16)f2bf(siluf_(uo[0]) * uo[1]);
    }
}

struct Args { const float* in[22]; float* out; unsigned char* ws; };
__global__ void __launch_bounds__(NTHREADS, 2) fwd_megakernel(Args args) {
    extern __shared__ __attribute__((aligned(16))) unsigned char lds_raw[];
    cg::grid_group grid = cg::this_grid();
    Ctx C;
    C.ka = (const CAS KArgs*)__builtin_amdgcn_kernarg_segment_ptr();
    C.out = args.out; C.ws = args.ws;
    C.lds = (LAS unsigned char*)lds_raw;
    C.tid = threadIdx.x; C.lane = C.tid & 63; C.wave = __builtin_amdgcn_readfirstlane(C.tid >> 6);
    C.gw = blockIdx.x * NWAVES + C.wave; C.ngw = gridDim.x * NWAVES;
    const int G = gridDim.x;
    volatile LAS unsigned* bst = (volatile LAS unsigned*)(C.lds + LDS_BYTES - 16);
    if (threadIdx.x < 4) bst[threadIdx.x] = 0u;
    __syncthreads();
    const XcdBarrier xbar = xcd_barrier_post((unsigned*)(args.ws + WS_BAR), bst);
#ifdef PROBE_TS
    volatile LAS unsigned long long* tsl = (volatile LAS unsigned long long*)(C.lds + LDS_BYTES - 512); int nts = 0;
#define GRID_SYNC() do { xcd_barrier(xbar); if (blockIdx.x == PROBE_BLK && threadIdx.x == 0) tsl[nts] = __builtin_amdgcn_s_memrealtime(); ++nts; } while (0)
#else
#define GRID_SYNC() xcd_barrier(xbar)
#endif
    unsigned char* const ws0 = args.ws; float* const out0 = args.out;
#define PHASE_BEGIN() do { size_t z_ = 0; const CAS KArgs* k_ = (const CAS KArgs*)__builtin_amdgcn_kernarg_segment_ptr(); int t_ = threadIdx.x; asm volatile("" : "+s"(z_), "+s"(k_), "+v"(t_)); \
        unsigned char* w_ = ws0 + z_; float* o_ = out0 + z_;     \
        C.ws = w_; C.out = o_; C.ka = k_; C.tid = t_; C.lane = t_ & 63; C.wave = __builtin_amdgcn_readfirstlane(t_ >> 6); C.gw = blockIdx.x * NWAVES + C.wave; ss = (float*)(w_ + WS_SS); XB = (bf16*)(w_ + WS_XB); } while (0)
    float* ss; bf16* XB;

#ifdef PROBE_TS
    if (blockIdx.x == PROBE_BLK && threadIdx.x == 0) tsl[15] = __builtin_amdgcn_s_memrealtime();
#endif
#ifndef NO_P0
    p0_prologue(C);
#ifdef DUP_P0
    grid.sync(); p0_prologue(C);
#endif
#endif
    GRID_SYNC();
    if (gridDim.x > 65536u) grid.sync();
    for (int l = 0; l < DEPTH; ++l) {
        PHASE_BEGIN();
        {
            pg8::Gemm g{XB, (const bf16*)(C.ws + WS_W1T) + (size_t)l * N1 * DM, MTOK, N1, DM}; pg8::StaticOrder S; S.init(MTOK, N1, G, (int)blockIdx.x);
            pg8::EpiP E{(bf16*)(C.ws + WS_P), (float*)(C.ws + WS_PS), ss + (size_t)l * MTOK, (float*)(C.ws + WS_FF), C.ka->in[3] + l * 64, C.ka->in[4] + l * 64, (bf16*)(C.ws + WS_FVT)};
#ifndef NO_G1
            pg8::gemm_phase<pg8::EpiP, pg8::StaticOrder, true, true>(C.lds, g, S, E);
#ifdef DUP_G1
            GRID_SYNC(); pg8::gemm_phase<pg8::EpiP, pg8::StaticOrder, true, true>(C.lds, g, S, E);
#endif
#endif
        }
        GRID_SYNC();
        PHASE_BEGIN();
        SUBTS(0);
#ifndef NO_M0
        m0_prep(C, l);
#endif
        SUBTS(1);
        for (int it = C.gw; it < 4096; it += C.ngw) { GdnRaw ga, gb; gdn_stage1_load(C, it, ga); gdn_stage1_load(C, it + 4096, gb);
            gdn_stage1_finish(C, l, it, ga, C.lds + C.wave * 20480); gdn_stage1_finish(C, l, it + 4096, gb, C.lds + C.wave * 20480); }
        SUBTS(2);
        for (int it = C.gw; it < 4096; it += C.ngw) lin_stage1_pair<0>(C, l, it, it + 4096, C.lds + C.wave * 20480);
        SUBTS(3);
        { GlaW gw_; gla_w_load(C, l, (C.gw >> 7) & 3, gw_);
          for (int it = C.gw; it < 4096; it += C.ngw) gla_stage1_pair(C, it, it + 4096, gw_); }
        SUBTS(4);
        SUBTS(5);
#ifdef DUP_GDN1
        { GdnRaw ga, gb; int it = C.gw;
          if (it < 8192) gdn_stage1_load(C, it, ga);
          for (; it < 8192; it += 2 * C.ngw) {
              if (it + C.ngw < 8192) gdn_stage1_load(C, it + C.ngw, gb);
              gdn_stage1_finish(C, l, it, ga, C.lds + C.wave * 20480);
              if (it + C.ngw < 8192) { if (it + 2 * C.ngw < 8192) gdn_stage1_load(C, it + 2 * C.ngw, ga); gdn_stage1_finish(C, l, it + C.ngw, gb, C.lds + C.wave * 20480); }
          } }
#endif
#ifdef DUP_FVT
        for (int r_ = 0; r_ < 4; ++r_) for (int it = C.gw; it < 8192; it += C.ngw) fox_vt_item(C, it);
#endif
        GRID_SYNC();
        PHASE_BEGIN();
#ifndef NO_M1
        m1_mixers(C, l);
#ifdef DUP_M1
        GRID_SYNC(); m1_mixers(C, l);
#endif
#endif
        GRID_SYNC();
        PHASE_BEGIN();
        {
            pg8::Gemm g{(const bf16*)(C.ws + WS_O), (const bf16*)(C.ws + WS_WOT) + (size_t)l * DM * DM, MTOK, DM, DM}; pg8::StaticOrder S; S.init(MTOK, DM, G, (int)blockIdx.x);
            pg8::EpiRes<false> E{XB, nullptr, ss + (size_t)(2 + l) * MTOK};
#ifndef NO_G2
            pg8::gemm_phase<pg8::EpiRes<false>, pg8::StaticOrder, true, true>(C.lds, g, S, E);
#ifdef DUP_G2P
            { GRID_SYNC(); pg8::EpiRes<false> E2{XB, nullptr, (float*)(C.ws + WS_HALO), (bf16*)(C.ws + WS_P)}; pg8::gemm_phase<pg8::EpiRes<false>, pg8::StaticOrder, true, true>(C.lds, g, S, E2); }
#endif
#ifdef DUP_G2_OLD
            if (l == 0) { GRID_SYNC(); pg8::EpiRes E2{C.ka->in[0], C.out, XB, (float*)(C.ws + WS_HALO)}; pg8::gemm_phase<pg8::EpiRes, pg8::StaticOrder, true, true>(C.lds, g, S, E2); }
#endif
#endif
        }
        GRID_SYNC();
        PHASE_BEGIN();
        {
            pg8::Gemm g{XB, (const bf16*)(C.ws + WS_WUT) + (size_t)l * NUP * DM, MTOK, NUP, DM}; pg8::StaticOrder S; S.init(MTOK, NUP, G, (int)blockIdx.x);
            pg8::EpiConv E{(bf16*)(C.ws + WS_ACT), (float*)(C.ws + WS_HALO), ss + (size_t)(2 + l) * MTOK, C.ka->in[19] + (size_t)l * 3 * NUP, C.ka->in[20] + (size_t)l * NUP, (LAS float*)(C.lds + 131072)};
#ifndef NO_G3
            pg8::gemm_phase<pg8::EpiConv, pg8::StaticOrder, true, true>(C.lds, g, S, E);
#ifdef DUP_G3
            GRID_SYNC(); pg8::gemm_phase<pg8::EpiConv, pg8::StaticOrder, true, true>(C.lds, g, S, E);
#endif
#endif
        }
        GRID_SYNC();
        PHASE_BEGIN();
        cv_fixup(C, l);
#ifdef DUP_FIX
        GRID_SYNC(); cv_fixup(C, l);
#endif
#ifdef DUP_SYNC
        for (int q = 0; q < 10; ++q) GRID_SYNC();
#endif
        GRID_SYNC();
        PHASE_BEGIN();
        {
            pg8::Gemm g{(const bf16*)(C.ws + WS_ACT), (const bf16*)(C.ws + WS_WDT) + (size_t)l * DM * DFF, MTOK, DM, DFF}; pg8::StaticOrder S; S.init(MTOK, DM, G, (int)blockIdx.x);
            if (l + 1 < DEPTH) { pg8::EpiRes<false> E{XB, nullptr, ss + (size_t)(l + 1) * MTOK};
#ifdef DUP_G4P
                { pg8::EpiRes<false> E2{XB, nullptr, (float*)(C.ws + WS_HALO), (bf16*)(C.ws + WS_P)}; pg8::gemm_phase<pg8::EpiRes<false>, pg8::StaticOrder, true, true>(C.lds, g, S, E2); GRID_SYNC(); }
#endif
                pg8::gemm_phase<pg8::EpiRes<false>, pg8::StaticOrder, true, true>(C.lds, g, S, E);
            } else { pg8::EpiRes<true> E{XB, C.out, nullptr};
                pg8::gemm_phase<pg8::EpiRes<true>, pg8::StaticOrder, true, true>(C.lds, g, S, E); }
        }
        GRID_SYNC();
    }
#ifdef PROBE_TS
    if (blockIdx.x == PROBE_BLK && threadIdx.x == 0) {
        const unsigned long long d = tsl[PROBE_B] - tsl[PROBE_A], t0 = __builtin_amdgcn_s_memrealtime();
        while (__builtin_amdgcn_s_memrealtime() - t0 < 8ull * d) __builtin_amdgcn_s_sleep(16);
    }
#endif
}

extern "C" void kernel_launch(void* const* d_in, const int* in_sizes, int n_in, void* d_out, int out_size, void* d_ws, size_t ws_size, hipStream_t stream) {
    static int grid = 0;
    if (grid == 0) {
        if (n_in != 22 || in_sizes[0] != MTOK * DM || out_size != MTOK * DM || ws_size < WS_END) {
            fprintf(stderr, "kernel_launch: unexpected problem (n_in %d, in0 %d, out %d, ws %zu < %zu)\n", n_in, n_in > 0 ? in_sizes[0] : -1, out_size, ws_size, (size_t)WS_END); grid = -1; return; }
        int dev = 0, cus = 0, per_cu = 0;
        (void)hipGetDevice(&dev); (void)hipDeviceGetAttribute(&cus, hipDeviceAttributeMultiprocessorCount, dev);
        if (hipFuncSetAttribute((const void*)fwd_megakernel, hipFuncAttributeMaxDynamicSharedMemorySize, LDS_BYTES) != hipSuccess) { fprintf(stderr, "kernel_launch: hipFuncSetAttribute failed\n"); grid = -1; return; }
        if (hipOccupancyMaxActiveBlocksPerMultiprocessor(&per_cu, (const void*)fwd_megakernel, NTHREADS, LDS_BYTES) != hipSuccess || per_cu < 1) { fprintf(stderr, "kernel_launch: occupancy query says %d blocks per CU\n", per_cu); per_cu = 1; }
        (void)hipGetLastError();
        grid = cus;
    }
    if (grid < 0) return;
    if (hipMemsetAsync((char*)d_ws + WS_BAR, 0, 16384, stream) != hipSuccess) { fprintf(stderr, "kernel_launch: memset of the barrier words failed\n"); return; }
    Args a{};
    for (int i = 0; i < 22; ++i) a.in[i] = (const float*)d_in[i];
    a.out = (float*)d_out; a.ws = (unsigned char*)d_ws;
    void* kargs[] = {&a};
    hipError_t e = hipLaunchCooperativeKernel((const void*)fwd_megakernel, dim3(grid), dim3(NTHREADS), kargs, LDS_BYTES, stream);
    if (e != hipSuccess) fprintf(stderr, "kernel_launch: cooperative launch failed: %s (grid %d)\n", hipGetErrorString(e), grid);
}
```

```cpp
#include <hip/hip_runtime.h>
#include <hip/hip_cooperative_groups.h>
#include <cstdio>
#include <cstdint>
namespace cg = cooperative_groups;
constexpr float RMS_EPS = 1e-6f;

namespace pg8 {
#define PG8_LAS __attribute__((address_space(3)))
typedef unsigned short bf16_t;
typedef short bf16x8 __attribute__((ext_vector_type(8)));
typedef float f32x4 __attribute__((ext_vector_type(4)));
typedef unsigned u32x4 __attribute__((ext_vector_type(4)));
constexpr int BM = 256, BK = 64, HALF = 128, HTB = HALF * BK * 2  , STAGE_BYTES = 8 * HTB, NXCD = 8, WGM = 8;

__host__ __device__ __forceinline__ int lds_byte(int r, int c) { const int st = (r >> 4) * 2 + (c >> 5), rr = r & 15, cc = c & 31, ob = rr * 64 + cc * 2; return st * 1024 + (ob ^ (((ob >> 9) & 1) << 5)); }
__host__ __device__ __forceinline__ void stage_rc(int b, int& R, int& C) { const int st = b / 1024, sb = b % 1024, swz = sb ^ (((sb >> 9) & 1) << 5); R = (st >> 1) * 16 + swz / 64; C = (st & 1) * 32 + (swz % 64) / 2; }
__host__ __device__ __forceinline__ int perm32(int rho) { const int n = rho >> 4, i = rho & 15; return 8 * (i >> 2) + 4 * n + (i & 3); }

struct Unit { int pm, pn; };
struct Gemm { const bf16_t* A; const bf16_t* Bt; int M, N, K; };

struct StaticOrder {
    int nM, nN, nwg, G, c;
    __host__ __device__ void init(int M, int N, int G_, int c_) { nM = M / BM; nN = N / BM; nwg = nM * nN; G = G_; c = c_; }
    __host__ __device__ bool next(int i, Unit& u) const {
        const long L = (long)i * G + c; if (L >= nwg) return false;
        int wgid = (int)L; { const int q = nwg / NXCD, r = nwg % NXCD, xcd = wgid % NXCD, off = wgid / NXCD; wgid = (xcd < r ? xcd * (q + 1) : r * (q + 1) + (xcd - r) * q) + off; }
        const int nig = WGM * nN, gid = wgid / nig, fm = gid * WGM, gsz = (nM - fm) < WGM ? (nM - fm) : WGM;
        u.pm = fm + ((wgid % nig) % gsz); u.pn = (wgid % nig) / gsz; return true;
    }
    __device__ __forceinline__ void a_ready(const Unit&) const {}
    __device__ __forceinline__ void done(const Unit&) const {}
};
__device__ __forceinline__ unsigned cvt_pk_bf16(float lo, float hi) { unsigned r; asm volatile("v_cvt_pk_bf16_f32 %0, %1, %2" : "=v"(r) : "v"(lo), "v"(hi)); return r; }
typedef float f32x2 __attribute__((ext_vector_type(2)));

typedef unsigned u32x2 __attribute__((ext_vector_type(2)));
struct EpiP {
    static constexpr bool PERM = true, AFTER_DRAIN = false, PROBE_DUP = true;
    bf16_t* P; float* PS; const float* ss; float* FF; const float* qg; const float* kg; bf16_t* FVT; bf16_t* VTH; bf16_t* VTG;
    __device__ __forceinline__ void operator()(const f32x4 (&acc)[2][2][4][2], const Unit& u, int wr, int wc, int fr, int fq) const {
        const int row0 = u.pm * BM + wr * 64 + fr;
        float rs[2][4];
#pragma unroll
        for (int ai = 0; ai < 2; ++ai)
#pragma unroll
            for (int m = 0; m < 4; ++m) rs[ai][m] = ss[row0 + ai * HALF + m * 16];
#pragma unroll
        for (int ai = 0; ai < 2; ++ai)
#pragma unroll
            for (int m = 0; m < 4; ++m) {
                const int row = row0 + ai * HALF + m * 16;
                const float rstd = __builtin_amdgcn_rsqf(rs[ai][m] * (1.0f / 1024.0f) + RMS_EPS);
                if (u.pn < 2) {
                    const float* gp = u.pn == 0 ? qg : kg;
                    f32x4 p[2][2]; float sq = 0.f;
#pragma unroll
                    for (int bj = 0; bj < 2; ++bj)
#pragma unroll
                        for (int n = 0; n < 2; ++n) { p[bj][n] = acc[ai][bj][m][n] * rstd; sq += (p[bj][n][0] * p[bj][n][0] + p[bj][n][1] * p[bj][n][1]) + (p[bj][n][2] * p[bj][n][2] + p[bj][n][3] * p[bj][n][3]); }
                    sq += __shfl_xor(sq, 16); sq += __shfl_xor(sq, 32);
                                        const float r = __builtin_amdgcn_rsqf(sq * (1.0f / 64.0f) + RMS_EPS) * (u.pn == 0 ? 0.18033688011112042f : 1.0f);
                    bf16_t* rowp = P + (size_t)row * 3584 + u.pn * BM + wc * 64 + 8 * fq;
#pragma unroll
                    for (int bj = 0; bj < 2; ++bj) { const f32x4 g0 = *(const f32x4*)(gp + 32 * bj + 8 * fq), g1 = *(const f32x4*)(gp + 32 * bj + 8 * fq + 4);
                                                const f32x4 v0 = p[bj][0] * g0 * r, v1 = p[bj][1] * g1 * r;
                        u32x4 w; w.x = cvt_pk_bf16(v0[0], v0[1]); w.y = cvt_pk_bf16(v0[2], v0[3]); w.z = cvt_pk_bf16(v1[0], v1[1]); w.w = cvt_pk_bf16(v1[2], v1[3]);
                        *(u32x4*)(rowp + 32 * bj) = w; }
                } else if (u.pn == 2 || u.pn == 9 || u.pn == 12) {
                    bf16_t* vp = (u.pn == 2 ? FVT : u.pn == 9 ? VTH : VTG) + (((size_t)(row >> 11) * 4 * 128 + ((row & 2047) >> 4)) * 64) * 16 + fr;
#pragma unroll
                    for (int bj = 0; bj < 2; ++bj)
#pragma unroll
                        for (int n = 0; n < 2; ++n) { const f32x4 v = acc[ai][bj][m][n] * rstd;
#pragma unroll
                            for (int k = 0; k < 4; ++k) { const int c = 128 * bj + 32 * wc + 8 * fq + 4 * n + k;
                                vp[((size_t)(c >> 6) * 128 * 64 + (c & 63)) * 16] = (bf16_t)(cvt_pk_bf16(v[k], 0.f) & 0xffffu); } }
                } else if (u.pn < 14) {
                    bf16_t* rowp = P + (size_t)row * 3584 + u.pn * BM + wc * 32 + 8 * fq;
#pragma unroll
                    for (int bj = 0; bj < 2; ++bj) { const f32x4 v0 = acc[ai][bj][m][0] * rstd, v1 = acc[ai][bj][m][1] * rstd;
                        u32x4 w; w.x = cvt_pk_bf16(v0[0], v0[1]); w.y = cvt_pk_bf16(v0[2], v0[3]); w.z = cvt_pk_bf16(v1[0], v1[1]); w.w = cvt_pk_bf16(v1[2], v1[3]);
                        __builtin_nontemporal_store(w, (u32x4*)(rowp + bj * HALF)); }
                } else if (wc == 0) {
                    float* rowp = PS + (size_t)row * 32 + 8 * fq;
                    const f32x4 v0 = acc[ai][0][m][0] * rstd;
                    *(f32x4*)(rowp) = v0; *(f32x4*)(rowp + 4) = acc[ai][0][m][1] * rstd;
                    if (fq == 0) { float* fp = FF + (size_t)(row >> 11) * 4 * 2048 + (row & 2047);
                        fp[0] = v0[0]; fp[2048] = v0[1]; fp[2 * 2048] = v0[2]; fp[3 * 2048] = v0[3]; }
                }
            }
    }
};
template <bool LAST> struct EpiRes {
    static constexpr bool PERM = false, AFTER_DRAIN = false, PROBE_DUP = false;
    bf16_t* xb; float* out; float* ssq; bf16_t* xbw = nullptr;
    __device__ __forceinline__ void operator()(const f32x4 (&acc)[2][2][4][2], const Unit& u, int wr, int wc, int fr, int fq) const {
        const int row0 = u.pm * BM + wr * 64 + fr, col0 = u.pn * BM + wc * 32 + 4 * fq;
        u32x2 bv[2][2][2][2];
#define EPR_LOADQ(q_) do { _Pragma("unroll") for (int mm = 0; mm < 2; ++mm) _Pragma("unroll") for (int bj = 0; bj < 2; ++bj) _Pragma("unroll") for (int n = 0; n < 2; ++n) \
            bv[(q_) & 1][mm][bj][n] = *(const u32x2*)(xb + (size_t)(row0 + ((q_) >> 1) * HALF + (2 * ((q_) & 1) + mm) * 16) * 1024 + col0 + bj * HALF + n * 16); } while (0)
        EPR_LOADQ(0); EPR_LOADQ(1);
#pragma unroll
        for (int q = 0; q < 4; ++q) {
            const int ai = q >> 1;
#pragma unroll
            for (int mm = 0; mm < 2; ++mm) {
                const int m = 2 * (q & 1) + mm;
                const int row = row0 + ai * HALF + m * 16; float s = 0.f;
#pragma unroll
                for (int bj = 0; bj < 2; ++bj)
#pragma unroll
                    for (int n = 0; n < 2; ++n) { const size_t off = (size_t)row * 1024 + col0 + bj * HALF + n * 16; const u32x2 b = bv[q & 1][mm][bj][n];
                        f32x4 o = acc[ai][bj][m][n];
                        o[0] += __uint_as_float(b.x << 16); o[1] += __uint_as_float(b.x & 0xffff0000u); o[2] += __uint_as_float(b.y << 16); o[3] += __uint_as_float(b.y & 0xffff0000u);
                        if (LAST) *(f32x4*)(out + off) = o;
                        else { s += (o[0] * o[0] + o[1] * o[1]) + (o[2] * o[2] + o[3] * o[3]);
                            u32x2 w; w.x = cvt_pk_bf16(o[0], o[1]); w.y = cvt_pk_bf16(o[2], o[3]); *(u32x2*)((xbw ? xbw : xb) + off) = w; } }
                if (!LAST) { s += __shfl_xor(s, 16); s += __shfl_xor(s, 32);
                    if (fq == 0) atomicAdd(ssq + row, s); }
            }
            if (q == 0) EPR_LOADQ(2);
            if (q == 1) EPR_LOADQ(3);
        }
#undef EPR_LOADQ
    }
};
struct EpiConv {
    static constexpr bool PERM = true, AFTER_DRAIN = false, PROBE_DUP = false;
    bf16_t* ACT; float* HALO; const float* ss; const float* cw; const float* cb; PG8_LAS float* xl;
    template <int CTRL> static __device__ __forceinline__ float dpp(float old, float src) {
        return __builtin_bit_cast(float, __builtin_amdgcn_update_dpp(__builtin_bit_cast(int, old), __builtin_bit_cast(int, src), CTRL, 0xf, 0xf, false)); }
    __device__ __forceinline__ void operator()(const f32x4 (&acc)[2][2][4][2], const Unit& u, int wr, int wc, int fr, int fq) const {
        const int row0 = u.pm * BM + wr * 64 + fr;
        float rs[2][4];
#pragma unroll
        for (int ai = 0; ai < 2; ++ai)
#pragma unroll
            for (int m = 0; m < 4; ++m) rs[ai][m] = __builtin_amdgcn_rsqf(ss[row0 + ai * HALF + m * 16] * (1.0f / 1024.0f) + RMS_EPS);
        const int colg = u.pn * HALF + wc * 32 + 8 * fq;
        f32x4 wn[1][2][3], bn[1][2];
#define EPC_LOADW(n_) do { _Pragma("unroll") for (int bj = 0; bj < 2; ++bj) { const int c = bj * 2816 + colg + 4 * (n_); bn[0][bj] = *(const f32x4*)(cb + c); \
            _Pragma("unroll") for (int j = 0; j < 3; ++j) wn[0][bj][j] = *(const f32x4*)(cw + j * 5632 + c); } } while (0)
        EPC_LOADW(0);
        if (fr >= 14) {
#pragma unroll
            for (int ai = 0; ai < 2; ++ai) { PG8_LAS float* xp = xl + ((((ai * 2 + wr) * 4 + wc) * 2 + (fr - 14)) * 64) + 8 * fq;
#pragma unroll
                for (int bj = 0; bj < 2; ++bj)
#pragma unroll
                    for (int n = 0; n < 2; ++n) *(PG8_LAS f32x4*)(xp + bj * 32 + 4 * n) = acc[ai][bj][3][n] * rs[ai][3]; }
            if (wr == 1) { float* hp = HALO + ((size_t)(u.pm * 22 + u.pn) * 4 + 2 + (fr - 14)) * 256 + wc * 32 + 8 * fq;
#pragma unroll
                for (int bj = 0; bj < 2; ++bj)
#pragma unroll
                    for (int n = 0; n < 2; ++n) *(f32x4*)(hp + bj * HALF + 4 * n) = acc[1][bj][3][n] * rs[1][3]; }
        }
        if (fr < 2 && wr == 0) { float* hp = HALO + ((size_t)(u.pm * 22 + u.pn) * 4 + fr) * 256 + wc * 32 + 8 * fq;
#pragma unroll
            for (int bj = 0; bj < 2; ++bj)
#pragma unroll
                for (int n = 0; n < 2; ++n) *(f32x4*)(hp + bj * HALF + 4 * n) = acc[0][bj][0][n] * rs[0][0]; }
        asm volatile("s_waitcnt lgkmcnt(0)" ::: "memory"); __builtin_amdgcn_s_barrier(); asm volatile("" ::: "memory");
        const bool seq_start = (u.pm & 7) == 0;
#ifdef DUP_EPC
        for (int rep_ = 0; rep_ < 2; ++rep_) { asm volatile("" ::: "memory"); EPC_LOADW(0);
#endif
#pragma unroll
        for (int n = 0; n < 2; ++n) {
            if (n == 1) EPC_LOADW(1);
            f32x4 (&w)[2][3] = wn[0]; f32x4 (&bb)[2] = bn[0];
#pragma unroll
            for (int ai = 0; ai < 2; ++ai) {
                f32x4 prev[2];
                f32x4 h1[2], h2[2];
                const int pg = ai * 2 + wr - 1;
#pragma unroll
                for (int bj = 0; bj < 2; ++bj) {
                    if (pg >= 0) { const PG8_LAS float* xp = xl + (((pg * 4 + wc) * 2) * 64) + 8 * fq + bj * 32 + 4 * n;
                        const f32x4 r14 = *(const PG8_LAS f32x4*)xp, r15 = *(const PG8_LAS f32x4*)(xp + 64); h1[bj] = r15; h2[bj] = fr == 0 ? r14 : r15; }
                    else { h1[bj] = (f32x4){0.f, 0.f, 0.f, 0.f}; h2[bj] = h1[bj]; }
                }
#pragma unroll
                for (int m = 0; m < 4; ++m) {
                    f32x4 cur[2], uo[2];
#pragma unroll
                    for (int bj = 0; bj < 2; ++bj) { cur[bj] = acc[ai][bj][m][n] * rs[ai][m];
#pragma unroll
                        for (int k = 0; k < 4; ++k) {
                            const float r1 = m == 0 ? h1[bj][k] : dpp<0x121>(0.f, prev[bj][k]), r2 = m == 0 ? h2[bj][k] : dpp<0x122>(0.f, prev[bj][k]);
                            const float t1 = dpp<0x111>(r1, cur[bj][k]), t2 = dpp<0x112>(r2, cur[bj][k]);
                            uo[bj][k] = w[bj][0][k] * t2 + w[bj][1][k] * t1 + w[bj][2][k] * cur[bj][k] + bb[bj][k]; }
                        prev[bj] = cur[bj]; }
                    f32x4 a;
#pragma unroll
                    for (int k = 0; k < 4; ++k) a[k] = uo[0][k] * __builtin_amdgcn_rcpf(1.0f + __expf(-uo[0][k])) * uo[1][k];
                    u32x2 o; o.x = cvt_pk_bf16(a[0], a[1]); o.y = cvt_pk_bf16(a[2], a[3]);
                    *(u32x2*)(ACT + (size_t)(row0 + ai * HALF + m * 16) * 2816 + colg + 4 * n) = o;
                }
            }
        }
#ifdef DUP_EPC
        }
#endif
        (void)seq_start;
#undef EPC_LOADW
    }
};
template <class Epi, class Sched, bool ALIGN_EPI = false, bool SP2 = false>
__device__ __forceinline__ void gemm_phase(PG8_LAS unsigned char* lds, const Gemm g, const Sched& S, const Epi& E) {
    int tid_ = threadIdx.x; asm volatile("" : "+v"(tid_));
    const int tid = tid_, wid = __builtin_amdgcn_readfirstlane(tid >> 6), lane = tid & 63, wr = wid >> 2, wc = wid & 3, fr = lane & 15, fq = lane >> 4;
    const int K = g.K, nt = K / BK;
    unsigned voffA[2], voffB[2];
#pragma unroll
    for (int i = 0; i < 2; ++i) { int R, C; stage_rc(tid * 16 + i * 8192, R, C); const int Rb = Epi::PERM ? ((R & ~31) + perm32(R & 31)) : R;
        voffA[i] = (unsigned)(R * K + C) * 2u; voffB[i] = (unsigned)(Rb * K + C) * 2u; }
    const size_t kstep = (size_t)(BK * 2);
    const size_t hstep = (size_t)HALF * K * 2;
    const size_t tstep = 2 * hstep;
    const unsigned ldsw = (unsigned)wid * 1024u;
    const int aoff = lds_byte(wr * 64 + fr, fq * 8), boff = lds_byte(wc * 32 + fr, fq * 8);
#define PG8_SA(b, h) (((b) * 2 + (h)) * HTB)
#define PG8_SB(b, h) ((4 + (b) * 2 + (h)) * HTB)
#define PG8_STAGE(bufoff, gbase, voff) do { _Pragma("unroll") for (int _i = 0; _i < 2; ++_i) \
        __builtin_amdgcn_global_load_lds((const unsigned*)((const char*)(gbase) + (voff)[_i]), (PG8_LAS unsigned*)(lds + (bufoff) + ldsw + _i * 8192), 16, 0, 0); } while (0)
#define PG8_LDA(dst, b, h) do { _Pragma("unroll") for (int m = 0; m < 4; ++m) _Pragma("unroll") for (int k = 0; k < 2; ++k) dst[m][k] = *(const PG8_LAS bf16x8*)(lds + PG8_SA(b, h) + aoff + m * 2048 + k * 1024); } while (0)
#define PG8_LDB(dst, b, h) do { _Pragma("unroll") for (int n = 0; n < 2; ++n) _Pragma("unroll") for (int k = 0; k < 2; ++k) dst[n][k] = *(const PG8_LAS bf16x8*)(lds + PG8_SB(b, h) + boff + n * 2048 + k * 1024); } while (0)
#define PG8_MMA(ai, bj, At, Bt) do { __builtin_amdgcn_s_setprio(1); _Pragma("unroll") for (int m = 0; m < 4; ++m) _Pragma("unroll") for (int n = 0; n < 2; ++n) _Pragma("unroll") for (int k = 0; k < 2; ++k) \
        acc[ai][bj][m][n] = __builtin_amdgcn_mfma_f32_16x16x32_bf16(Bt[n][k], At[m][k], acc[ai][bj][m][n], 0, 0, 0); __builtin_amdgcn_s_setprio(0); } while (0)
#define PG8_WAIT_V(n) asm volatile("s_waitcnt vmcnt(" #n ")" ::: "memory")
#define PG8_WAIT_L(n) asm volatile("s_waitcnt lgkmcnt(" #n ")" ::: "memory")
#define PG8_BAR __builtin_amdgcn_s_barrier()
#define PG8_SCHED __builtin_amdgcn_sched_barrier(0)
    Unit cur, nxt; int ui = 0;
    if (!S.next(0, cur)) return;
    f32x4 acc[2][2][4][2];
#pragma unroll
    for (int a = 0; a < 2; ++a)
#pragma unroll
        for (int b = 0; b < 2; ++b)
#pragma unroll
            for (int m = 0; m < 4; ++m)
#pragma unroll
                for (int n = 0; n < 2; ++n) acc[a][b][m][n] = (f32x4){0.f, 0.f, 0.f, 0.f};
    bf16x8 At[4][2], B0[2][2], B1[2][2];
    const char* cA = (const char*)g.A + (size_t)cur.pm * tstep; const char* cB = (const char*)g.Bt + (size_t)cur.pn * tstep;
    S.a_ready(cur);
    if constexpr (SP2) {
        PG8_STAGE(PG8_SB(0, 0), cB, voffB); PG8_STAGE(PG8_SB(0, 1), cB + hstep, voffB); PG8_STAGE(PG8_SA(0, 0), cA, voffA); PG8_STAGE(PG8_SA(0, 1), cA + hstep, voffA);
        if (wr == 1) PG8_BAR;
        PG8_WAIT_V(2); PG8_BAR;
        PG8_STAGE(PG8_SB(1, 0), cB + kstep, voffB); PG8_STAGE(PG8_SA(1, 0), cA + kstep, voffA); PG8_STAGE(PG8_SB(1, 1), cB + hstep + kstep, voffB);
        PG8_WAIT_V(6); PG8_BAR;
    } else {
        PG8_STAGE(PG8_SB(0, 0), cB, voffB); PG8_STAGE(PG8_SA(0, 0), cA, voffA); PG8_STAGE(PG8_SB(0, 1), cB + hstep, voffB); PG8_STAGE(PG8_SA(0, 1), cA + hstep, voffA);
        if (wr == 1) PG8_BAR;
        PG8_WAIT_V(4); PG8_BAR;
        PG8_STAGE(PG8_SB(1, 0), cB + kstep, voffB); PG8_STAGE(PG8_SA(1, 0), cA + kstep, voffA); PG8_STAGE(PG8_SB(1, 1), cB + hstep + kstep, voffB);
        PG8_WAIT_V(6); PG8_BAR;
    }
    for (;;) {
        const bool has_next = S.next(ui + 1, nxt);
        const char* nA = has_next ? (const char*)g.A + (size_t)nxt.pm * tstep : cA; const char* nB = has_next ? (const char*)g.Bt + (size_t)nxt.pn * tstep : cB;
        for (int t = 0; t < nt; t += 2) {
            const bool last = (t == nt - 2);
            const char* a1 = cA + (size_t)(t + 1) * kstep;
            const char* a2 = last ? nA : cA + (size_t)(t + 2) * kstep; const char* b2 = last ? nB : cB + (size_t)(t + 2) * kstep;
            const char* a3 = a2 + kstep; const char* b3 = b2 + kstep;
            if (last && has_next) S.a_ready(nxt);
            if constexpr (SP2) {
            PG8_LDB(B0, 0, 0); PG8_LDB(B1, 0, 1); PG8_SCHED; PG8_LDA(At, 0, 0); PG8_STAGE(PG8_SA(1, 1), a1 + hstep, voffA);
            PG8_WAIT_V(8); PG8_WAIT_L(0); PG8_BAR; PG8_MMA(0, 0, At, B0); PG8_MMA(0, 1, At, B1); PG8_BAR; PG8_SCHED;
            PG8_LDA(At, 0, 1); PG8_STAGE(PG8_SB(0, 0), b2, voffB); PG8_STAGE(PG8_SB(0, 1), b2 + hstep, voffB); PG8_STAGE(PG8_SA(0, 0), a2, voffA);
            PG8_WAIT_V(8); PG8_WAIT_L(0); PG8_BAR; PG8_MMA(1, 0, At, B0); PG8_MMA(1, 1, At, B1); PG8_BAR; PG8_SCHED;
            PG8_LDB(B0, 1, 0); PG8_LDB(B1, 1, 1); PG8_SCHED; PG8_LDA(At, 1, 0); PG8_STAGE(PG8_SA(0, 1), a2 + hstep, voffA);
            PG8_WAIT_V(8); PG8_WAIT_L(0); PG8_BAR; PG8_MMA(0, 0, At, B0); PG8_MMA(0, 1, At, B1); PG8_BAR; PG8_SCHED;
            PG8_LDA(At, 1, 1); PG8_STAGE(PG8_SB(1, 0), b3, voffB); PG8_STAGE(PG8_SB(1, 1), b3 + hstep, voffB); PG8_STAGE(PG8_SA(1, 0), a3, voffA);
            PG8_WAIT_V(8); PG8_WAIT_L(0); PG8_BAR; PG8_MMA(1, 0, At, B0); PG8_MMA(1, 1, At, B1); PG8_BAR; PG8_SCHED;
            } else {
            PG8_LDB(B0, 0, 0); PG8_SCHED; PG8_LDA(At, 0, 0); PG8_STAGE(PG8_SA(1, 1), a1 + hstep, voffA);
            PG8_WAIT_L(8); PG8_BAR; PG8_WAIT_L(0); PG8_MMA(0, 0, At, B0); PG8_BAR; PG8_SCHED;
            PG8_LDB(B1, 0, 1); PG8_STAGE(PG8_SB(0, 0), b2, voffB);
            PG8_BAR; PG8_WAIT_L(0); PG8_MMA(0, 1, At, B1); PG8_BAR;
            PG8_LDA(At, 0, 1); PG8_STAGE(PG8_SA(0, 0), a2, voffA);
            PG8_BAR; PG8_WAIT_L(0); PG8_MMA(1, 0, At, B0); PG8_BAR; PG8_SCHED;
            PG8_STAGE(PG8_SB(0, 1), b2 + hstep, voffB);
            PG8_WAIT_V(6); PG8_BAR; PG8_MMA(1, 1, At, B1); PG8_BAR;
            PG8_LDB(B0, 1, 0); PG8_SCHED; PG8_LDA(At, 1, 0); PG8_STAGE(PG8_SA(0, 1), a2 + hstep, voffA);
            PG8_WAIT_L(8); PG8_BAR; PG8_WAIT_L(0); PG8_MMA(0, 0, At, B0); PG8_BAR; PG8_SCHED;
            PG8_LDB(B1, 1, 1); PG8_STAGE(PG8_SB(1, 0), b3, voffB);
            PG8_BAR; PG8_WAIT_L(0); PG8_MMA(0, 1, At, B1); PG8_BAR;
            PG8_LDA(At, 1, 1); PG8_STAGE(PG8_SA(1, 0), a3, voffA);
            PG8_BAR; PG8_WAIT_L(0); PG8_MMA(1, 0, At, B0); PG8_BAR; PG8_SCHED;
            PG8_STAGE(PG8_SB(1, 1), b3 + hstep, voffB);
            PG8_WAIT_V(6); PG8_BAR; PG8_MMA(1, 1, At, B1); PG8_BAR;
            }
        }
        if constexpr (ALIGN_EPI) { if (wr == 0) PG8_BAR; }
        if constexpr (!Epi::AFTER_DRAIN) { E(acc, cur, wr, wc, fr, fq);
#ifdef DUP_EPI
            if constexpr (Epi::PROBE_DUP) { asm volatile("" ::: "memory"); E(acc, cur, wr, wc, fr, fq); }
#endif
            S.done(cur); }
        if (!has_next) break;
#pragma unroll
        for (int a = 0; a < 2; ++a)
#pragma unroll
            for (int b = 0; b < 2; ++b)
#pragma unroll
                for (int m = 0; m < 4; ++m)
#pragma unroll
                    for (int n = 0; n < 2; ++n) acc[a][b][m][n] = (f32x4){0.f, 0.f, 0.f, 0.f};
        cur = nxt; cA = nA; cB = nB; ++ui;
        if constexpr (ALIGN_EPI) { if (wr == 1) PG8_BAR; }
    }
    PG8_WAIT_V(0);
    if constexpr (!ALIGN_EPI) { if (wr == 0) PG8_BAR; }
    PG8_BAR;
    if constexpr (Epi::AFTER_DRAIN) { E.fused(acc, cur, wr, wc, fr, fq, lds, wid, lane); S.done(cur); }
#undef PG8_SA
#undef PG8_SB
#undef PG8_STAGE
#undef PG8_LDA
#undef PG8_LDB
#undef PG8_MMA
#undef PG8_WAIT_V
#undef PG8_WAIT_L
#undef PG8_BAR
#undef PG8_SCHED
}
}
constexpr int BATCH = 16, SEQ = 2048, DM = 1024, MTOK = BATCH * SEQ, DEPTH = 2;
constexpr int IN_COLS = 3612, NP = 3584, N1 = 3840, DFF = 2816, NUP = 5632;
constexpr int NWAVES = 8, NTHREADS = 512;
constexpr int LDS_BYTES = 163840;
#define GAS __attribute__((address_space(1)))
#define LAS __attribute__((address_space(3)))
typedef unsigned short bf16;
typedef float f32x4 __attribute__((ext_vector_type(4)));
typedef unsigned v4u __attribute__((ext_vector_type(4)));
typedef unsigned v2u __attribute__((ext_vector_type(2)));
#define LDS_WAIT() asm volatile("s_waitcnt lgkmcnt(0)" ::: "memory")

constexpr size_t MiB = 1u << 20;
constexpr size_t WS_SS = 0;
constexpr size_t WS_BAR = 1536 * 1024;
constexpr size_t WS_CF = 1 * MiB;
constexpr size_t WS_W1T = 2 * MiB;
constexpr size_t WS_WOT = 17 * MiB;
constexpr size_t WS_WUT = 21 * MiB;
constexpr size_t WS_WDT = 43 * MiB;
constexpr size_t WS_FF = 54 * MiB;
constexpr size_t WS_XB = 56 * MiB;
constexpr size_t WS_P = 120 * MiB;
constexpr size_t WS_PS = 344 * MiB;
constexpr size_t WS_O = 348 * MiB;
constexpr size_t WS_GQ = 412 * MiB;
constexpr size_t WS_HALO = 476 * MiB;
constexpr size_t WS_ACT = 296 * MiB;
constexpr size_t WS_END = 508 * MiB;

__device__ __forceinline__ float bf2f(unsigned u) { return __uint_as_float(u << 16); }
__device__ __forceinline__ unsigned f2bf(float f) { unsigned u = __float_as_uint(f); return (u + 0x7fffu + ((u >> 16) & 1u)) >> 16; }
typedef float f32x2_t __attribute__((ext_vector_type(2))); typedef __bf16 bf16x2_t __attribute__((ext_vector_type(2)));
__device__ __forceinline__ unsigned pk2(float lo, float hi) { f32x2_t v = {lo, hi}; bf16x2_t r = __builtin_convertvector(v, bf16x2_t); return __builtin_bit_cast(unsigned, r); }
__device__ __forceinline__ float xsum16(float x) { return x + __shfl_xor(x, 16); }
__device__ __forceinline__ float xsum32(float x) { return x + __shfl_xor(x, 32); }
__device__ __forceinline__ float xmax16(float x) { return fmaxf(x, __shfl_xor(x, 16)); }
__device__ __forceinline__ float xmax32(float x) { return fmaxf(x, __shfl_xor(x, 32)); }
__device__ __forceinline__ float wave_sum(float v) {
#pragma unroll
    for (int o = 1; o < 64; o <<= 1) v += __shfl_xor(v, o);
    return v;
}
__device__ __forceinline__ float rcpf_(float x) { return __builtin_amdgcn_rcpf(x); }
__device__ __forceinline__ float rsqf_(float x) { return __builtin_amdgcn_rsqf(x); }
__device__ __forceinline__ float sigmoidf_(float x) { return rcpf_(1.0f + __expf(-x)); }
__device__ __forceinline__ float siluf_(float x) { return x * rcpf_(1.0f + __expf(-x)); }
__device__ __forceinline__ float softplusf_(float x) { return x > 20.f ? x : __logf(1.0f + __expf(x)); }
__device__ __forceinline__ float logsigmoidf_(float x) { return fminf(x, 0.f) - __logf(1.0f + __expf(-fabsf(x))); }
__device__ __forceinline__ void unpack8(const v4u w, float* f) {
    f[0] = __uint_as_float(w.x << 16); f[1] = __uint_as_float(w.x & 0xffff0000u); f[2] = __uint_as_float(w.y << 16); f[3] = __uint_as_float(w.y & 0xffff0000u);
    f[4] = __uint_as_float(w.z << 16); f[5] = __uint_as_float(w.z & 0xffff0000u); f[6] = __uint_as_float(w.w << 16); f[7] = __uint_as_float(w.w & 0xffff0000u);
}

__device__ __forceinline__ int map_w1(int j) {
    const int t = j >> 8, i = j & 255;
    if (t < 2) return t * 256 + 64 * ((i >> 5) & 3) + 32 * (i >> 7) + (i & 31);
    if (t < 3) return j;
    if (t < 6) return 772 + (t - 3) * 256 + i;
    if (t == 6) return 1548 + i;
    if (t < 12) return 1804 + (t - 7) * 256 + i;
    if (t == 12) return 3084 + i;
    if (t == 13) return 3356 + i;
    if (i < 4) return 768 + i;
    if (i < 8) return 1540 + (i - 4);
    if (i < 12) return 1544 + (i - 8);
    if (i < 28) return 3340 + (i - 12);
    return -1;
}
template <int MAPKIND>
__device__ __forceinline__ void transpose_item(const float* W, int K, int N, bf16* WT, const float* gk, LAS float* scr, int item, int nblk, int lane) {
    const int kb = item / nblk, nb = item % nblk, k0 = 64 * kb, n0 = 32 * nb;
    const int jn = n0 + (lane & 31);
    const int src = MAPKIND == 1 ? map_w1(jn) : MAPKIND == 2 ? ((jn >> 8) * 128 + (jn & 127) + ((jn & 128) ? DFF : 0)) : jn;
    const int srcc = src >= 0 ? src : 0; const float keep = src >= 0 ? 1.f : 0.f;
    float wv[32], gv[32];
#pragma unroll
    for (int i = 0; i < 32; ++i) { const int kk = 2 * i + (lane >> 5); wv[i] = W[(size_t)(k0 + kk) * N + srcc]; gv[i] = gk ? gk[k0 + kk] : 1.f; }
#pragma unroll
    for (int i = 0; i < 32; ++i) { const int kk = 2 * i + (lane >> 5); scr[kk * 33 + (lane & 31)] = wv[i] * gv[i] * keep; }
    LDS_WAIT();
    const int c = lane & 7;
#pragma unroll
    for (int j = 0; j < 4; ++j) { const int n = (lane >> 3) + 8 * j; const LAS float* s = scr + (8 * c) * 33 + n;
        v4u o; o.x = pk2(s[0 * 33], s[1 * 33]); o.y = pk2(s[2 * 33], s[3 * 33]); o.z = pk2(s[4 * 33], s[5 * 33]); o.w = pk2(s[6 * 33], s[7 * 33]);
        *(v4u*)(WT + (size_t)(n0 + n) * K + k0 + 8 * c) = o; }
    LDS_WAIT();
}

#define CAS __attribute__((address_space(4)))
struct KArgs { const float* in[22]; float* out; unsigned char* ws; };
struct Ctx {
    const CAS KArgs* ka; float* out; unsigned char* ws;
    LAS unsigned char* lds;
    int tid, lane, wave, gw, ngw;
};

__device__ __forceinline__ void p0_prologue(Ctx& C) {
    LAS float* scr = (LAS float*)(C.lds + C.wave * 16384);
    constexpr int I1 = 16 * 120, I2 = 16 * 32, I3 = 16 * 176, I4 = 44 * 32, IL = I1 + I2 + I3 + I4;
    for (int it = C.gw; it < 2 * IL; it += C.ngw) {
        const int l = it / IL; int r = it % IL;
        if (r < I1) { transpose_item<1>(C.ka->in[2] + (size_t)l * DM * IN_COLS, DM, IN_COLS, (bf16*)(C.ws + WS_W1T) + (size_t)l * N1 * DM, C.ka->in[1] + l * DM, scr, r, 120, C.lane); continue; } r -= I1;
        if (r < I2) { transpose_item<0>(C.ka->in[16] + (size_t)l * DM * DM, DM, DM, (bf16*)(C.ws + WS_WOT) + (size_t)l * DM * DM, nullptr, scr, r, 32, C.lane); continue; } r -= I2;
        if (r < I3) { transpose_item<2>(C.ka->in[18] + (size_t)l * DM * NUP, DM, NUP, (bf16*)(C.ws + WS_WUT) + (size_t)l * NUP * DM, C.ka->in[17] + l * DM, scr, r, 176, C.lane); continue; } r -= I3;
        transpose_item<0>(C.ka->in[21] + (size_t)l * DFF * DM, DFF, DM, (bf16*)(C.ws + WS_WDT) + (size_t)l * DM * DFF, nullptr, scr, r, 32, C.lane);
    }
    float* ss = (float*)(C.ws + WS_SS);
    bf16* XB = (bf16*)(C.ws + WS_XB);
    for (int m0 = C.gw * 4; m0 < MTOK; m0 += C.ngw * 4) {
        f32x4 v[4][4];
#pragma unroll
        for (int r = 0; r < 4; ++r) { const f32x4* xr = (const f32x4*)(C.ka->in[0] + (size_t)(m0 + r) * DM) + C.lane;
#pragma unroll
            for (int j = 0; j < 4; ++j) v[r][j] = xr[64 * j]; }
#pragma unroll
        for (int r = 0; r < 4; ++r) { unsigned long long* o8 = (unsigned long long*)(XB + (size_t)(m0 + r) * DM) + C.lane; float s = 0.f;
#pragma unroll
            for (int j = 0; j < 4; ++j) { const f32x4 w = v[r][j]; s += (w.x * w.x + w.y * w.y) + (w.z * w.z + w.w * w.w);
                o8[64 * j] = (unsigned long long)pk2(w.x, w.y) | ((unsigned long long)pk2(w.z, w.w) << 32); }
            s = wave_sum(s);
            if (C.lane == 0) ss[m0 + r] = s; }
    }
    for (int i = blockIdx.x * NTHREADS + C.tid; i < 3 * MTOK; i += gridDim.x * NTHREADS) ss[MTOK + i] = 0.f;
}

__device__ __forceinline__ void m0_prep(Ctx& C, int l) {
    bf16* P = (bf16*)(C.ws + WS_P); const float* PS = (const float*)(C.ws + WS_PS); float* CF = (float*)(C.ws + WS_CF);
    const float* qn_g = C.ka->in[3] + l * 64; const float* kn_g = C.ka->in[4] + l * 64; const float* b_f = C.ka->in[5] + l * 4; const float* cw = C.ka->in[7] + l * 4 * 768;
    const int lane = C.lane;
    for (int bh = C.gw; bh < 64; bh += C.ngw) {
        const int b = bh >> 2, h = bh & 3; const float bias = b_f[h];
        const size_t r0 = (size_t)b * SEQ + lane * 32;
        float v[32]; (void)r0;
        { const f32x4* fp = (const f32x4*)((const float*)(C.ws + WS_FF) + (size_t)bh * SEQ + lane * 32);
#pragma unroll
          for (int i = 0; i < 8; ++i) { const f32x4 q4 = fp[i]; v[4 * i] = q4.x; v[4 * i + 1] = q4.y; v[4 * i + 2] = q4.z; v[4 * i + 3] = q4.w; } }
        float run = 0.f;
#pragma unroll
        for (int i = 0; i < 32; ++i) { run += logsigmoidf_(v[i] + bias); v[i] = run; }
        float inc = run;
#pragma unroll
        for (int o = 1; o < 64; o <<= 1) { const float t = __shfl_up(inc, o); if (lane >= o) inc += t; }
        const float ex = inc - run;
        float* cf = CF + (size_t)bh * SEQ + lane * 32;
#pragma unroll
        for (int i = 0; i < 32; i += 4) *(f32x4*)(cf + i) = (f32x4){ex + v[i], ex + v[i + 1], ex + v[i + 2], ex + v[i + 3]} * 1.4426950408889634f;
    }
}
#define XB_TMO      128
#define XB_XCNT(j)  (256  + 64 * (j))
#define XB_XSUB(j)  (1280 + 64 * (j))
#define XB_XGEN(j)  (2304 + 64 * (j))
#define XB_TOP      3328
#define XB_TOPGEN   3392
#define XCD_BAR_WORDS 3456
#define XB_SPIN_CAP (1u << 18)

__device__ __forceinline__ unsigned xb_ld(unsigned* p)              { return __hip_atomic_load(p, __ATOMIC_RELAXED, __HIP_MEMORY_SCOPE_AGENT); }
__device__ __forceinline__ unsigned xb_add(unsigned* p, unsigned v) { return __hip_atomic_fetch_add(p, v, __ATOMIC_RELAXED, __HIP_MEMORY_SCOPE_AGENT); }
__device__ __forceinline__ unsigned xb_xcc_id() { return (unsigned)__builtin_amdgcn_s_getreg((3 << 11) | 20) & 0xFu; }
#define XB_SPIN(cond, bar) do { unsigned _sp = 0; while (cond) { __builtin_amdgcn_s_sleep(1); \
    if ((++_sp & 255u) == 0u) { if (xb_ld(&(bar)[XB_TMO])) break; if (_sp > XB_SPIN_CAP) { atomicAdd(&(bar)[XB_TMO], 1u); break; } } } } while (0)

struct XcdBarrier {
    unsigned* bar; unsigned x;
    volatile LAS unsigned* st;
};

__device__ __forceinline__ XcdBarrier xcd_barrier_post(unsigned* bar, volatile LAS unsigned* st) {
    XcdBarrier b; b.bar = bar; b.x = xb_xcc_id(); b.st = st;
    if (threadIdx.x == 0) (void)xb_add(&bar[XB_XCNT(b.x)], 1u);
    return b;
}
__device__ __forceinline__ void xcd_barrier_complete(unsigned* bar, unsigned x, unsigned& nloc, unsigned& nx) {
    const unsigned G = gridDim.x * gridDim.y * gridDim.z;
    unsigned sum, cnt, mine, sp = 0u;
    for (;;) {
        sum = 0u; cnt = 0u; mine = 0u;
#pragma unroll
        for (unsigned j = 0; j < 16; ++j) { const unsigned c = xb_ld(&bar[XB_XCNT(j)]); sum += c; cnt += (c > 0u) ? 1u : 0u; mine = (j == x) ? c : mine; }
        if (sum == G) break;
        __builtin_amdgcn_s_sleep(1);
        if ((++sp & 255u) == 0u) { if (xb_ld(&bar[XB_TMO])) break; if (sp > XB_SPIN_CAP) { atomicAdd(&bar[XB_TMO], 1u); break; } }
    }
    nloc = mine > 0u ? mine : 1u; nx = cnt > 0u ? cnt : 1u;
}

__device__ __forceinline__ void xcd_barrier(const XcdBarrier& b) {
    asm volatile("s_waitcnt vmcnt(0)" ::: "memory");
    __syncthreads();
    if (threadIdx.x == 0) {
        unsigned* bar = b.bar;
        __builtin_amdgcn_s_waitcnt(0);
        unsigned nloc = b.st[0], nx = b.st[1];
        if (nloc == 0u) { xcd_barrier_complete(bar, b.x, nloc, nx); b.st[0] = nloc; b.st[1] = nx; }
        const unsigned old = xb_add(&bar[XB_XSUB(b.x)], 1u);
        const unsigned gen = old / nloc;
        if (old + 1u == (gen + 1u) * nloc) {
            __builtin_amdgcn_fence(__ATOMIC_RELEASE, "agent");
            asm volatile("s_waitcnt vmcnt(0)" ::: "memory");
            const unsigned og = xb_add(&bar[XB_TOP], 1u);
            const unsigned tg = og / nx;
            if (og + 1u == (tg + 1u) * nx) xb_add(&bar[XB_TOPGEN], 1u);
            else XB_SPIN(xb_ld(&bar[XB_TOPGEN]) == tg, bar);
            __builtin_amdgcn_fence(__ATOMIC_ACQUIRE, "agent");
            xb_add(&bar[XB_XGEN(b.x)], 1u);
            asm volatile("s_waitcnt vmcnt(0)" ::: "memory");
        } else {
            XB_SPIN(xb_ld(&bar[XB_XGEN(b.x)]) == gen, bar);
            __builtin_amdgcn_fence(__ATOMIC_ACQUIRE, "agent");
            asm volatile("s_waitcnt vmcnt(0)" ::: "memory");
        }
    }
    __syncthreads();
}
typedef short s16x4 __attribute__((ext_vector_type(4)));
constexpr size_t OS_VTH = 0 * MiB, OS_VTG = 16 * MiB, OS_KTH = 32 * MiB, OS_KTG = 48 * MiB, OS_ADH = 56 * MiB, OS_ADG = 58 * MiB;
__device__ __forceinline__ f32x4 mfma16(s16x4 a, s16x4 b, f32x4 c) { return __builtin_amdgcn_mfma_f32_16x16x16bf16_1k(a, b, c, 0, 0, 0); }
__device__ __forceinline__ s16x4 ld8(const bf16* p) { return *(const s16x4*)p; }
__device__ __forceinline__ s16x4 cvt4(f32x4 v) { v2u w; w.x = pk2(v.x, v.y); w.y = pk2(v.z, v.w); return __builtin_bit_cast(s16x4, w); }

struct LinRaw { unsigned short v[16], q[16], k[16]; f32x4 gk4; };
template <int MODE>
__device__ __forceinline__ void lin_stage1_load(Ctx& C, int item, LinRaw& R) {
    const int lane = C.lane, bh = item >> 7, blk = item & 127, b = bh >> 2, h = bh & 3;
    const bf16* P = (const bf16*)(C.ws + WS_P); const size_t row0 = (size_t)b * SEQ + blk * 16;
    const bf16* vp = P + row0 * NP + (MODE == 0 ? 9 : 12) * 256 + h * 64 + lane;
    const bf16* qp = MODE == 0 ? P + row0 * NP + 7 * 256 + h * 64 + lane : P + row0 * NP + 11 * 256 + h * 32 + (lane & 31);
    const bf16* kp = qp + (MODE == 0 ? 256 : 128);
#pragma unroll
    for (int t = 0; t < 16; ++t) { R.q[t] = qp[(size_t)t * NP]; R.k[t] = kp[(size_t)t * NP]; }
    if (MODE == 1) R.gk4 = *(const f32x4*)((const float*)(C.ws + WS_PS) + (row0 + (lane >> 2)) * 32 + 12 + 4 * (lane & 3));
}
template <int MODE>
__device__ __forceinline__ void lin_stage1_finish(Ctx& C, int l, int item, const LinRaw& R, LAS float* gl) {
    constexpr int DK = MODE == 0 ? 64 : 32;
    const int lane = C.lane, bh = item >> 7, blk = item & 127, b = bh >> 2, h = bh & 3;
    bf16* P = (bf16*)(C.ws + WS_P);
    const size_t row0 = (size_t)b * SEQ + blk * 16;
    bf16* Kt = (bf16*)((unsigned char*)C.out + (MODE == 0 ? OS_KTH : OS_KTG)) + (size_t)item * DK * 16;
    bf16* Vt = (bf16*)((unsigned char*)C.out + (MODE == 0 ? OS_VTH : OS_VTG)) + (size_t)item * 64 * 16;
    float* Ad = (float*)((unsigned char*)C.out + (MODE == 0 ? OS_ADH : OS_ADG)) + (size_t)item * DK;
    const int d = lane;
    float la[16], kk[16], qq[16];
    bf16* qp; bf16* kp;
    if (MODE == 0) {
        float lb = 0.f;
        if (l == 1) { const float a0 = C.ka->in[11][h * 64 + d], a1 = C.ka->in[11][256 + h * 64 + d]; lb = rcpf_(1.0f + __expf(a0 - a1)); }
        qp = P + row0 * NP + 7 * 256 + h * 64 + d; kp = qp + 256;
#pragma unroll
        for (int t = 0; t < 16; ++t) { const float qv = bf2f(R.q[t]), fv = bf2f(R.k[t]); const float sg = sigmoidf_(fv);
            la[t] = __logf(lb + (1.0f - lb) * sg); kk[t] = (1.0f - lb) * (1.0f - sg); qq[t] = siluf_(qv) * 0.125f; }
    } else {
        const float* Wg = C.ka->in[13] + l * 16 * 128 + h * 32 + (d & 31); const float bg = C.ka->in[14][l * 128 + h * 32 + (d & 31)];
        float wg[16];
#pragma unroll
        for (int r = 0; r < 16; ++r) wg[r] = Wg[r * 128];
        qp = P + row0 * NP + 11 * 256 + h * 32 + (d & 31); kp = qp + 128;
        *(LAS f32x4*)(gl + lane * 4) = R.gk4;
        LDS_WAIT();
#pragma unroll
        for (int t = 0; t < 16; ++t) { float gk[16];
#pragma unroll
            for (int r4 = 0; r4 < 4; ++r4) { const f32x4 q4 = *(const LAS f32x4*)(gl + t * 16 + 4 * r4); gk[4 * r4] = q4.x; gk[4 * r4 + 1] = q4.y; gk[4 * r4 + 2] = q4.z; gk[4 * r4 + 3] = q4.w; }
            float zz = bg;
#pragma unroll
            for (int r = 0; r < 16; ++r) zz += gk[r] * wg[r];
            la[t] = logsigmoidf_(zz) * (1.0f / 16.0f); kk[t] = bf2f(R.k[t]); qq[t] = bf2f(R.q[t]) * 0.17677669529663687f; }
    }
    if (MODE == 0 || lane < 32) {
        float g = 0.f;
#pragma unroll
        for (int t = 0; t < 16; ++t) { g += la[t]; la[t] = g; }
        unsigned w[8];
#pragma unroll
        for (int t = 0; t < 16; ++t) {
            qp[(size_t)t * NP] = (bf16)f2bf(qq[t] * __expf(la[t]));
            kp[(size_t)t * NP] = (bf16)f2bf(kk[t] * __expf(fminf(-la[t], 80.f)));
            const unsigned kt = f2bf(kk[t] * __expf(g - la[t]));
            if (t & 1) w[t >> 1] |= kt << 16; else w[t >> 1] = kt;
        }
        { v4u* o = (v4u*)(Kt + d * 16); o[0] = (v4u){w[0], w[1], w[2], w[3]}; o[1] = (v4u){w[4], w[5], w[6], w[7]}; }
        Ad[d] = __expf(g);
    }
}
template <int MODE>
__device__ __forceinline__ void lin_stage1_pair(Ctx& C, int l, int itemA, int itemB, LAS unsigned char* wl) {
    LinRaw A, B; lin_stage1_load<MODE>(C, itemA, A); lin_stage1_load<MODE>(C, itemB, B);
    lin_stage1_finish<MODE>(C, l, itemA, A, (LAS float*)wl); lin_stage1_finish<MODE>(C, l, itemB, B, (LAS float*)(wl + 1024));
}
template <int MODE>
__device__ __forceinline__ void lin_stage1_quad(Ctx& C, int l, int item, int stride, LAS unsigned char* wl) {
    LinRaw A, B, D, E; lin_stage1_load<MODE>(C, item, A); lin_stage1_load<MODE>(C, item + stride, B); lin_stage1_load<MODE>(C, item + 2 * stride, D); lin_stage1_load<MODE>(C, item + 3 * stride, E);
    lin_stage1_finish<MODE>(C, l, item, A, (LAS float*)wl); lin_stage1_finish<MODE>(C, l, item + stride, B, (LAS float*)(wl + 1024));
    lin_stage1_finish<MODE>(C, l, item + 2 * stride, D, (LAS float*)(wl + 2048)); lin_stage1_finish<MODE>(C, l, item + 3 * stride, E, (LAS float*)(wl + 3072));
}

struct ScanSeg { const unsigned char* g; unsigned gstride, gstep; int nch, rowch, lpitch, loff; };
constexpr int SCAN_BH_LDS = 11520, SCAN_BUF = 2 * SCAN_BH_LDS, SCAN_XS = 2 * SCAN_BUF;
struct ScanCopy { const unsigned char* gp[3]; unsigned gstep[3]; int loff[3]; };
__device__ __forceinline__ void scan_copy_init(ScanCopy& cp, const ScanSeg (&segs)[2][6], int tid) {
    int per = 0;
#pragma unroll
    for (int s = 0; s < 6; ++s) per += segs[0][s].nch;
#pragma unroll
    for (int j = 0; j < 3; ++j) {
        const int c = tid + 512 * j; cp.gp[j] = nullptr; cp.gstep[j] = 0; cp.loff[j] = 0;
        if (c < 2 * per) {
            const int bhl = c >= per ? 1 : 0; int r = c - bhl * per;
#pragma unroll
            for (int s = 0; s < 6; ++s) {
                const ScanSeg& sg = segs[bhl][s];
                if (r >= 0 && r < sg.nch) {
                    const int row = sg.rowch ? r / sg.rowch : 0, ch = sg.rowch ? r % sg.rowch : r;
                    cp.gp[j] = sg.g + (size_t)row * sg.gstride + ch * 16; cp.gstep[j] = sg.gstep; cp.loff[j] = bhl * SCAN_BH_LDS + sg.loff + row * sg.lpitch + ch * 16;
                }
                r -= sg.nch;
            }
        } else { cp.gp[j] = cp.gp[0]; cp.gstep[j] = cp.gstep[0]; cp.loff[j] = cp.loff[0]; }
    }
}
__device__ __forceinline__ void scan_copy_load(const ScanCopy& cp, v4u (&R)[3], int step) {
#pragma unroll
    for (int j = 0; j < 3; ++j) R[j] = *(const v4u*)(cp.gp[j] + (size_t)step * cp.gstep[j]);
}
__device__ __forceinline__ void scan_copy_store(const ScanCopy& cp, const v4u (&R)[3], LAS unsigned char* buf) {
#pragma unroll
    for (int j = 0; j < 3; ++j) *(LAS v4u*)(buf + cp.loff[j]) = R[j];
}

template <int MODE>
__device__ __forceinline__ void lin_scan(Ctx& C, int l, int bh0) {
    constexpr int DK = MODE == 0 ? 64 : 32, ND = DK / 16, PQ = DK * 2 + 16;
    constexpr int OQ = 0, OK = 16 * PQ, OZ = 2 * 16 * PQ, OKT = OZ + 2304, OVT = OKT + DK * 32, OAD = OVT + 2048;
    static_assert(OAD + DK * 4 <= SCAN_BH_LDS, "scan LDS map");
    const int lane = C.lane, n = lane & 15, g = lane >> 4, et = C.wave & 3, bhl = C.wave >> 2, bh = bh0 + bhl, b = bh >> 2, h = bh & 3;
    const unsigned char* P = C.ws + WS_P; bf16* O = (bf16*)(C.ws + WS_O);
    const float* gain = (MODE == 0 ? C.ka->in[12] : C.ka->in[15]) + l * 64;
    const int ocol = (MODE == 0 ? 512 : 768) + h * 64;
    ScanSeg segs[2][6];
#pragma unroll
    for (int q = 0; q < 2; ++q) {
        const int bq = bh0 + q, hq = bq & 3; const size_t rb = (size_t)(bq >> 2) * SEQ;
        const int qcol = MODE == 0 ? 7 * 256 + hq * 64 : 11 * 256 + hq * 32, kcol = MODE == 0 ? 8 * 256 + hq * 64 : 11 * 256 + 128 + hq * 32, zcol = (MODE == 0 ? 10 : 13) * 256 + hq * 64;
        segs[q][0] = ScanSeg{P + (rb * NP + qcol) * 2, NP * 2, 16 * NP * 2, 16 * (DK / 8), DK / 8, PQ, OQ};
        segs[q][1] = ScanSeg{P + (rb * NP + kcol) * 2, NP * 2, 16 * NP * 2, 16 * (DK / 8), DK / 8, PQ, OK};
        segs[q][2] = ScanSeg{P + (rb * NP + zcol) * 2, NP * 2, 16 * NP * 2, 128, 8, 144, OZ};
        segs[q][3] = ScanSeg{(unsigned char*)C.out + (MODE == 0 ? OS_KTH : OS_KTG) + (size_t)bq * 128 * DK * 32, 0, DK * 32, DK * 2, 0, 0, OKT};
        segs[q][4] = ScanSeg{(unsigned char*)C.out + (MODE == 0 ? OS_VTH : OS_VTG) + (size_t)bq * 128 * 2048, 0, 2048, 128, 0, 0, OVT};
        segs[q][5] = ScanSeg{(unsigned char*)C.out + (MODE == 0 ? OS_ADH : OS_ADG) + (size_t)bq * 128 * DK * 4, 0, DK * 4, DK / 4, 0, 0, OAD};
    }
    ScanCopy cp; scan_copy_init(cp, segs, C.tid);
    LAS unsigned char* lds = C.lds; LAS float* xs = (LAS float*)(lds + SCAN_XS);
    f32x4 S[ND];
#pragma unroll
    for (int i = 0; i < ND; ++i) S[i] = (f32x4){0.f, 0.f, 0.f, 0.f};
    const f32x4 gn = *(const f32x4*)(gain + 16 * et + 4 * g);
    const size_t rowb = (size_t)b * SEQ;
    v4u R[4][3];
    scan_copy_load(cp, R[0], 0); scan_copy_store(cp, R[0], lds);
    scan_copy_load(cp, R[1], 1); scan_copy_load(cp, R[2], 2); scan_copy_load(cp, R[3], 3); scan_copy_load(cp, R[0], 4);
    __syncthreads();
#pragma unroll 1
    for (int blk0 = 0; blk0 < 128; blk0 += 4) {
#pragma unroll
        for (int u = 0; u < 4; ++u) {
            const int blk = blk0 + u;
            scan_copy_store(cp, R[(u + 1) & 3], lds + ((blk + 1) & 1) * SCAN_BUF);
            scan_copy_load(cp, R[(u + 1) & 3], blk + 5 < 128 ? blk + 5 : 127);
            const LAS unsigned char* base = lds + (blk & 1) * SCAN_BUF + bhl * SCAN_BH_LDS;
            s16x4 qf[ND], khf[ND], ktf[ND]; f32x4 ad[ND];
#pragma unroll
            for (int i = 0; i < ND; ++i) { qf[i] = *(const LAS s16x4*)(base + OQ + n * PQ + (16 * i + 4 * g) * 2); khf[i] = *(const LAS s16x4*)(base + OK + n * PQ + (16 * i + 4 * g) * 2);
                ktf[i] = *(const LAS s16x4*)(base + OKT + ((16 * i + n) * 16 + 4 * g) * 2); ad[i] = *(const LAS f32x4*)(base + OAD + (16 * i + 4 * g) * 4); }
            const s16x4 vtf = *(const LAS s16x4*)(base + OVT + ((16 * et + n) * 16 + 4 * g) * 2), zf = *(const LAS s16x4*)(base + OZ + n * 144 + (16 * et + 4 * g) * 2);
            f32x4 at = (f32x4){0.f, 0.f, 0.f, 0.f};
#pragma unroll
            for (int i = 0; i < ND; ++i) at = mfma16(khf[i], qf[i], at);
#pragma unroll
            for (int j = 0; j < 4; ++j) if (4 * g + j > n) at[j] = 0.f;
            f32x4 oT = mfma16(vtf, cvt4(at), (f32x4){0.f, 0.f, 0.f, 0.f});
#pragma unroll
            for (int i = 0; i < ND; ++i) oT = mfma16(cvt4(S[i]), qf[i], oT);
#pragma unroll
            for (int i = 0; i < ND; ++i) S[i] = mfma16(ktf[i], vtf, S[i] * ad[i]);
            float ss = (oT.x * oT.x + oT.y * oT.y) + (oT.z * oT.z + oT.w * oT.w);
            ss = xsum32(xsum16(ss));
            LAS float* xp = xs + (blk & 1) * 128 + bhl * 64;
            if (g == 0) xp[et * 16 + n] = ss;
            __syncthreads();
            ss = (xp[n] + xp[16 + n]) + (xp[32 + n] + xp[48 + n]);
            const float r = rsqf_(ss * (1.0f / 64.0f) + RMS_EPS);
            { const v2u zw = __builtin_bit_cast(v2u, zf);
              const float z0 = bf2f(zw.x & 0xffffu), z1 = bf2f(zw.x >> 16), z2 = bf2f(zw.y & 0xffffu), z3 = bf2f(zw.y >> 16);
              v2u w; w.x = pk2(oT.x * r * gn.x * siluf_(z0), oT.y * r * gn.y * siluf_(z1)); w.y = pk2(oT.z * r * gn.z * siluf_(z2), oT.w * r * gn.w * siluf_(z3));
              *(v2u*)(O + (rowb + blk * 16 + n) * DM + ocol + 16 * et + 4 * g) = w; }
        }
    }
    __syncthreads();
}

struct GlaRaw { unsigned short v[16], q[2][4], k[2][4]; f32x4 gk4; };
struct GlaW { s16x4 bh[2], bl[2]; float bias[2]; };
__device__ __forceinline__ void gla_w_load(Ctx& C, int l, int h, GlaW& W) {
    const int n = C.lane & 15, g = C.lane >> 4;
#pragma unroll
    for (int dt = 0; dt < 2; ++dt) { const float* wp = C.ka->in[13] + l * 16 * 128 + h * 32 + 16 * dt + n; float w[4], lo[4];
#pragma unroll
        for (int j = 0; j < 4; ++j) { w[j] = wp[(4 * g + j) * 128]; lo[j] = w[j] - bf2f(f2bf(w[j])); }
        W.bh[dt] = cvt4((f32x4){w[0], w[1], w[2], w[3]}); W.bl[dt] = cvt4((f32x4){lo[0], lo[1], lo[2], lo[3]});
        W.bias[dt] = C.ka->in[14][l * 128 + h * 32 + 16 * dt + n]; }
}
__device__ __forceinline__ void gla_stage1_load(Ctx& C, int item, GlaRaw& R) {
    const int lane = C.lane, n = lane & 15, g = lane >> 4, bh = item >> 7, blk = item & 127, b = bh >> 2, h = bh & 3;
    const bf16* P = (const bf16*)(C.ws + WS_P); const size_t row0 = (size_t)b * SEQ + blk * 16;
    const bf16* vp = P + row0 * NP + 12 * 256 + h * 64 + lane;
#pragma unroll
    for (int dt = 0; dt < 2; ++dt)
#pragma unroll
        for (int j = 0; j < 4; ++j) { const bf16* qp = P + (row0 + 4 * g + j) * NP + 11 * 256 + h * 32 + 16 * dt + n; R.q[dt][j] = qp[0]; R.k[dt][j] = qp[128]; }
    R.gk4 = *(const f32x4*)((const float*)(C.ws + WS_PS) + (row0 + n) * 32 + 12 + 4 * g);
}
__device__ __forceinline__ void gla_stage1_finish(Ctx& C, int item, const GlaRaw& R, const GlaW& W) {
    const int lane = C.lane, n = lane & 15, g = lane >> 4, bh = item >> 7, blk = item & 127, b = bh >> 2, h = bh & 3;
    bf16* P = (bf16*)(C.ws + WS_P); const size_t row0 = (size_t)b * SEQ + blk * 16;
    bf16* Kt = (bf16*)((unsigned char*)C.out + OS_KTG) + (size_t)item * 32 * 16;
    bf16* Vt = (bf16*)((unsigned char*)C.out + OS_VTG) + (size_t)item * 64 * 16;
    float* Ad = (float*)((unsigned char*)C.out + OS_ADG) + (size_t)item * 32;
    f32x4 alo;
#pragma unroll
    for (int j = 0; j < 4; ++j) alo[j] = R.gk4[j] - bf2f(f2bf(R.gk4[j]));
    const s16x4 ah = cvt4(R.gk4), al = cvt4(alo);
#pragma unroll
    for (int dt = 0; dt < 2; ++dt) {
        f32x4 z = mfma16(ah, W.bh[dt], (f32x4){0.f, 0.f, 0.f, 0.f}); z = mfma16(al, W.bh[dt], z); z = mfma16(ah, W.bl[dt], z);
        float gc[4]; float run = 0.f;
#pragma unroll
        for (int j = 0; j < 4; ++j) { run += logsigmoidf_(z[j] + W.bias[dt]) * (1.0f / 16.0f); gc[j] = run; }
        const float s16 = xsum16(run), p16 = s16 - run, p32 = xsum32(s16) - s16;
        const float ex = ((g & 1) ? p16 : 0.f) + ((g & 2) ? p32 : 0.f), glast = s16 + p32;
        bf16* qp = P + (row0 + 4 * g) * NP + 11 * 256 + h * 32 + 16 * dt + n;
        float kt[4];
#pragma unroll
        for (int j = 0; j < 4; ++j) { const float G = ex + gc[j], kv = bf2f(R.k[dt][j]);
            qp[(size_t)j * NP] = (bf16)f2bf(bf2f(R.q[dt][j]) * 0.17677669529663687f * __expf(G));
            qp[(size_t)j * NP + 128] = (bf16)f2bf(kv * __expf(fminf(-G, 80.f)));
            kt[j] = kv * __expf(glast - G); }
        *(s16x4*)(Kt + (16 * dt + n) * 16 + 4 * g) = cvt4((f32x4){kt[0], kt[1], kt[2], kt[3]});
        if (g == 0) Ad[16 * dt + n] = __expf(glast);
    }
}
__device__ __forceinline__ void gla_stage1_pair(Ctx& C, int itemA, int itemB, const GlaW& W) {
    GlaRaw A, B; gla_stage1_load(C, itemA, A); gla_stage1_load(C, itemB, B);
    gla_stage1_finish(C, itemA, A, W); gla_stage1_finish(C, itemB, B, W);
}
constexpr size_t WS_GD_Q = 412 * MiB, WS_GD_W = 428 * MiB, WS_GD_KT = 444 * MiB, WS_GD_UT = 460 * MiB, WS_GD_AQ = 476 * MiB, WS_GD_AB = 480 * MiB;
typedef unsigned short us2_t __attribute__((ext_vector_type(2)));
struct GdnRaw { us2_t r[3][10]; float pb, pa; };
__device__ __forceinline__ void gdn_stage1_load(Ctx& C, int item, GdnRaw& R) {
    const int lane = C.lane, bh = item >> 7, blk = item & 127, b = bh >> 2, h = bh & 3;
    const bf16* P = (const bf16*)(C.ws + WS_P); const float* PS = (const float*)(C.ws + WS_PS);
    const size_t row0 = (size_t)b * SEQ + blk * 16;
#pragma unroll
    for (int part = 0; part < 3; ++part) { const bf16* rp = P + row0 * NP + 768 + part * 256 + h * 64 + lane;
#pragma unroll
        for (int i = 0; i < 19; ++i) R.r[part][i >> 1][i & 1] = rp[(long)((blk * 16 + i - 3 >= 0) ? i - 3 : 0) * NP]; }
    const float* ps = PS + (row0 + (lane & 15)) * 32; R.pb = ps[4 + h]; R.pa = ps[8 + h];
}
__device__ __forceinline__ void gdn_stage1_finish(Ctx& C, int l, int item, const GdnRaw& R, LAS unsigned char* wl) {
    const int lane = C.lane, bh = item >> 7, blk = item & 127, b = bh >> 2, h = bh & 3, n = lane & 15, g = lane >> 4;
    const size_t row0 = (size_t)b * SEQ + blk * 16;
    bf16* Qg = (bf16*)(C.ws + WS_GD_Q) + row0 * 256 + h * 64; bf16* Wg = (bf16*)(C.ws + WS_GD_W) + row0 * 256 + h * 64;
    bf16* Ktg = (bf16*)(C.ws + WS_GD_KT) + (size_t)item * 1024; bf16* Utg = (bf16*)(C.ws + WS_GD_UT) + (size_t)item * 1024;
    bf16* Aqg = (bf16*)(C.ws + WS_GD_AQ) + (size_t)item * 256; float* Abg = (float*)(C.ws + WS_GD_AB);
    LAS bf16* qh = (LAS bf16*)wl; LAS bf16* kh = qh + 1024; LAS bf16* kT = kh + 1024; LAS bf16* vT = kT + 1024;
    LAS float* Ms = (LAS float*)(wl + 8192); LAS bf16* Xw = (LAS bf16*)(wl + 9216); LAS bf16* Xu = Xw + 256; LAS float* sc = (LAS float*)(wl + 10240);
    {
        const float Acoef = -__expf(C.ka->in[8][l * 4 + h]), dtb = C.ka->in[9][l * 4 + h];
        const float beta = sigmoidf_(R.pb); float gc = Acoef * softplusf_(R.pa + dtb);
#pragma unroll
        for (int o = 1; o < 16; o <<= 1) { const float t = __shfl_up(gc, o); if (n >= o) gc += t; }
        if (lane < 16) { sc[lane] = beta; sc[16 + lane] = gc; }
    }
    LDS_WAIT();
    float gc[16];
#pragma unroll
    for (int t = 0; t < 16; t += 4) { const f32x4 v = *(const LAS f32x4*)(sc + 16 + t); gc[t] = v.x; gc[t + 1] = v.y; gc[t + 2] = v.z; gc[t + 3] = v.w; }
    const float glast = gc[15];
    const float* cw = C.ka->in[7] + l * 4 * 768 + h * 64 + lane;
    float raw[3][19];
#pragma unroll
    for (int part = 0; part < 3; ++part)
#pragma unroll
        for (int i = 0; i < 19; ++i) raw[part][i] = (i >= 3 || blk > 0) ? bf2f(R.r[part][i >> 1][i & 1]) : 0.f;
    float kraw[16];
#pragma unroll
    for (int part = 0; part < 3; ++part) {
        const float w0 = cw[part * 256], w1 = cw[768 + part * 256], w2 = cw[2 * 768 + part * 256], w3 = cw[3 * 768 + part * 256];
        float y[16];
#pragma unroll
        for (int t = 0; t < 16; ++t) y[t] = siluf_(w0 * raw[part][t] + w1 * raw[part][t + 1] + w2 * raw[part][t + 2] + w3 * raw[part][t + 3]);
        if (part == 0) {
#pragma unroll
            for (int t = 0; t < 16; ++t) qh[t * 64 + lane] = (bf16)f2bf(y[t]);
        } else if (part == 1) {
            unsigned w[8];
#pragma unroll
            for (int t = 0; t < 16; ++t) { kh[t * 64 + lane] = (bf16)f2bf(y[t]); kraw[t] = y[t]; }
#pragma unroll
            for (int t = 0; t < 16; t += 2) w[t >> 1] = pk2(y[t], y[t + 1]);
            LAS v4u* o = (LAS v4u*)(kT + lane * 16); o[0] = (v4u){w[0], w[1], w[2], w[3]}; o[1] = (v4u){w[4], w[5], w[6], w[7]};
        } else {
            unsigned w[8];
#pragma unroll
            for (int t = 0; t < 16; t += 2) w[t >> 1] = pk2(y[t], y[t + 1]);
            LAS v4u* o = (LAS v4u*)(vT + lane * 16); o[0] = (v4u){w[0], w[1], w[2], w[3]}; o[1] = (v4u){w[4], w[5], w[6], w[7]};
        }
    }
    LDS_WAIT();
    f32x4 ckk = (f32x4){0.f, 0.f, 0.f, 0.f}, cqk = ckk, cqq = ckk;
#pragma unroll
    for (int i = 0; i < 4; ++i) { const s16x4 kf = *(const LAS s16x4*)(kh + n * 64 + 16 * i + 4 * g), qf = *(const LAS s16x4*)(qh + n * 64 + 16 * i + 4 * g);
        ckk = mfma16(kf, kf, ckk); cqk = mfma16(kf, qf, cqk); cqq = mfma16(qf, qf, cqq); }
    if (g == (n >> 2)) { const int j = n & 3; sc[32 + n] = rsqf_(ckk[j] + RMS_EPS); sc[48 + n] = rsqf_(cqq[j] + RMS_EPS) * 0.125f; }
    LDS_WAIT();
    float rnk[16], rnq[16];
#pragma unroll
    for (int t = 0; t < 16; t += 4) { const f32x4 a = *(const LAS f32x4*)(sc + 32 + t), c2 = *(const LAS f32x4*)(sc + 48 + t);
        rnk[t] = a.x; rnk[t + 1] = a.y; rnk[t + 2] = a.z; rnk[t + 3] = a.w; rnq[t] = c2.x; rnq[t + 1] = c2.y; rnq[t + 2] = c2.z; rnq[t + 3] = c2.w; }
    {
#pragma unroll
        for (int t = 0; t < 16; ++t) Qg[(size_t)t * 256 + lane] = (bf16)f2bf(bf2f(qh[t * 64 + lane]) * rnq[t] * __expf(gc[t]));
        unsigned wk[8];
#pragma unroll
        for (int t = 0; t < 16; t += 2) wk[t >> 1] = pk2(kraw[t] * rnk[t] * __expf(glast - gc[t]), kraw[t + 1] * rnk[t + 1] * __expf(glast - gc[t + 1]));
        v4u* og = (v4u*)(Ktg + lane * 16); og[0] = (v4u){wk[0], wk[1], wk[2], wk[3]}; og[1] = (v4u){wk[4], wk[5], wk[6], wk[7]};
    }
    { const float rkr = sc[32 + n], rqr = sc[48 + n]; const f32x4 rks = *(const LAS f32x4*)(sc + 32 + 4 * g);
#pragma unroll
      for (int j = 0; j < 4; ++j) { ckk[j] *= rks[j] * rkr; cqk[j] *= rks[j] * rqr; } }
    const float Gr = sc[16 + n], beta_r = sc[n];
    const f32x4 Gs = *(const LAS f32x4*)(sc + 16 + 4 * g);
    f32x4 mv, av;
#pragma unroll
    for (int j = 0; j < 4; ++j) { const int s = 4 * g + j; const float dec = __expf(Gr - Gs[j]); mv[j] = s < n ? beta_r * ckk[j] * dec : 0.f; av[j] = s <= n ? cqk[j] * dec : 0.f; }
    *(LAS f32x4*)(Ms + n * 16 + 4 * g) = mv;
    *(s16x4*)(Aqg + n * 16 + 4 * g) = cvt4(av);
    LDS_WAIT();
    float X[16];
    X[0] = (n == 0) ? 1.f : 0.f;
#pragma unroll
    for (int r = 1; r < 16; ++r) {
        float a0 = (n == r) ? 1.f : 0.f, a1 = 0.f;
#pragma unroll
        for (int s4 = 0; s4 < r; s4 += 4) { const f32x4 m4 = *(const LAS f32x4*)(Ms + r * 16 + s4);
            a0 -= m4.x * X[s4]; if (s4 + 1 < r) a1 -= m4.y * X[s4 + 1]; if (s4 + 2 < r) a0 -= m4.z * X[s4 + 2]; if (s4 + 3 < r) a1 -= m4.w * X[s4 + 3]; }
        X[r] = a0 + a1;
    }
    { const float bu = sc[n], bw = bu * __expf(sc[16 + n]) * sc[32 + n];
      if (lane < 16) {
#pragma unroll
          for (int r = 0; r < 16; ++r) { Xw[r * 16 + n] = (bf16)f2bf(X[r] * bw); Xu[r * 16 + n] = (bf16)f2bf(X[r] * bu); } } }
    LDS_WAIT();
    const s16x4 xwf = *(const LAS s16x4*)(Xw + n * 16 + 4 * g), xuf = *(const LAS s16x4*)(Xu + n * 16 + 4 * g);
#pragma unroll
    for (int i = 0; i < 4; ++i) {
        const f32x4 cwt = mfma16(*(const LAS s16x4*)(kT + (16 * i + n) * 16 + 4 * g), xwf, (f32x4){0.f, 0.f, 0.f, 0.f});
        *(s16x4*)(Wg + (size_t)n * 256 + 16 * i + 4 * g) = cvt4(cwt);
        const f32x4 cut = mfma16(xuf, *(const LAS s16x4*)(vT + (16 * i + n) * 16 + 4 * g), (f32x4){0.f, 0.f, 0.f, 0.f});
        *(s16x4*)(Utg + (16 * i + n) * 16 + 4 * g) = cvt4(cut);
    }
    if (lane == 0) Abg[item] = __expf(glast);
    LDS_WAIT();
}

__device__ __forceinline__ void gdn_scan(Ctx& C, int l, int bh0) {
    constexpr int OQ = 0, OW = 2304, OZ = 4608, OKT = 6912, OUT = 8960, OAQ = 11008;
    const int lane = C.lane, n = lane & 15, g = lane >> 4, et = C.wave & 3, bhl = C.wave >> 2, bh = bh0 + bhl, b = bh >> 2, h = bh & 3;
    bf16* O = (bf16*)(C.ws + WS_O);
    const float* Abg = (const float*)(C.ws + WS_GD_AB) + bh * 128;
    const float* gain = C.ka->in[10] + l * 64;
    ScanSeg segs[2][6];
#pragma unroll
    for (int q = 0; q < 2; ++q) {
        const int bq = bh0 + q, hq = bq & 3; const size_t rb = (size_t)(bq >> 2) * SEQ;
        segs[q][0] = ScanSeg{C.ws + WS_GD_Q + (rb * 256 + hq * 64) * 2, 512, 16 * 512, 128, 8, 144, OQ};
        segs[q][1] = ScanSeg{C.ws + WS_GD_W + (rb * 256 + hq * 64) * 2, 512, 16 * 512, 128, 8, 144, OW};
        segs[q][2] = ScanSeg{C.ws + WS_P + (rb * NP + 1536 + hq * 64) * 2, NP * 2, 16 * NP * 2, 128, 8, 144, OZ};
        segs[q][3] = ScanSeg{C.ws + WS_GD_KT + (size_t)bq * 128 * 2048, 0, 2048, 128, 0, 0, OKT};
        segs[q][4] = ScanSeg{C.ws + WS_GD_UT + (size_t)bq * 128 * 2048, 0, 2048, 128, 0, 0, OUT};
        segs[q][5] = ScanSeg{C.ws + WS_GD_AQ + (size_t)bq * 128 * 512, 0, 512, 32, 0, 0, OAQ};
    }
    ScanCopy cp; scan_copy_init(cp, segs, C.tid);
    LAS unsigned char* lds = C.lds; LAS float* xs = (LAS float*)(lds + SCAN_XS);
    f32x4 S[4];
#pragma unroll
    for (int i = 0; i < 4; ++i) S[i] = (f32x4){0.f, 0.f, 0.f, 0.f};
    const f32x4 gn = *(const f32x4*)(gain + 16 * et + 4 * g);
    const size_t rowb = (size_t)b * SEQ;
    v4u R[4][3]; float abr[4];
    scan_copy_load(cp, R[0], 0); scan_copy_store(cp, R[0], lds);
    scan_copy_load(cp, R[1], 1); scan_copy_load(cp, R[2], 2); scan_copy_load(cp, R[3], 3); scan_copy_load(cp, R[0], 4);
#pragma unroll
    for (int u = 0; u < 4; ++u) abr[u] = Abg[u];
    __syncthreads();
#pragma unroll 1
    for (int blk0 = 0; blk0 < 128; blk0 += 4) {
#pragma unroll
        for (int u = 0; u < 4; ++u) {
            const int blk = blk0 + u;
            scan_copy_store(cp, R[(u + 1) & 3], lds + ((blk + 1) & 1) * SCAN_BUF);
            scan_copy_load(cp, R[(u + 1) & 3], blk + 5 < 128 ? blk + 5 : 127);
            const float ab = abr[u]; abr[u] = Abg[blk + 4 < 128 ? blk + 4 : 127];
            const LAS unsigned char* base = lds + (blk & 1) * SCAN_BUF + bhl * SCAN_BH_LDS;
            s16x4 qf[4], wf[4], ktf[4];
#pragma unroll
            for (int i = 0; i < 4; ++i) { qf[i] = *(const LAS s16x4*)(base + OQ + n * 144 + (16 * i + 4 * g) * 2); wf[i] = *(const LAS s16x4*)(base + OW + n * 144 + (16 * i + 4 * g) * 2);
                ktf[i] = *(const LAS s16x4*)(base + OKT + ((16 * i + n) * 16 + 4 * g) * 2); }
            const s16x4 utf = *(const LAS s16x4*)(base + OUT + ((16 * et + n) * 16 + 4 * g) * 2), zf = *(const LAS s16x4*)(base + OZ + n * 144 + (16 * et + 4 * g) * 2);
            const s16x4 aqf = *(const LAS s16x4*)(base + OAQ + (n * 16 + 4 * g) * 2);
            s16x4 Sb[4];
#pragma unroll
            for (int i = 0; i < 4; ++i) Sb[i] = cvt4(S[i]);
            f32x4 acc = (f32x4){0.f, 0.f, 0.f, 0.f};
#pragma unroll
            for (int i = 0; i < 4; ++i) acc = mfma16(wf[i], Sb[i], acc);
            const v2u uw = __builtin_bit_cast(v2u, utf);
            f32x4 vn; vn.x = bf2f(uw.x & 0xffffu) - acc.x; vn.y = bf2f(uw.x >> 16) - acc.y; vn.z = bf2f(uw.y & 0xffffu) - acc.z; vn.w = bf2f(uw.y >> 16) - acc.w;
            const s16x4 vb = cvt4(vn);
            f32x4 oT = mfma16(vb, aqf, (f32x4){0.f, 0.f, 0.f, 0.f});
#pragma unroll
            for (int i = 0; i < 4; ++i) oT = mfma16(Sb[i], qf[i], oT);
#pragma unroll
            for (int i = 0; i < 4; ++i) S[i] = mfma16(ktf[i], vb, S[i] * ab);
            float ss = (oT.x * oT.x + oT.y * oT.y) + (oT.z * oT.z + oT.w * oT.w);
            ss = xsum32(xsum16(ss));
            LAS float* xp = xs + (blk & 1) * 128 + bhl * 64;
            if (g == 0) xp[et * 16 + n] = ss;
            __syncthreads();
            ss = (xp[n] + xp[16 + n]) + (xp[32 + n] + xp[48 + n]);
            const float r = rsqf_(ss * (1.0f / 64.0f) + RMS_EPS);
            { const v2u zw = __builtin_bit_cast(v2u, zf);
              const float z0 = bf2f(zw.x & 0xffffu), z1 = bf2f(zw.x >> 16), z2 = bf2f(zw.y & 0xffffu), z3 = bf2f(zw.y >> 16);
              v2u w; w.x = pk2(oT.x * r * gn.x * siluf_(z0), oT.y * r * gn.y * siluf_(z1)); w.y = pk2(oT.z * r * gn.z * siluf_(z2), oT.w * r * gn.w * siluf_(z3));
              *(v2u*)(O + (rowb + blk * 16 + n) * DM + 256 + h * 64 + 16 * et + 4 * g) = w; }
        }
    }
    __syncthreads();
}
typedef short bf16x8 __attribute__((ext_vector_type(8)));
constexpr size_t WS_FVT = 484 * MiB;
constexpr int FOX_KP = 72, FOX_BUF = 64 * FOX_KP * 2 * 2 + 256;
__device__ __forceinline__ void fox_vt_item(Ctx& C, int item) {
    const int lane = C.lane, bh = item >> 7, blk = item & 127, b = bh >> 2, h = bh & 3;
    const bf16* vp = (const bf16*)(C.ws + WS_P) + ((size_t)b * SEQ + blk * 16) * NP + 512 + h * 64 + lane; unsigned w[8];
#pragma unroll
    for (int t = 0; t < 16; t += 2) w[t >> 1] = (unsigned)vp[(size_t)t * NP] | ((unsigned)vp[(size_t)(t + 1) * NP] << 16);
    v4u* o = (v4u*)((bf16*)(C.ws + WS_FVT) + ((size_t)item * 64 + lane) * 16); o[0] = (v4u){w[0], w[1], w[2], w[3]}; o[1] = (v4u){w[4], w[5], w[6], w[7]};
}
__device__ __forceinline__ void fox_vt_pair(Ctx& C, int itemA, int itemB) {
    const int lane = C.lane; unsigned w[2][8];
#pragma unroll
    for (int q = 0; q < 2; ++q) { const int item = q ? itemB : itemA, bh = item >> 7, blk = item & 127, b = bh >> 2, h = bh & 3;
        const bf16* vp = (const bf16*)(C.ws + WS_P) + ((size_t)b * SEQ + blk * 16) * NP + 512 + h * 64 + lane;
#pragma unroll
        for (int t = 0; t < 16; t += 2) w[q][t >> 1] = (unsigned)vp[(size_t)t * NP] | ((unsigned)vp[(size_t)(t + 1) * NP] << 16); }
#pragma unroll
    for (int q = 0; q < 2; ++q) { const int item = q ? itemB : itemA;
        v4u* o = (v4u*)((bf16*)(C.ws + WS_FVT) + ((size_t)item * 64 + lane) * 16); o[0] = (v4u){w[q][0], w[q][1], w[q][2], w[q][3]}; o[1] = (v4u){w[q][4], w[q][5], w[q][6], w[q][7]}; }
}
__device__ __forceinline__ void fox_unit(Ctx& C, int l, int bh, int qb) {
    const int tid = C.tid, lane = C.lane, wave = C.wave, n = lane & 15, g = lane >> 4, b = bh >> 2, h = bh & 3;
    const bf16* P = (const bf16*)(C.ws + WS_P); const float* CF = (const float*)(C.ws + WS_CF) + (size_t)bh * SEQ; bf16* O = (bf16*)(C.ws + WS_O);
    const bf16* Vtf = (const bf16*)(C.ws + WS_FVT) + (size_t)bh * 128 * 1024;
    const size_t rowb = (size_t)b * SEQ;
    const int q0 = qb * 256 + wave * 32;
    bf16x8 qf[2][2]; float ct[2];
#pragma unroll
    for (int qs = 0; qs < 2; ++qs) { ct[qs] = CF[q0 + 16 * qs + n];
#pragma unroll
        for (int ks = 0; ks < 2; ++ks) qf[qs][ks] = *(const bf16x8*)(P + (rowb + q0 + 16 * qs + n) * NP + h * 64 + 32 * ks + 8 * g); }
    f32x4 OT[2][4];
#pragma unroll
    for (int qs = 0; qs < 2; ++qs)
#pragma unroll
        for (int dt = 0; dt < 4; ++dt) OT[qs][dt] = (f32x4){0.f, 0.f, 0.f, 0.f};
    float mx[2] = {-INFINITY, -INFINITY}, lsum[2] = {0.f, 0.f};
    const int ntiles = 4 * (qb + 1);
    const int kkey = tid >> 3, kch = tid & 7, vb4 = tid >> 7, vd = (tid >> 1) & 63, vh = tid & 1;
    const bf16* kptr = P + (rowb + kkey) * NP + 256 + h * 64 + 8 * kch;
    const bf16* vptr = Vtf + ((size_t)vb4 * 64 + vd) * 16 + 8 * vh;
    const int kw = kkey * FOX_KP + 8 * kch, vw = 64 * FOX_KP + vd * FOX_KP + 16 * vb4 + 8 * vh;
    LAS unsigned char* lds = C.lds;
    v4u kr[2], vr[2]; float cr[2];
#define FOX_LOAD(set, t) do { const int t_ = (t) < ntiles ? (t) : ntiles - 1; kr[set] = *(const v4u*)(kptr + (size_t)t_ * 64 * NP); vr[set] = *(const v4u*)(vptr + (size_t)t_ * 4 * 1024); cr[set] = CF[t_ * 64 + (tid & 63)]; } while (0)
#define FOX_STORE(set, buf) do { *(LAS v4u*)((LAS bf16*)(buf) + kw) = kr[set]; *(LAS v4u*)((LAS bf16*)(buf) + vw) = vr[set]; if (tid < 64) ((LAS float*)((buf) + 64 * FOX_KP * 4))[tid] = cr[set]; } while (0)
    FOX_LOAD(0, 0); FOX_STORE(0, lds);
    FOX_LOAD(1, 1); FOX_LOAD(0, 2);
    __syncthreads();
#pragma unroll 1
    for (int kt0 = 0; kt0 < ntiles; kt0 += 2) {
#pragma unroll
      for (int u = 0; u < 2; ++u) {
        const int kt = kt0 + u;
        LAS unsigned char* cur = lds + (kt & 1) * FOX_BUF; LAS unsigned char* nxt = lds + ((kt & 1) ^ 1) * FOX_BUF;
        FOX_STORE((u + 1) & 1, nxt);
        FOX_LOAD((u + 1) & 1, kt + 3);
        if (64 * kt <= q0 + 31) {
            const bool diag = 64 * kt + 63 > q0;
            const LAS bf16* Ks = (const LAS bf16*)cur; const LAS bf16* Vs = Ks + 64 * FOX_KP; const LAS float* Cs = (const LAS float*)(cur + 64 * FOX_KP * 4);
            bf16x8 kf[4][2]; f32x4 c4[4];
#pragma unroll
            for (int mt = 0; mt < 4; ++mt) { c4[mt] = *(const LAS f32x4*)(Cs + 16 * mt + 4 * g);
#pragma unroll
                for (int ks = 0; ks < 2; ++ks) kf[mt][ks] = *(const LAS bf16x8*)(Ks + (16 * mt + n) * FOX_KP + 32 * ks + 8 * g); }
            __builtin_amdgcn_sched_barrier(0);
            f32x4 sv[2][4];
#pragma unroll
            for (int qs = 0; qs < 2; ++qs)
#pragma unroll
                for (int mt = 0; mt < 4; ++mt) {
                    f32x4 a = (f32x4){0.f, 0.f, 0.f, 0.f};
#pragma unroll
                    for (int ks = 0; ks < 2; ++ks) a = __builtin_amdgcn_mfma_f32_16x16x32_bf16(kf[mt][ks], qf[qs][ks], a, 0, 0, 0);
                    sv[qs][mt] = a;
                }
            s16x4 pb[2][4]; float corr[2];
#pragma unroll
            for (int qs = 0; qs < 2; ++qs) {
                float mloc = -INFINITY;
#pragma unroll
                for (int mt = 0; mt < 4; ++mt) { sv[qs][mt] = sv[qs][mt] + (ct[qs] - c4[mt]);
                    if (diag) {
#pragma unroll
                        for (int j = 0; j < 4; ++j) if (64 * kt + 16 * mt + 4 * g + j > q0 + 16 * qs + n) sv[qs][mt][j] = -INFINITY; }
                    mloc = fmaxf(fmaxf(mloc, fmaxf(sv[qs][mt][0], sv[qs][mt][1])), fmaxf(sv[qs][mt][2], sv[qs][mt][3])); }
                mloc = xmax32(xmax16(mloc));
                const float mn = fmaxf(mx[qs], mloc); corr[qs] = __builtin_amdgcn_exp2f(mx[qs] - mn);
                mx[qs] = mn; lsum[qs] *= corr[qs];
#pragma unroll
                for (int mt = 0; mt < 4; ++mt) { f32x4 p;
#pragma unroll
                    for (int j = 0; j < 4; ++j) { p[j] = __builtin_amdgcn_exp2f(sv[qs][mt][j] - mn); lsum[qs] += p[j]; }
                    pb[qs][mt] = cvt4(p); }
            }
#pragma unroll
            for (int dt = 0; dt < 4; ++dt) {
                bf16x8 vf2[2];
#pragma unroll
                for (int a = 0; a < 2; ++a) { const s16x4 lo = *(const LAS s16x4*)(Vs + (16 * dt + n) * FOX_KP + 32 * a + 4 * g), hi = *(const LAS s16x4*)(Vs + (16 * dt + n) * FOX_KP + 32 * a + 16 + 4 * g);
                    vf2[a] = (bf16x8){lo[0], lo[1], lo[2], lo[3], hi[0], hi[1], hi[2], hi[3]}; }
#pragma unroll
                for (int qs = 0; qs < 2; ++qs) { OT[qs][dt] = OT[qs][dt] * corr[qs];
#pragma unroll
                    for (int a = 0; a < 2; ++a) { const s16x4 lo = pb[qs][2 * a], hi = pb[qs][2 * a + 1];
                        OT[qs][dt] = __builtin_amdgcn_mfma_f32_16x16x32_bf16(vf2[a], (bf16x8){lo[0], lo[1], lo[2], lo[3], hi[0], hi[1], hi[2], hi[3]}, OT[qs][dt], 0, 0, 0); } }
            }
        }
        __syncthreads();
      }
    }
#undef FOX_LOAD
#undef FOX_STORE
    const float* on_g = C.ka->in[6] + l * 64;
#pragma unroll
    for (int qs = 0; qs < 2; ++qs) {
        float ls = xsum32(xsum16(lsum[qs]));
        const float inv = rcpf_(ls); float ss = 0.f;
#pragma unroll
        for (int dt = 0; dt < 4; ++dt) { OT[qs][dt] = OT[qs][dt] * inv; ss += (OT[qs][dt].x * OT[qs][dt].x + OT[qs][dt].y * OT[qs][dt].y) + (OT[qs][dt].z * OT[qs][dt].z + OT[qs][dt].w * OT[qs][dt].w); }
        ss = xsum32(xsum16(ss));
        const float r = rsqf_(ss * (1.0f / 64.0f) + RMS_EPS);
#pragma unroll
        for (int dt = 0; dt < 4; ++dt) { const f32x4 gg = *(const f32x4*)(on_g + 16 * dt + 4 * g);
            v2u w; w.x = pk2(OT[qs][dt].x * r * gg.x, OT[qs][dt].y * r * gg.y); w.y = pk2(OT[qs][dt].z * r * gg.z, OT[qs][dt].w * r * gg.w);
            *(v2u*)(O + (rowb + q0 + 16 * qs + n) * DM + h * 64 + 16 * dt + 4 * g) = w; }
    }
}
#ifdef PROBE_TS
#define SUBTS(i) do { if (blockIdx.x == PROBE_BLK && threadIdx.x == 0 && l == 0) ((volatile LAS unsigned long long*)(C.lds + LDS_BYTES - 512))[16 + (i)] = __builtin_amdgcn_s_memrealtime(); } while (0)
#else
#define SUBTS(i) do { } while (0)
#endif
constexpr int SCAN_BLOCKS = 96;
__device__ __forceinline__ void m1_mixers(Ctx& C, int l) {
    const int bx = (int)blockIdx.x;
    SUBTS(6);
#ifdef PROBE_FOXW
    if (blockIdx.x == PROBE_BLK && threadIdx.x == 0 && l == 0) { volatile LAS unsigned long long* t_ = (volatile LAS unsigned long long*)(C.lds + LDS_BYTES - 512); t_[25] = 0; t_[26] = 0; }
#endif
    if (bx < SCAN_BLOCKS) {
        if (bx < 32) gdn_scan(C, l, 2 * bx);
        else if (bx < 64) lin_scan<0>(C, l, 2 * (bx - 32));
        else lin_scan<1>(C, l, 2 * (bx - 64));
        SUBTS(7);
#ifdef DUP_SCAN
        __syncthreads();
        if (bx < 32) gdn_scan(C, l, 2 * bx);
        else if (bx < 64) lin_scan<0>(C, l, 2 * (bx - 32));
        else lin_scan<1>(C, l, 2 * (bx - 64));
#endif
    } else {
        const int G2 = (int)gridDim.x - SCAN_BLOCKS, j = (int)blockIdx.x - SCAN_BLOCKS;
        for (int r = 0; r * G2 < 512; ++r) { const int u = r * G2 + ((r & 1) ? (G2 - 1 - j) : j); if (u < 512) fox_unit(C, l, u & 63, 7 - (u >> 6)); }
        SUBTS(7);
#ifdef DUP_FOX
        for (int r = 0; r * G2 < 512; ++r) { const int u = r * G2 + ((r & 1) ? (G2 - 1 - j) : j); if (u < 512) fox_unit(C, l, u & 63, 7 - (u >> 6)); }
#endif
    }
}

__device__ __forceinline__ void cv_fixup(Ctx& C, int l) {
    const float* H = (const float*)(C.ws + WS_HALO); bf16* ACT = (bf16*)(C.ws + WS_ACT);
    const float* cw = C.ka->in[19] + (size_t)l * 3 * NUP; const float* cb = C.ka->in[20] + (size_t)l * NUP;
    for (int i = blockIdx.x * NTHREADS + C.tid; i < 128 * 22 * 2 * 128; i += gridDim.x * NTHREADS) {
        const int j = i & 127, rr = (i >> 7) & 1, t = i >> 8, pn = t % 22, pm = t / 22;
        if ((pm & 7) == 0) continue;
        const float* h0 = H + (size_t)(pm * 22 + pn) * 1024; const float* hp = H + (size_t)((pm - 1) * 22 + pn) * 1024;
        float uo[2];
#pragma unroll
        for (int bj = 0; bj < 2; ++bj) { const int c = bj * 128 + j, col = bj * DFF + pn * 128 + j;
            const float y0 = h0[rr * 256 + c], y1 = rr == 0 ? hp[3 * 256 + c] : h0[c], y2 = rr == 0 ? hp[2 * 256 + c] : hp[3 * 256 + c];
            uo[bj] = cw[col] * y2 + cw[NUP + col] * y1 + cw[2 * NUP + col] * y0 + cb[col]; }
        ACT[(size_t)(pm * 256 + rr) * DFF + pn * 128 + j] = (bf16)f2bf(siluf_(uo[0]) * uo[1]);
    }
}

struct Args { const float* in[22]; float* out; unsigned char* ws; };
__global__ void __launch_bounds__(NTHREADS, 2) fwd_megakernel(Args args) {
    extern __shared__ __attribute__((aligned(16))) unsigned char lds_raw[];
    cg::grid_group grid = cg::this_grid();
    Ctx C;
    C.ka = (const CAS KArgs*)__builtin_amdgcn_kernarg_segment_ptr();
    C.out = args.out; C.ws = args.ws;
    C.lds = (LAS unsigned char*)lds_raw;
    C.tid = threadIdx.x; C.lane = C.tid & 63; C.wave = __builtin_amdgcn_readfirstlane(C.tid >> 6);
    C.gw = blockIdx.x * NWAVES + C.wave; C.ngw = gridDim.x * NWAVES;
    const int G = gridDim.x;
    volatile LAS unsigned* bst = (volatile LAS unsigned*)(C.lds + LDS_BYTES - 16);
    if (threadIdx.x < 4) bst[threadIdx.x] = 0u;
    __syncthreads();
    const XcdBarrier xbar = xcd_barrier_post((unsigned*)(args.ws + WS_BAR), bst);
#ifdef PROBE_TS
    volatile LAS unsigned long long* tsl = (volatile LAS unsigned long long*)(C.lds + LDS_BYTES - 512); int nts = 0;
#define GRID_SYNC() do { xcd_barrier(xbar); if (blockIdx.x == PROBE_BLK && threadIdx.x == 0) tsl[nts] = __builtin_amdgcn_s_memrealtime(); ++nts; } while (0)
#else
#define GRID_SYNC() xcd_barrier(xbar)
#endif
    unsigned char* const ws0 = args.ws; float* const out0 = args.out;
#define PHASE_BEGIN() do { size_t z_ = 0; const CAS KArgs* k_ = (const CAS KArgs*)__builtin_amdgcn_kernarg_segment_ptr(); int t_ = threadIdx.x; asm volatile("" : "+s"(z_), "+s"(k_), "+v"(t_)); \
        unsigned char* w_ = ws0 + z_; float* o_ = out0 + z_;     \
        C.ws = w_; C.out = o_; C.ka = k_; C.tid = t_; C.lane = t_ & 63; C.wave = __builtin_amdgcn_readfirstlane(t_ >> 6); C.gw = blockIdx.x * NWAVES + C.wave; ss = (float*)(w_ + WS_SS); XB = (bf16*)(w_ + WS_XB); } while (0)
    float* ss; bf16* XB;

#ifdef PROBE_TS
    if (blockIdx.x == PROBE_BLK && threadIdx.x == 0) tsl[15] = __builtin_amdgcn_s_memrealtime();
#endif
#ifndef NO_P0
    p0_prologue(C);
#ifdef DUP_P0
    grid.sync(); p0_prologue(C);
#endif
#endif
    GRID_SYNC();
    if (gridDim.x > 65536u) grid.sync();
    for (int l = 0; l < DEPTH; ++l) {
        PHASE_BEGIN();
        {
            pg8::Gemm g{XB, (const bf16*)(C.ws + WS_W1T) + (size_t)l * N1 * DM, MTOK, N1, DM}; pg8::StaticOrder S; S.init(MTOK, N1, G, (int)blockIdx.x);
            pg8::EpiP E{(bf16*)(C.ws + WS_P), (float*)(C.ws + WS_PS), ss + (size_t)l * MTOK, (float*)(C.ws + WS_FF), C.ka->in[3] + l * 64, C.ka->in[4] + l * 64, (bf16*)(C.ws + WS_FVT), (bf16*)((unsigned char*)C.out + OS_VTH), (bf16*)((unsigned char*)C.out + OS_VTG)};
#ifndef NO_G1
            pg8::gemm_phase<pg8::EpiP, pg8::StaticOrder, true, true>(C.lds, g, S, E);
#ifdef DUP_G1
            GRID_SYNC(); pg8::gemm_phase<pg8::EpiP, pg8::StaticOrder, true, true>(C.lds, g, S, E);
#endif
#endif
        }
        GRID_SYNC();
        PHASE_BEGIN();
        SUBTS(0);
#ifndef NO_M0
        m0_prep(C, l);
#endif
        SUBTS(1);
        for (int it = C.gw; it < 4096; it += C.ngw) { GdnRaw ga, gb; gdn_stage1_load(C, it, ga); gdn_stage1_load(C, it + 4096, gb);
            gdn_stage1_finish(C, l, it, ga, C.lds + C.wave * 20480); gdn_stage1_finish(C, l, it + 4096, gb, C.lds + C.wave * 20480); }
        SUBTS(2);
        for (int it = C.gw; it < 4096; it += C.ngw) lin_stage1_pair<0>(C, l, it, it + 4096, C.lds + C.wave * 20480);
        SUBTS(3);
        { GlaW gw_; gla_w_load(C, l, (C.gw >> 7) & 3, gw_);
          for (int it = C.gw; it < 4096; it += C.ngw) gla_stage1_pair(C, it, it + 4096, gw_); }
        SUBTS(4);
        SUBTS(5);
#ifdef DUP_GDN1
        { GdnRaw ga, gb; int it = C.gw;
          if (it < 8192) gdn_stage1_load(C, it, ga);
          for (; it < 8192; it += 2 * C.ngw) {
              if (it + C.ngw < 8192) gdn_stage1_load(C, it + C.ngw, gb);
              gdn_stage1_finish(C, l, it, ga, C.lds + C.wave * 20480);
              if (it + C.ngw < 8192) { if (it + 2 * C.ngw < 8192) gdn_stage1_load(C, it + 2 * C.ngw, ga); gdn_stage1_finish(C, l, it + C.ngw, gb, C.lds + C.wave * 20480); }
          } }
#endif
#ifdef DUP_FVT
        for (int r_ = 0; r_ < 4; ++r_) for (int it = C.gw; it < 8192; it += C.ngw) fox_vt_item(C, it);
#endif
        GRID_SYNC();
        PHASE_BEGIN();
#ifndef NO_M1
        m1_mixers(C, l);
#ifdef DUP_M1
        GRID_SYNC(); m1_mixers(C, l);
#endif
#endif
        GRID_SYNC();
        PHASE_BEGIN();
        {
            pg8::Gemm g{(const bf16*)(C.ws + WS_O), (const bf16*)(C.ws + WS_WOT) + (size_t)l * DM * DM, MTOK, DM, DM}; pg8::StaticOrder S; S.init(MTOK, DM, G, (int)blockIdx.x);
            pg8::EpiRes<false> E{XB, nullptr, ss + (size_t)(2 + l) * MTOK};
#ifndef NO_G2
            pg8::gemm_phase<pg8::EpiRes<false>, pg8::StaticOrder, true, true>(C.lds, g, S, E);
#ifdef DUP_G2P
            { GRID_SYNC(); pg8::EpiRes<false> E2{XB, nullptr, (float*)(C.ws + WS_HALO), (bf16*)(C.ws + WS_P)}; pg8::gemm_phase<pg8::EpiRes<false>, pg8::StaticOrder, true, true>(C.lds, g, S, E2); }
#endif
#ifdef DUP_G2_OLD
            if (l == 0) { GRID_SYNC(); pg8::EpiRes E2{C.ka->in[0], C.out, XB, (float*)(C.ws + WS_HALO)}; pg8::gemm_phase<pg8::EpiRes, pg8::StaticOrder, true, true>(C.lds, g, S, E2); }
#endif
#endif
        }
        GRID_SYNC();
        PHASE_BEGIN();
        {
            pg8::Gemm g{XB, (const bf16*)(C.ws + WS_WUT) + (size_t)l * NUP * DM, MTOK, NUP, DM}; pg8::StaticOrder S; S.init(MTOK, NUP, G, (int)blockIdx.x);
            pg8::EpiConv E{(bf16*)(C.ws + WS_ACT), (float*)(C.ws + WS_HALO), ss + (size_t)(2 + l) * MTOK, C.ka->in[19] + (size_t)l * 3 * NUP, C.ka->in[20] + (size_t)l * NUP, (LAS float*)(C.lds + 131072)};
#ifndef NO_G3
            pg8::gemm_phase<pg8::EpiConv, pg8::StaticOrder, true, true>(C.lds, g, S, E);
#ifdef DUP_G3
            GRID_SYNC(); pg8::gemm_phase<pg8::EpiConv, pg8::StaticOrder, true, true>(C.lds, g, S, E);
#endif
#endif
        }
        GRID_SYNC();
        PHASE_BEGIN();
        cv_fixup(C, l);
#ifdef DUP_FIX
        GRID_SYNC(); cv_fixup(C, l);
#endif
#ifdef DUP_SYNC
        for (int q = 0; q < 10; ++q) GRID_SYNC();
#endif
        GRID_SYNC();
        PHASE_BEGIN();
        {
            pg8::Gemm g{(const bf16*)(C.ws + WS_ACT), (const bf16*)(C.ws + WS_WDT) + (size_t)l * DM * DFF, MTOK, DM, DFF}; pg8::StaticOrder S; S.init(MTOK, DM, G, (int)blockIdx.x);
            if (l + 1 < DEPTH) { pg8::EpiRes<false> E{XB, nullptr, ss + (size_t)(l + 1) * MTOK};
#ifdef DUP_G4P
                { pg8::EpiRes<false> E2{XB, nullptr, (float*)(C.ws + WS_HALO), (bf16*)(C.ws + WS_P)}; pg8::gemm_phase<pg8::EpiRes<false>, pg8::StaticOrder, true, true>(C.lds, g, S, E2); GRID_SYNC(); }
#endif
                pg8::gemm_phase<pg8::EpiRes<false>, pg8::StaticOrder, true, true>(C.lds, g, S, E);
            } else { pg8::EpiRes<true> E{XB, C.out, nullptr};
                pg8::gemm_phase<pg8::EpiRes<true>, pg8::StaticOrder, true, true>(C.lds, g, S, E); }
        }
        GRID_SYNC();
    }
#ifdef PROBE_TS
    if (blockIdx.x == PROBE_BLK && threadIdx.x == 0) {
        const unsigned long long d = tsl[PROBE_B] - tsl[PROBE_A], t0 = __builtin_amdgcn_s_memrealtime();
        while (__builtin_amdgcn_s_memrealtime() - t0 < 8ull * d) __builtin_amdgcn_s_sleep(16);
    }
#endif
}

extern "C" void kernel_launch(void* const* d_in, const int* in_sizes, int n_in, void* d_out, int out_size, void* d_ws, size_t ws_size, hipStream_t stream) {
    static int grid = 0;
    if (grid == 0) {
        if (n_in != 22 || in_sizes[0] != MTOK * DM || out_size != MTOK * DM || ws_size < WS_END) {
            fprintf(stderr, "kernel_launch: unexpected problem (n_in %d, in0 %d, out %d, ws %zu < %zu)\n", n_in, n_in > 0 ? in_sizes[0] : -1, out_size, ws_size, (size_t)WS_END); grid = -1; return; }
        int dev = 0, cus = 0, per_cu = 0;
        (void)hipGetDevice(&dev); (void)hipDeviceGetAttribute(&cus, hipDeviceAttributeMultiprocessorCount, dev);
        if (hipFuncSetAttribute((const void*)fwd_megakernel, hipFuncAttributeMaxDynamicSharedMemorySize, LDS_BYTES) != hipSuccess) { fprintf(stderr, "kernel_launch: hipFuncSetAttribute failed\n"); grid = -1; return; }
        if (hipOccupancyMaxActiveBlocksPerMultiprocessor(&per_cu, (const void*)fwd_megakernel, NTHREADS, LDS_BYTES) != hipSuccess || per_cu < 1) { fprintf(stderr, "kernel_launch: occupancy query says %d blocks per CU\n", per_cu); per_cu = 1; }
        (void)hipGetLastError();
        grid = cus;
    }
    if (grid < 0) return;
    if (hipMemsetAsync((char*)d_ws + WS_BAR, 0, 16384, stream) != hipSuccess) { fprintf(stderr, "kernel_launch: memset of the barrier words failed\n"); return; }
    Args a{};
    for (int i = 0; i < 22; ++i) a.in[i] = (const float*)d_in[i];
    a.out = (float*)d_out; a.ws = (unsigned char*)d_ws;
    void* kargs[] = {&a};
    hipError_t e = hipLaunchCooperativeKernel((const void*)fwd_megakernel, dim3(grid), dim3(NTHREADS), kargs, LDS_BYTES, stream);
    if (e != hipSuccess) fprintf(stderr, "kernel_launch: cooperative launch failed: %s (grid %d)\n", hipGetErrorString(e), grid);
}
```

```cpp
#include <hip/hip_runtime.h>
#include <hip/hip_cooperative_groups.h>
#include <cstdio>
#include <cstdint>
namespace cg = cooperative_groups;
constexpr float RMS_EPS = 1e-6f;

namespace pg8 {
#define PG8_LAS __attribute__((address_space(3)))
typedef unsigned short bf16_t;
typedef short bf16x8 __attribute__((ext_vector_type(8)));
typedef float f32x4 __attribute__((ext_vector_type(4)));
typedef unsigned u32x4 __attribute__((ext_vector_type(4)));
constexpr int BM = 256, BK = 64, HALF = 128, HTB = HALF * BK * 2  , STAGE_BYTES = 8 * HTB, NXCD = 8, WGM = 8;

__host__ __device__ __forceinline__ int lds_byte(int r, int c) { const int st = (r >> 4) * 2 + (c >> 5), rr = r & 15, cc = c & 31, ob = rr * 64 + cc * 2; return st * 1024 + (ob ^ (((ob >> 9) & 1) << 5)); }
__host__ __device__ __forceinline__ void stage_rc(int b, int& R, int& C) { const int st = b / 1024, sb = b % 1024, swz = sb ^ (((sb >> 9) & 1) << 5); R = (st >> 1) * 16 + swz / 64; C = (st & 1) * 32 + (swz % 64) / 2; }
__host__ __device__ __forceinline__ int perm32(int rho) { const int n = rho >> 4, i = rho & 15; return 8 * (i >> 2) + 4 * n + (i & 3); }

struct Unit { int pm, pn; };
struct Gemm { const bf16_t* A; const bf16_t* Bt; int M, N, K; };

struct StaticOrder {
    int nM, nN, nwg, G, c;
    __host__ __device__ void init(int M, int N, int G_, int c_) { nM = M / BM; nN = N / BM; nwg = nM * nN; G = G_; c = c_; }
    __host__ __device__ bool next(int i, Unit& u) const {
        const long L = (long)i * G + c; if (L >= nwg) return false;
        int wgid = (int)L; { const int q = nwg / NXCD, r = nwg % NXCD, xcd = wgid % NXCD, off = wgid / NXCD; wgid = (xcd < r ? xcd * (q + 1) : r * (q + 1) + (xcd - r) * q) + off; }
        const int nig = WGM * nN, gid = wgid / nig, fm = gid * WGM, gsz = (nM - fm) < WGM ? (nM - fm) : WGM;
        u.pm = fm + ((wgid % nig) % gsz); u.pn = (wgid % nig) / gsz; return true;
    }
    __device__ __forceinline__ void a_ready(const Unit&) const {}
    __device__ __forceinline__ void done(const Unit&) const {}
};
__device__ __forceinline__ unsigned cvt_pk_bf16(float lo, float hi) { unsigned r; asm volatile("v_cvt_pk_bf16_f32 %0, %1, %2" : "=v"(r) : "v"(lo), "v"(hi)); return r; }
typedef float f32x2 __attribute__((ext_vector_type(2)));

typedef unsigned u32x2 __attribute__((ext_vector_type(2)));
struct EpiP {
    static constexpr bool PERM = true, AFTER_DRAIN = false, PROBE_DUP = true;
    bf16_t* P; float* PS; const float* ss; float* FF; const float* qg; const float* kg; bf16_t* FVT; bf16_t* VTH; bf16_t* VTG; const float* hglb; int layer; bf16_t* KTH; float* ADH;
    template <int CTRL> static __device__ __forceinline__ float dppf(float old, float src) {
        return __builtin_bit_cast(float, __builtin_amdgcn_update_dpp(__builtin_bit_cast(int, old), __builtin_bit_cast(int, src), CTRL, 0xf, 0xf, false)); }
    __device__ __forceinline__ void operator()(const f32x4 (&acc)[2][2][4][2], const Unit& u, int wr, int wc, int fr, int fq) const {
        const int row0 = u.pm * BM + wr * 64 + fr;
        float rs[2][4];
#pragma unroll
        for (int ai = 0; ai < 2; ++ai)
#pragma unroll
            for (int m = 0; m < 4; ++m) rs[ai][m] = ss[row0 + ai * HALF + m * 16];
        float hlb[2][4];
#pragma unroll
        for (int n = 0; n < 2; ++n)
#pragma unroll
            for (int k = 0; k < 4; ++k) { hlb[n][k] = 0.f;
                if ((u.pn == 7 || u.pn == 8) && layer == 1) { const int c = (2 * (u.pn - 7) + (wc >> 1)) * 64 + 32 * (wc & 1) + 8 * fq + 4 * n + k; hlb[n][k] = __builtin_amdgcn_rcpf(1.0f + __expf(hglb[c] - hglb[256 + c])); } }
#pragma unroll
        for (int ai = 0; ai < 2; ++ai)
#pragma unroll
            for (int m = 0; m < 4; ++m) {
                const int row = row0 + ai * HALF + m * 16;
                const float rstd = __builtin_amdgcn_rsqf(rs[ai][m] * (1.0f / 1024.0f) + RMS_EPS);
                if (u.pn < 2) {
                    const float* gp = u.pn == 0 ? qg : kg;
                    f32x4 p[2][2]; float sq = 0.f;
#pragma unroll
                    for (int bj = 0; bj < 2; ++bj)
#pragma unroll
                        for (int n = 0; n < 2; ++n) { p[bj][n] = acc[ai][bj][m][n] * rstd; sq += (p[bj][n][0] * p[bj][n][0] + p[bj][n][1] * p[bj][n][1]) + (p[bj][n][2] * p[bj][n][2] + p[bj][n][3] * p[bj][n][3]); }
                    sq += __shfl_xor(sq, 16); sq += __shfl_xor(sq, 32);
                                        const float r = __builtin_amdgcn_rsqf(sq * (1.0f / 64.0f) + RMS_EPS) * (u.pn == 0 ? 0.18033688011112042f : 1.0f);
                    bf16_t* rowp = P + (size_t)row * 3584 + u.pn * BM + wc * 64 + 8 * fq;
#pragma unroll
                    for (int bj = 0; bj < 2; ++bj) { const f32x4 g0 = *(const f32x4*)(gp + 32 * bj + 8 * fq), g1 = *(const f32x4*)(gp + 32 * bj + 8 * fq + 4);
                                                const f32x4 v0 = p[bj][0] * g0 * r, v1 = p[bj][1] * g1 * r;
                        u32x4 w; w.x = cvt_pk_bf16(v0[0], v0[1]); w.y = cvt_pk_bf16(v0[2], v0[3]); w.z = cvt_pk_bf16(v1[0], v1[1]); w.w = cvt_pk_bf16(v1[2], v1[3]);
                        *(u32x4*)(rowp + 32 * bj) = w; }
                } else if (u.pn == 2 || u.pn == 9 || u.pn == 12) {
                    bf16_t* vp = (u.pn == 2 ? FVT : u.pn == 9 ? VTH : VTG) + (((size_t)(row >> 11) * 4 * 128 + ((row & 2047) >> 4)) * 64) * 16 + fr;
#pragma unroll
                    for (int bj = 0; bj < 2; ++bj)
#pragma unroll
                        for (int n = 0; n < 2; ++n) { const f32x4 v = acc[ai][bj][m][n] * rstd;
#pragma unroll
                            for (int k = 0; k < 4; ++k) { const int c = 128 * bj + 32 * wc + 8 * fq + 4 * n + k;
                                vp[((size_t)(c >> 6) * 128 * 64 + (c & 63)) * 16] = (bf16_t)(cvt_pk_bf16(v[k], 0.f) & 0xffffu); } }
                } else if (u.pn == 7 || u.pn == 8) {
                    const int h = 2 * (u.pn - 7) + (wc >> 1), d0 = 32 * (wc & 1) + 8 * fq;
                    const size_t item = ((size_t)(row >> 11) * 4 + h) * 128 + ((row & 2047) >> 4);
                    u32x4 wq, wk; unsigned* wqp = (unsigned*)&wq; unsigned* wkp = (unsigned*)&wk; float adv[8];
#pragma unroll
                    for (int n = 0; n < 2; ++n) { float qo[4], ko[4];
#pragma unroll
                        for (int k = 0; k < 4; ++k) {
                            const float lb = hlb[n][k];
                            const float qv = acc[ai][0][m][n][k] * rstd, fv = acc[ai][1][m][n][k] * rstd;
                            const float sg = __builtin_amdgcn_rcpf(1.0f + __expf(-fv));
                            const float la = __logf(lb + (1.0f - lb) * sg), kk = (1.0f - lb) * (1.0f - sg);
                            float gc = la;
                            gc += dppf<0x111>(0.f, gc); gc += dppf<0x112>(0.f, gc); gc += dppf<0x114>(0.f, gc); gc += dppf<0x118>(0.f, gc);
                            const float gl = __shfl(gc, (fq << 4) | 15);
                            qo[k] = qv * __builtin_amdgcn_rcpf(1.0f + __expf(-qv)) * 0.125f * __expf(gc);
                            ko[k] = kk * __expf(fminf(-gc, 80.f));
                            KTH[(item * 64 + d0 + 4 * n + k) * 16 + fr] = (bf16_t)(cvt_pk_bf16(kk * __expf(gl - gc), 0.f) & 0xffffu);
                            adv[4 * n + k] = __expf(gl); }
                        wqp[2 * n] = cvt_pk_bf16(qo[0], qo[1]); wqp[2 * n + 1] = cvt_pk_bf16(qo[2], qo[3]); wkp[2 * n] = cvt_pk_bf16(ko[0], ko[1]); wkp[2 * n + 1] = cvt_pk_bf16(ko[2], ko[3]); }
                    *(u32x4*)(P + (size_t)row * 3584 + 7 * BM + h * 64 + d0) = wq;
                    *(u32x4*)(P + (size_t)row * 3584 + 8 * BM + h * 64 + d0) = wk;
                    if (fr == 0) { float* ap = ADH + item * 64 + d0; *(f32x4*)ap = (f32x4){adv[0], adv[1], adv[2], adv[3]}; *(f32x4*)(ap + 4) = (f32x4){adv[4], adv[5], adv[6], adv[7]}; }
                } else if (u.pn < 14) {
                    bf16_t* rowp = P + (size_t)row * 3584 + u.pn * BM + wc * 32 + 8 * fq;
#pragma unroll
                    for (int bj = 0; bj < 2; ++bj) { const f32x4 v0 = acc[ai][bj][m][0] * rstd, v1 = acc[ai][bj][m][1] * rstd;
                        u32x4 w; w.x = cvt_pk_bf16(v0[0], v0[1]); w.y = cvt_pk_bf16(v0[2], v0[3]); w.z = cvt_pk_bf16(v1[0], v1[1]); w.w = cvt_pk_bf16(v1[2], v1[3]);
                        __builtin_nontemporal_store(w, (u32x4*)(rowp + bj * HALF)); }
                } else if (wc == 0) {
                    float* rowp = PS + (size_t)row * 32 + 8 * fq;
                    const f32x4 v0 = acc[ai][0][m][0] * rstd;
                    *(f32x4*)(rowp) = v0; *(f32x4*)(rowp + 4) = acc[ai][0][m][1] * rstd;
                    if (fq == 0) { float* fp = FF + (size_t)(row >> 11) * 4 * 2048 + (row & 2047);
                        fp[0] = v0[0]; fp[2048] = v0[1]; fp[2 * 2048] = v0[2]; fp[3 * 2048] = v0[3]; }
                }
            }
    }
};
template <bool LAST> struct EpiRes {
    static constexpr bool PERM = false, AFTER_DRAIN = false, PROBE_DUP = false;
    bf16_t* xb; float* out; float* ssq; bf16_t* xbw = nullptr;
    __device__ __forceinline__ void operator()(const f32x4 (&acc)[2][2][4][2], const Unit& u, int wr, int wc, int fr, int fq) const {
        const int row0 = u.pm * BM + wr * 64 + fr, col0 = u.pn * BM + wc * 32 + 4 * fq;
        u32x2 bv[2][2][2][2];
#define EPR_LOADQ(q_) do { _Pragma("unroll") for (int mm = 0; mm < 2; ++mm) _Pragma("unroll") for (int bj = 0; bj < 2; ++bj) _Pragma("unroll") for (int n = 0; n < 2; ++n) \
            bv[(q_) & 1][mm][bj][n] = *(const u32x2*)(xb + (size_t)(row0 + ((q_) >> 1) * HALF + (2 * ((q_) & 1) + mm) * 16) * 1024 + col0 + bj * HALF + n * 16); } while (0)
        EPR_LOADQ(0); EPR_LOADQ(1);
#pragma unroll
        for (int q = 0; q < 4; ++q) {
            const int ai = q >> 1;
#pragma unroll
            for (int mm = 0; mm < 2; ++mm) {
                const int m = 2 * (q & 1) + mm;
                const int row = row0 + ai * HALF + m * 16; float s = 0.f;
#pragma unroll
                for (int bj = 0; bj < 2; ++bj)
#pragma unroll
                    for (int n = 0; n < 2; ++n) { const size_t off = (size_t)row * 1024 + col0 + bj * HALF + n * 16; const u32x2 b = bv[q & 1][mm][bj][n];
                        f32x4 o = acc[ai][bj][m][n];
                        o[0] += __uint_as_float(b.x << 16); o[1] += __uint_as_float(b.x & 0xffff0000u); o[2] += __uint_as_float(b.y << 16); o[3] += __uint_as_float(b.y & 0xffff0000u);
                        if (LAST) *(f32x4*)(out + off) = o;
                        else { s += (o[0] * o[0] + o[1] * o[1]) + (o[2] * o[2] + o[3] * o[3]);
                            u32x2 w; w.x = cvt_pk_bf16(o[0], o[1]); w.y = cvt_pk_bf16(o[2], o[3]); *(u32x2*)((xbw ? xbw : xb) + off) = w; } }
                if (!LAST) { s += __shfl_xor(s, 16); s += __shfl_xor(s, 32);
                    if (fq == 0) atomicAdd(ssq + row, s); }
            }
            if (q == 0) EPR_LOADQ(2);
            if (q == 1) EPR_LOADQ(3);
        }
#undef EPR_LOADQ
    }
};
struct EpiConv {
    static constexpr bool PERM = true, AFTER_DRAIN = false, PROBE_DUP = false;
    bf16_t* ACT; float* HALO; const float* ss; const float* cw; const float* cb; PG8_LAS float* xl;
    template <int CTRL> static __device__ __forceinline__ float dpp(float old, float src) {
        return __builtin_bit_cast(float, __builtin_amdgcn_update_dpp(__builtin_bit_cast(int, old), __builtin_bit_cast(int, src), CTRL, 0xf, 0xf, false)); }
    __device__ __forceinline__ void operator()(const f32x4 (&acc)[2][2][4][2], const Unit& u, int wr, int wc, int fr, int fq) const {
        const int row0 = u.pm * BM + wr * 64 + fr;
        float rs[2][4];
#pragma unroll
        for (int ai = 0; ai < 2; ++ai)
#pragma unroll
            for (int m = 0; m < 4; ++m) rs[ai][m] = __builtin_amdgcn_rsqf(ss[row0 + ai * HALF + m * 16] * (1.0f / 1024.0f) + RMS_EPS);
        const int colg = u.pn * HALF + wc * 32 + 8 * fq;
        f32x4 wn[1][2][3], bn[1][2];
#define EPC_LOADW(n_) do { _Pragma("unroll") for (int bj = 0; bj < 2; ++bj) { const int c = bj * 2816 + colg + 4 * (n_); bn[0][bj] = *(const f32x4*)(cb + c); \
            _Pragma("unroll") for (int j = 0; j < 3; ++j) wn[0][bj][j] = *(const f32x4*)(cw + j * 5632 + c); } } while (0)
        EPC_LOADW(0);
        if (fr >= 14) {
#pragma unroll
            for (int ai = 0; ai < 2; ++ai) { PG8_LAS float* xp = xl + ((((ai * 2 + wr) * 4 + wc) * 2 + (fr - 14)) * 64) + 8 * fq;
#pragma unroll
                for (int bj = 0; bj < 2; ++bj)
#pragma unroll
                    for (int n = 0; n < 2; ++n) *(PG8_LAS f32x4*)(xp + bj * 32 + 4 * n) = acc[ai][bj][3][n] * rs[ai][3]; }
            if (wr == 1) { float* hp = HALO + ((size_t)(u.pm * 22 + u.pn) * 4 + 2 + (fr - 14)) * 256 + wc * 32 + 8 * fq;
#pragma unroll
                for (int bj = 0; bj < 2; ++bj)
#pragma unroll
                    for (int n = 0; n < 2; ++n) *(f32x4*)(hp + bj * HALF + 4 * n) = acc[1][bj][3][n] * rs[1][3]; }
        }
        if (fr < 2 && wr == 0) { float* hp = HALO + ((size_t)(u.pm * 22 + u.pn) * 4 + fr) * 256 + wc * 32 + 8 * fq;
#pragma unroll
            for (int bj = 0; bj < 2; ++bj)
#pragma unroll
                for (int n = 0; n < 2; ++n) *(f32x4*)(hp + bj * HALF + 4 * n) = acc[0][bj][0][n] * rs[0][0]; }
        asm volatile("s_waitcnt lgkmcnt(0)" ::: "memory"); __builtin_amdgcn_s_barrier(); asm volatile("" ::: "memory");
        const bool seq_start = (u.pm & 7) == 0;
#ifdef DUP_EPC
        for (int rep_ = 0; rep_ < 2; ++rep_) { asm volatile("" ::: "memory"); EPC_LOADW(0);
#endif
#pragma unroll
        for (int n = 0; n < 2; ++n) {
            if (n == 1) EPC_LOADW(1);
            f32x4 (&w)[2][3] = wn[0]; f32x4 (&bb)[2] = bn[0];
#pragma unroll
            for (int ai = 0; ai < 2; ++ai) {
                f32x4 prev[2];
                f32x4 h1[2], h2[2];
                const int pg = ai * 2 + wr - 1;
#pragma unroll
                for (int bj = 0; bj < 2; ++bj) {
                    if (pg >= 0) { const PG8_LAS float* xp = xl + (((pg * 4 + wc) * 2) * 64) + 8 * fq + bj * 32 + 4 * n;
                        const f32x4 r14 = *(const PG8_LAS f32x4*)xp, r15 = *(const PG8_LAS f32x4*)(xp + 64); h1[bj] = r15; h2[bj] = fr == 0 ? r14 : r15; }
                    else { h1[bj] = (f32x4){0.f, 0.f, 0.f, 0.f}; h2[bj] = h1[bj]; }
                }
#pragma unroll
                for (int m = 0; m < 4; ++m) {
                    f32x4 cur[2], uo[2];
#pragma unroll
                    for (int bj = 0; bj < 2; ++bj) { cur[bj] = acc[ai][bj][m][n] * rs[ai][m];
#pragma unroll
                        for (int k = 0; k < 4; ++k) {
                            const float r1 = m == 0 ? h1[bj][k] : dpp<0x121>(0.f, prev[bj][k]), r2 = m == 0 ? h2[bj][k] : dpp<0x122>(0.f, prev[bj][k]);
                            const float t1 = dpp<0x111>(r1, cur[bj][k]), t2 = dpp<0x112>(r2, cur[bj][k]);
                            uo[bj][k] = w[bj][0][k] * t2 + w[bj][1][k] * t1 + w[bj][2][k] * cur[bj][k] + bb[bj][k]; }
                        prev[bj] = cur[bj]; }
                    f32x4 a;
#pragma unroll
                    for (int k = 0; k < 4; ++k) a[k] = uo[0][k] * __builtin_amdgcn_rcpf(1.0f + __expf(-uo[0][k])) * uo[1][k];
                    u32x2 o; o.x = cvt_pk_bf16(a[0], a[1]); o.y = cvt_pk_bf16(a[2], a[3]);
                    *(u32x2*)(ACT + (size_t)(row0 + ai * HALF + m * 16) * 2816 + colg + 4 * n) = o;
                }
            }
        }
#ifdef DUP_EPC
        }
#endif
        (void)seq_start;
#undef EPC_LOADW
    }
};
template <class Epi, class Sched, bool ALIGN_EPI = false, bool SP2 = false>
__device__ __forceinline__ void gemm_phase(PG8_LAS unsigned char* lds, const Gemm g, const Sched& S, const Epi& E) {
    int tid_ = threadIdx.x; asm volatile("" : "+v"(tid_));
    const int tid = tid_, wid = __builtin_amdgcn_readfirstlane(tid >> 6), lane = tid & 63, wr = wid >> 2, wc = wid & 3, fr = lane & 15, fq = lane >> 4;
    const int K = g.K, nt = K / BK;
    unsigned voffA[2], voffB[2];
#pragma unroll
    for (int i = 0; i < 2; ++i) { int R, C; stage_rc(tid * 16 + i * 8192, R, C); const int Rb = Epi::PERM ? ((R & ~31) + perm32(R & 31)) : R;
        voffA[i] = (unsigned)(R * K + C) * 2u; voffB[i] = (unsigned)(Rb * K + C) * 2u; }
    const size_t kstep = (size_t)(BK * 2);
    const size_t hstep = (size_t)HALF * K * 2;
    const size_t tstep = 2 * hstep;
    const unsigned ldsw = (unsigned)wid * 1024u;
    const int aoff = lds_byte(wr * 64 + fr, fq * 8), boff = lds_byte(wc * 32 + fr, fq * 8);
#define PG8_SA(b, h) (((b) * 2 + (h)) * HTB)
#define PG8_SB(b, h) ((4 + (b) * 2 + (h)) * HTB)
#define PG8_STAGE(bufoff, gbase, voff) do { _Pragma("unroll") for (int _i = 0; _i < 2; ++_i) \
        __builtin_amdgcn_global_load_lds((const unsigned*)((const char*)(gbase) + (voff)[_i]), (PG8_LAS unsigned*)(lds + (bufoff) + ldsw + _i * 8192), 16, 0, 0); } while (0)
#define PG8_LDA(dst, b, h) do { _Pragma("unroll") for (int m = 0; m < 4; ++m) _Pragma("unroll") for (int k = 0; k < 2; ++k) dst[m][k] = *(const PG8_LAS bf16x8*)(lds + PG8_SA(b, h) + aoff + m * 2048 + k * 1024); } while (0)
#define PG8_LDB(dst, b, h) do { _Pragma("unroll") for (int n = 0; n < 2; ++n) _Pragma("unroll") for (int k = 0; k < 2; ++k) dst[n][k] = *(const PG8_LAS bf16x8*)(lds + PG8_SB(b, h) + boff + n * 2048 + k * 1024); } while (0)
#define PG8_MMA(ai, bj, At, Bt) do { __builtin_amdgcn_s_setprio(1); _Pragma("unroll") for (int m = 0; m < 4; ++m) _Pragma("unroll") for (int n = 0; n < 2; ++n) _Pragma("unroll") for (int k = 0; k < 2; ++k) \
        acc[ai][bj][m][n] = __builtin_amdgcn_mfma_f32_16x16x32_bf16(Bt[n][k], At[m][k], acc[ai][bj][m][n], 0, 0, 0); __builtin_amdgcn_s_setprio(0); } while (0)
#define PG8_WAIT_V(n) asm volatile("s_waitcnt vmcnt(" #n ")" ::: "memory")
#define PG8_WAIT_L(n) asm volatile("s_waitcnt lgkmcnt(" #n ")" ::: "memory")
#define PG8_BAR __builtin_amdgcn_s_barrier()
#define PG8_SCHED __builtin_amdgcn_sched_barrier(0)
    Unit cur, nxt; int ui = 0;
    if (!S.next(0, cur)) return;
    f32x4 acc[2][2][4][2];
#pragma unroll
    for (int a = 0; a < 2; ++a)
#pragma unroll
        for (int b = 0; b < 2; ++b)
#pragma unroll
            for (int m = 0; m < 4; ++m)
#pragma unroll
                for (int n = 0; n < 2; ++n) acc[a][b][m][n] = (f32x4){0.f, 0.f, 0.f, 0.f};
    bf16x8 At[4][2], B0[2][2], B1[2][2];
    const char* cA = (const char*)g.A + (size_t)cur.pm * tstep; const char* cB = (const char*)g.Bt + (size_t)cur.pn * tstep;
    S.a_ready(cur);
    if constexpr (SP2) {
        PG8_STAGE(PG8_SB(0, 0), cB, voffB); PG8_STAGE(PG8_SB(0, 1), cB + hstep, voffB); PG8_STAGE(PG8_SA(0, 0), cA, voffA); PG8_STAGE(PG8_SA(0, 1), cA + hstep, voffA);
        if (wr == 1) PG8_BAR;
        PG8_WAIT_V(2); PG8_BAR;
        PG8_STAGE(PG8_SB(1, 0), cB + kstep, voffB); PG8_STAGE(PG8_SA(1, 0), cA + kstep, voffA); PG8_STAGE(PG8_SB(1, 1), cB + hstep + kstep, voffB);
        PG8_WAIT_V(6); PG8_BAR;
    } else {
        PG8_STAGE(PG8_SB(0, 0), cB, voffB); PG8_STAGE(PG8_SA(0, 0), cA, voffA); PG8_STAGE(PG8_SB(0, 1), cB + hstep, voffB); PG8_STAGE(PG8_SA(0, 1), cA + hstep, voffA);
        if (wr == 1) PG8_BAR;
        PG8_WAIT_V(4); PG8_BAR;
        PG8_STAGE(PG8_SB(1, 0), cB + kstep, voffB); PG8_STAGE(PG8_SA(1, 0), cA + kstep, voffA); PG8_STAGE(PG8_SB(1, 1), cB + hstep + kstep, voffB);
        PG8_WAIT_V(6); PG8_BAR;
    }
    for (;;) {
        const bool has_next = S.next(ui + 1, nxt);
        const char* nA = has_next ? (const char*)g.A + (size_t)nxt.pm * tstep : cA; const char* nB = has_next ? (const char*)g.Bt + (size_t)nxt.pn * tstep : cB;
        for (int t = 0; t < nt; t += 2) {
            const bool last = (t == nt - 2);
            const char* a1 = cA + (size_t)(t + 1) * kstep;
            const char* a2 = last ? nA : cA + (size_t)(t + 2) * kstep; const char* b2 = last ? nB : cB + (size_t)(t + 2) * kstep;
            const char* a3 = a2 + kstep; const char* b3 = b2 + kstep;
            if (last && has_next) S.a_ready(nxt);
            if constexpr (SP2) {
            PG8_LDB(B0, 0, 0); PG8_LDB(B1, 0, 1); PG8_SCHED; PG8_LDA(At, 0, 0); PG8_STAGE(PG8_SA(1, 1), a1 + hstep, voffA);
            PG8_WAIT_V(8); PG8_WAIT_L(0); PG8_BAR; PG8_MMA(0, 0, At, B0); PG8_MMA(0, 1, At, B1); PG8_BAR; PG8_SCHED;
            PG8_LDA(At, 0, 1); PG8_STAGE(PG8_SB(0, 0), b2, voffB); PG8_STAGE(PG8_SB(0, 1), b2 + hstep, voffB); PG8_STAGE(PG8_SA(0, 0), a2, voffA);
            PG8_WAIT_V(8); PG8_WAIT_L(0); PG8_BAR; PG8_MMA(1, 0, At, B0); PG8_MMA(1, 1, At, B1); PG8_BAR; PG8_SCHED;
            PG8_LDB(B0, 1, 0); PG8_LDB(B1, 1, 1); PG8_SCHED; PG8_LDA(At, 1, 0); PG8_STAGE(PG8_SA(0, 1), a2 + hstep, voffA);
            PG8_WAIT_V(8); PG8_WAIT_L(0); PG8_BAR; PG8_MMA(0, 0, At, B0); PG8_MMA(0, 1, At, B1); PG8_BAR; PG8_SCHED;
            PG8_LDA(At, 1, 1); PG8_STAGE(PG8_SB(1, 0), b3, voffB); PG8_STAGE(PG8_SB(1, 1), b3 + hstep, voffB); PG8_STAGE(PG8_SA(1, 0), a3, voffA);
            PG8_WAIT_V(8); PG8_WAIT_L(0); PG8_BAR; PG8_MMA(1, 0, At, B0); PG8_MMA(1, 1, At, B1); PG8_BAR; PG8_SCHED;
            } else {
            PG8_LDB(B0, 0, 0); PG8_SCHED; PG8_LDA(At, 0, 0); PG8_STAGE(PG8_SA(1, 1), a1 + hstep, voffA);
            PG8_WAIT_L(8); PG8_BAR; PG8_WAIT_L(0); PG8_MMA(0, 0, At, B0); PG8_BAR; PG8_SCHED;
            PG8_LDB(B1, 0, 1); PG8_STAGE(PG8_SB(0, 0), b2, voffB);
            PG8_BAR; PG8_WAIT_L(0); PG8_MMA(0, 1, At, B1); PG8_BAR;
            PG8_LDA(At, 0, 1); PG8_STAGE(PG8_SA(0, 0), a2, voffA);
            PG8_BAR; PG8_WAIT_L(0); PG8_MMA(1, 0, At, B0); PG8_BAR; PG8_SCHED;
            PG8_STAGE(PG8_SB(0, 1), b2 + hstep, voffB);
            PG8_WAIT_V(6); PG8_BAR; PG8_MMA(1, 1, At, B1); PG8_BAR;
            PG8_LDB(B0, 1, 0); PG8_SCHED; PG8_LDA(At, 1, 0); PG8_STAGE(PG8_SA(0, 1), a2 + hstep, voffA);
            PG8_WAIT_L(8); PG8_BAR; PG8_WAIT_L(0); PG8_MMA(0, 0, At, B0); PG8_BAR; PG8_SCHED;
            PG8_LDB(B1, 1, 1); PG8_STAGE(PG8_SB(1, 0), b3, voffB);
            PG8_BAR; PG8_WAIT_L(0); PG8_MMA(0, 1, At, B1); PG8_BAR;
            PG8_LDA(At, 1, 1); PG8_STAGE(PG8_SA(1, 0), a3, voffA);
            PG8_BAR; PG8_WAIT_L(0); PG8_MMA(1, 0, At, B0); PG8_BAR; PG8_SCHED;
            PG8_STAGE(PG8_SB(1, 1), b3 + hstep, voffB);
            PG8_WAIT_V(6); PG8_BAR; PG8_MMA(1, 1, At, B1); PG8_BAR;
            }
        }
        if constexpr (ALIGN_EPI) { if (wr == 0) PG8_BAR; }
        if constexpr (!Epi::AFTER_DRAIN) { E(acc, cur, wr, wc, fr, fq);
#ifdef DUP_EPI
            if constexpr (Epi::PROBE_DUP) { asm volatile("" ::: "memory"); E(acc, cur, wr, wc, fr, fq); }
#endif
            S.done(cur); }
        if (!has_next) break;
#pragma unroll
        for (int a = 0; a < 2; ++a)
#pragma unroll
            for (int b = 0; b < 2; ++b)
#pragma unroll
                for (int m = 0; m < 4; ++m)
#pragma unroll
                    for (int n = 0; n < 2; ++n) acc[a][b][m][n] = (f32x4){0.f, 0.f, 0.f, 0.f};
        cur = nxt; cA = nA; cB = nB; ++ui;
        if constexpr (ALIGN_EPI) { if (wr == 1) PG8_BAR; }
    }
    PG8_WAIT_V(0);
    if constexpr (!ALIGN_EPI) { if (wr == 0) PG8_BAR; }
    PG8_BAR;
    if constexpr (Epi::AFTER_DRAIN) { E.fused(acc, cur, wr, wc, fr, fq, lds, wid, lane); S.done(cur); }
#undef PG8_SA
#undef PG8_SB
#undef PG8_STAGE
#undef PG8_LDA
#undef PG8_LDB
#undef PG8_MMA
#undef PG8_WAIT_V
#undef PG8_WAIT_L
#undef PG8_BAR
#undef PG8_SCHED
}
}
constexpr int BATCH = 16, SEQ = 2048, DM = 1024, MTOK = BATCH * SEQ, DEPTH = 2;
constexpr int IN_COLS = 3612, NP = 3584, N1 = 3840, DFF = 2816, NUP = 5632;
constexpr int NWAVES = 8, NTHREADS = 512;
constexpr int LDS_BYTES = 163840;
#define GAS __attribute__((address_space(1)))
#define LAS __attribute__((address_space(3)))
typedef unsigned short bf16;
typedef float f32x4 __attribute__((ext_vector_type(4)));
typedef unsigned v4u __attribute__((ext_vector_type(4)));
typedef unsigned v2u __attribute__((ext_vector_type(2)));
#define LDS_WAIT() asm volatile("s_waitcnt lgkmcnt(0)" ::: "memory")

constexpr size_t MiB = 1u << 20;
constexpr size_t WS_SS = 0;
constexpr size_t WS_BAR = 1536 * 1024;
constexpr size_t WS_CF = 1 * MiB;
constexpr size_t WS_W1T = 2 * MiB;
constexpr size_t WS_WOT = 17 * MiB;
constexpr size_t WS_WUT = 21 * MiB;
constexpr size_t WS_WDT = 43 * MiB;
constexpr size_t WS_FF = 54 * MiB;
constexpr size_t WS_XB = 56 * MiB;
constexpr size_t WS_P = 120 * MiB;
constexpr size_t WS_PS = 344 * MiB;
constexpr size_t WS_O = 348 * MiB;
constexpr size_t WS_GQ = 412 * MiB;
constexpr size_t WS_HALO = 476 * MiB;
constexpr size_t WS_ACT = 296 * MiB;
constexpr size_t WS_END = 508 * MiB;

__device__ __forceinline__ float bf2f(unsigned u) { return __uint_as_float(u << 16); }
__device__ __forceinline__ unsigned f2bf(float f) { unsigned u = __float_as_uint(f); return (u + 0x7fffu + ((u >> 16) & 1u)) >> 16; }
typedef float f32x2_t __attribute__((ext_vector_type(2))); typedef __bf16 bf16x2_t __attribute__((ext_vector_type(2)));
__device__ __forceinline__ unsigned pk2(float lo, float hi) { f32x2_t v = {lo, hi}; bf16x2_t r = __builtin_convertvector(v, bf16x2_t); return __builtin_bit_cast(unsigned, r); }
__device__ __forceinline__ float xsum16(float x) { return x + __shfl_xor(x, 16); }
__device__ __forceinline__ float xsum32(float x) { return x + __shfl_xor(x, 32); }
__device__ __forceinline__ float xmax16(float x) { return fmaxf(x, __shfl_xor(x, 16)); }
__device__ __forceinline__ float xmax32(float x) { return fmaxf(x, __shfl_xor(x, 32)); }
__device__ __forceinline__ float wave_sum(float v) {
#pragma unroll
    for (int o = 1; o < 64; o <<= 1) v += __shfl_xor(v, o);
    return v;
}
__device__ __forceinline__ float rcpf_(float x) { return __builtin_amdgcn_rcpf(x); }
__device__ __forceinline__ float rsqf_(float x) { return __builtin_amdgcn_rsqf(x); }
__device__ __forceinline__ float sigmoidf_(float x) { return rcpf_(1.0f + __expf(-x)); }
__device__ __forceinline__ float siluf_(float x) { return x * rcpf_(1.0f + __expf(-x)); }
__device__ __forceinline__ float softplusf_(float x) { return x > 20.f ? x : __logf(1.0f + __expf(x)); }
__device__ __forceinline__ float logsigmoidf_(float x) { return fminf(x, 0.f) - __logf(1.0f + __expf(-fabsf(x))); }
__device__ __forceinline__ void unpack8(const v4u w, float* f) {
    f[0] = __uint_as_float(w.x << 16); f[1] = __uint_as_float(w.x & 0xffff0000u); f[2] = __uint_as_float(w.y << 16); f[3] = __uint_as_float(w.y & 0xffff0000u);
    f[4] = __uint_as_float(w.z << 16); f[5] = __uint_as_float(w.z & 0xffff0000u); f[6] = __uint_as_float(w.w << 16); f[7] = __uint_as_float(w.w & 0xffff0000u);
}

__device__ __forceinline__ int map_w1(int j) {
    const int t = j >> 8, i = j & 255;
    if (t < 2) return t * 256 + 64 * ((i >> 5) & 3) + 32 * (i >> 7) + (i & 31);
    if (t < 3) return j;
    if (t < 6) return 772 + (t - 3) * 256 + i;
    if (t == 6) return 1548 + i;
    if (t == 7 || t == 8) { const int bj = i >> 7, wc = (i >> 5) & 3, x = i & 31; return (bj ? 2060 : 1804) + (2 * (t - 7) + (wc >> 1)) * 64 + 32 * (wc & 1) + x; }
    if (t < 12) return 1804 + (t - 7) * 256 + i;
    if (t == 12) return 3084 + i;
    if (t == 13) return 3356 + i;
    if (i < 4) return 768 + i;
    if (i < 8) return 1540 + (i - 4);
    if (i < 12) return 1544 + (i - 8);
    if (i < 28) return 3340 + (i - 12);
    return -1;
}
template <int MAPKIND>
__device__ __forceinline__ void transpose_item(const float* W, int K, int N, bf16* WT, const float* gk, LAS float* scr, int item, int nblk, int lane) {
    const int kb = item / nblk, nb = item % nblk, k0 = 64 * kb, n0 = 32 * nb;
    const int jn = n0 + (lane & 31);
    const int src = MAPKIND == 1 ? map_w1(jn) : MAPKIND == 2 ? ((jn >> 8) * 128 + (jn & 127) + ((jn & 128) ? DFF : 0)) : jn;
    const int srcc = src >= 0 ? src : 0; const float keep = src >= 0 ? 1.f : 0.f;
    float wv[32], gv[32];
#pragma unroll
    for (int i = 0; i < 32; ++i) { const int kk = 2 * i + (lane >> 5); wv[i] = W[(size_t)(k0 + kk) * N + srcc]; gv[i] = gk ? gk[k0 + kk] : 1.f; }
#pragma unroll
    for (int i = 0; i < 32; ++i) { const int kk = 2 * i + (lane >> 5); scr[kk * 33 + (lane & 31)] = wv[i] * gv[i] * keep; }
    LDS_WAIT();
    const int c = lane & 7;
#pragma unroll
    for (int j = 0; j < 4; ++j) { const int n = (lane >> 3) + 8 * j; const LAS float* s = scr + (8 * c) * 33 + n;
        v4u o; o.x = pk2(s[0 * 33], s[1 * 33]); o.y = pk2(s[2 * 33], s[3 * 33]); o.z = pk2(s[4 * 33], s[5 * 33]); o.w = pk2(s[6 * 33], s[7 * 33]);
        *(v4u*)(WT + (size_t)(n0 + n) * K + k0 + 8 * c) = o; }
    LDS_WAIT();
}

#define CAS __attribute__((address_space(4)))
struct KArgs { const float* in[22]; float* out; unsigned char* ws; };
struct Ctx {
    const CAS KArgs* ka; float* out; unsigned char* ws;
    LAS unsigned char* lds;
    int tid, lane, wave, gw, ngw;
};

__device__ __forceinline__ void p0_prologue(Ctx& C) {
    LAS float* scr = (LAS float*)(C.lds + C.wave * 16384);
    constexpr int I1 = 16 * 120, I2 = 16 * 32, I3 = 16 * 176, I4 = 44 * 32, IL = I1 + I2 + I3 + I4;
    for (int it = C.gw; it < 2 * IL; it += C.ngw) {
        const int l = it / IL; int r = it % IL;
        if (r < I1) { transpose_item<1>(C.ka->in[2] + (size_t)l * DM * IN_COLS, DM, IN_COLS, (bf16*)(C.ws + WS_W1T) + (size_t)l * N1 * DM, C.ka->in[1] + l * DM, scr, r, 120, C.lane); continue; } r -= I1;
        if (r < I2) { transpose_item<0>(C.ka->in[16] + (size_t)l * DM * DM, DM, DM, (bf16*)(C.ws + WS_WOT) + (size_t)l * DM * DM, nullptr, scr, r, 32, C.lane); continue; } r -= I2;
        if (r < I3) { transpose_item<2>(C.ka->in[18] + (size_t)l * DM * NUP, DM, NUP, (bf16*)(C.ws + WS_WUT) + (size_t)l * NUP * DM, C.ka->in[17] + l * DM, scr, r, 176, C.lane); continue; } r -= I3;
        transpose_item<0>(C.ka->in[21] + (size_t)l * DFF * DM, DFF, DM, (bf16*)(C.ws + WS_WDT) + (size_t)l * DM * DFF, nullptr, scr, r, 32, C.lane);
    }
    float* ss = (float*)(C.ws + WS_SS);
    bf16* XB = (bf16*)(C.ws + WS_XB);
    for (int m0 = C.gw * 4; m0 < MTOK; m0 += C.ngw * 4) {
        f32x4 v[4][4];
#pragma unroll
        for (int r = 0; r < 4; ++r) { const f32x4* xr = (const f32x4*)(C.ka->in[0] + (size_t)(m0 + r) * DM) + C.lane;
#pragma unroll
            for (int j = 0; j < 4; ++j) v[r][j] = xr[64 * j]; }
#pragma unroll
        for (int r = 0; r < 4; ++r) { unsigned long long* o8 = (unsigned long long*)(XB + (size_t)(m0 + r) * DM) + C.lane; float s = 0.f;
#pragma unroll
            for (int j = 0; j < 4; ++j) { const f32x4 w = v[r][j]; s += (w.x * w.x + w.y * w.y) + (w.z * w.z + w.w * w.w);
                o8[64 * j] = (unsigned long long)pk2(w.x, w.y) | ((unsigned long long)pk2(w.z, w.w) << 32); }
            s = wave_sum(s);
            if (C.lane == 0) ss[m0 + r] = s; }
    }
    for (int i = blockIdx.x * NTHREADS + C.tid; i < 3 * MTOK; i += gridDim.x * NTHREADS) ss[MTOK + i] = 0.f;
}

__device__ __forceinline__ void m0_prep(Ctx& C, int l) {
    bf16* P = (bf16*)(C.ws + WS_P); const float* PS = (const float*)(C.ws + WS_PS); float* CF = (float*)(C.ws + WS_CF);
    const float* qn_g = C.ka->in[3] + l * 64; const float* kn_g = C.ka->in[4] + l * 64; const float* b_f = C.ka->in[5] + l * 4; const float* cw = C.ka->in[7] + l * 4 * 768;
    const int lane = C.lane;
    for (int bh = C.gw; bh < 64; bh += C.ngw) {
        const int b = bh >> 2, h = bh & 3; const float bias = b_f[h];
        const size_t r0 = (size_t)b * SEQ + lane * 32;
        float v[32]; (void)r0;
        { const f32x4* fp = (const f32x4*)((const float*)(C.ws + WS_FF) + (size_t)bh * SEQ + lane * 32);
#pragma unroll
          for (int i = 0; i < 8; ++i) { const f32x4 q4 = fp[i]; v[4 * i] = q4.x; v[4 * i + 1] = q4.y; v[4 * i + 2] = q4.z; v[4 * i + 3] = q4.w; } }
        float run = 0.f;
#pragma unroll
        for (int i = 0; i < 32; ++i) { run += logsigmoidf_(v[i] + bias); v[i] = run; }
        float inc = run;
#pragma unroll
        for (int o = 1; o < 64; o <<= 1) { const float t = __shfl_up(inc, o); if (lane >= o) inc += t; }
        const float ex = inc - run;
        float* cf = CF + (size_t)bh * SEQ + lane * 32;
#pragma unroll
        for (int i = 0; i < 32; i += 4) *(f32x4*)(cf + i) = (f32x4){ex + v[i], ex + v[i + 1], ex + v[i + 2], ex + v[i + 3]} * 1.4426950408889634f;
    }
}
#define XB_TMO      128
#define XB_XCNT(j)  (256  + 64 * (j))
#define XB_XSUB(j)  (1280 + 64 * (j))
#define XB_XGEN(j)  (2304 + 64 * (j))
#define XB_TOP      3328
#define XB_TOPGEN   3392
#define XCD_BAR_WORDS 3456
#define XB_SPIN_CAP (1u << 18)

__device__ __forceinline__ unsigned xb_ld(unsigned* p)              { return __hip_atomic_load(p, __ATOMIC_RELAXED, __HIP_MEMORY_SCOPE_AGENT); }
__device__ __forceinline__ unsigned xb_add(unsigned* p, unsigned v) { return __hip_atomic_fetch_add(p, v, __ATOMIC_RELAXED, __HIP_MEMORY_SCOPE_AGENT); }
__device__ __forceinline__ unsigned xb_xcc_id() { return (unsigned)__builtin_amdgcn_s_getreg((3 << 11) | 20) & 0xFu; }
#define XB_SPIN(cond, bar) do { unsigned _sp = 0; while (cond) { __builtin_amdgcn_s_sleep(1); \
    if ((++_sp & 255u) == 0u) { if (xb_ld(&(bar)[XB_TMO])) break; if (_sp > XB_SPIN_CAP) { atomicAdd(&(bar)[XB_TMO], 1u); break; } } } } while (0)

struct XcdBarrier {
    unsigned* bar; unsigned x;
    volatile LAS unsigned* st;
};

__device__ __forceinline__ XcdBarrier xcd_barrier_post(unsigned* bar, volatile LAS unsigned* st) {
    XcdBarrier b; b.bar = bar; b.x = xb_xcc_id(); b.st = st;
    if (threadIdx.x == 0) (void)xb_add(&bar[XB_XCNT(b.x)], 1u);
    return b;
}
__device__ __forceinline__ void xcd_barrier_complete(unsigned* bar, unsigned x, unsigned& nloc, unsigned& nx) {
    const unsigned G = gridDim.x * gridDim.y * gridDim.z;
    unsigned sum, cnt, mine, sp = 0u;
    for (;;) {
        sum = 0u; cnt = 0u; mine = 0u;
#pragma unroll
        for (unsigned j = 0; j < 16; ++j) { const unsigned c = xb_ld(&bar[XB_XCNT(j)]); sum += c; cnt += (c > 0u) ? 1u : 0u; mine = (j == x) ? c : mine; }
        if (sum == G) break;
        __builtin_amdgcn_s_sleep(1);
        if ((++sp & 255u) == 0u) { if (xb_ld(&bar[XB_TMO])) break; if (sp > XB_SPIN_CAP) { atomicAdd(&bar[XB_TMO], 1u); break; } }
    }
    nloc = mine > 0u ? mine : 1u; nx = cnt > 0u ? cnt : 1u;
}

__device__ __forceinline__ void xcd_barrier(const XcdBarrier& b) {
    asm volatile("s_waitcnt vmcnt(0)" ::: "memory");
    __syncthreads();
    if (threadIdx.x == 0) {
        unsigned* bar = b.bar;
        __builtin_amdgcn_s_waitcnt(0);
        unsigned nloc = b.st[0], nx = b.st[1];
        if (nloc == 0u) { xcd_barrier_complete(bar, b.x, nloc, nx); b.st[0] = nloc; b.st[1] = nx; }
        const unsigned old = xb_add(&bar[XB_XSUB(b.x)], 1u);
        const unsigned gen = old / nloc;
        if (old + 1u == (gen + 1u) * nloc) {
            __builtin_amdgcn_fence(__ATOMIC_RELEASE, "agent");
            asm volatile("s_waitcnt vmcnt(0)" ::: "memory");
            const unsigned og = xb_add(&bar[XB_TOP], 1u);
            const unsigned tg = og / nx;
            if (og + 1u == (tg + 1u) * nx) xb_add(&bar[XB_TOPGEN], 1u);
            else XB_SPIN(xb_ld(&bar[XB_TOPGEN]) == tg, bar);
            __builtin_amdgcn_fence(__ATOMIC_ACQUIRE, "agent");
            xb_add(&bar[XB_XGEN(b.x)], 1u);
            asm volatile("s_waitcnt vmcnt(0)" ::: "memory");
        } else {
            XB_SPIN(xb_ld(&bar[XB_XGEN(b.x)]) == gen, bar);
            __builtin_amdgcn_fence(__ATOMIC_ACQUIRE, "agent");
            asm volatile("s_waitcnt vmcnt(0)" ::: "memory");
        }
    }
    __syncthreads();
}
typedef short s16x4 __attribute__((ext_vector_type(4)));
constexpr size_t OS_VTH = 0 * MiB, OS_VTG = 16 * MiB, OS_KTH = 32 * MiB, OS_KTG = 48 * MiB, OS_ADH = 56 * MiB, OS_ADG = 58 * MiB;
__device__ __forceinline__ f32x4 mfma16(s16x4 a, s16x4 b, f32x4 c) { return __builtin_amdgcn_mfma_f32_16x16x16bf16_1k(a, b, c, 0, 0, 0); }
__device__ __forceinline__ s16x4 ld8(const bf16* p) { return *(const s16x4*)p; }
__device__ __forceinline__ s16x4 cvt4(f32x4 v) { v2u w; w.x = pk2(v.x, v.y); w.y = pk2(v.z, v.w); return __builtin_bit_cast(s16x4, w); }

struct LinRaw { unsigned short v[16], q[16], k[16]; f32x4 gk4; };
template <int MODE>
__device__ __forceinline__ void lin_stage1_load(Ctx& C, int item, LinRaw& R) {
    const int lane = C.lane, bh = item >> 7, blk = item & 127, b = bh >> 2, h = bh & 3;
    const bf16* P = (const bf16*)(C.ws + WS_P); const size_t row0 = (size_t)b * SEQ + blk * 16;
    const bf16* vp = P + row0 * NP + (MODE == 0 ? 9 : 12) * 256 + h * 64 + lane;
    const bf16* qp = MODE == 0 ? P + row0 * NP + 7 * 256 + h * 64 + lane : P + row0 * NP + 11 * 256 + h * 32 + (lane & 31);
    const bf16* kp = qp + (MODE == 0 ? 256 : 128);
#pragma unroll
    for (int t = 0; t < 16; ++t) { R.q[t] = qp[(size_t)t * NP]; R.k[t] = kp[(size_t)t * NP]; }
    if (MODE == 1) R.gk4 = *(const f32x4*)((const float*)(C.ws + WS_PS) + (row0 + (lane >> 2)) * 32 + 12 + 4 * (lane & 3));
}
template <int MODE>
__device__ __forceinline__ void lin_stage1_finish(Ctx& C, int l, int item, const LinRaw& R, LAS float* gl) {
    constexpr int DK = MODE == 0 ? 64 : 32;
    const int lane = C.lane, bh = item >> 7, blk = item & 127, b = bh >> 2, h = bh & 3;
    bf16* P = (bf16*)(C.ws + WS_P);
    const size_t row0 = (size_t)b * SEQ + blk * 16;
    bf16* Kt = (bf16*)((unsigned char*)C.out + (MODE == 0 ? OS_KTH : OS_KTG)) + (size_t)item * DK * 16;
    bf16* Vt = (bf16*)((unsigned char*)C.out + (MODE == 0 ? OS_VTH : OS_VTG)) + (size_t)item * 64 * 16;
    float* Ad = (float*)((unsigned char*)C.out + (MODE == 0 ? OS_ADH : OS_ADG)) + (size_t)item * DK;
    const int d = lane;
    float la[16], kk[16], qq[16];
    bf16* qp; bf16* kp;
    if (MODE == 0) {
        float lb = 0.f;
        if (l == 1) { const float a0 = C.ka->in[11][h * 64 + d], a1 = C.ka->in[11][256 + h * 64 + d]; lb = rcpf_(1.0f + __expf(a0 - a1)); }
        qp = P + row0 * NP + 7 * 256 + h * 64 + d; kp = qp + 256;
#pragma unroll
        for (int t = 0; t < 16; ++t) { const float qv = bf2f(R.q[t]), fv = bf2f(R.k[t]); const float sg = sigmoidf_(fv);
            la[t] = __logf(lb + (1.0f - lb) * sg); kk[t] = (1.0f - lb) * (1.0f - sg); qq[t] = siluf_(qv) * 0.125f; }
    } else {
        const float* Wg = C.ka->in[13] + l * 16 * 128 + h * 32 + (d & 31); const float bg = C.ka->in[14][l * 128 + h * 32 + (d & 31)];
        float wg[16];
#pragma unroll
        for (int r = 0; r < 16; ++r) wg[r] = Wg[r * 128];
        qp = P + row0 * NP + 11 * 256 + h * 32 + (d & 31); kp = qp + 128;
        *(LAS f32x4*)(gl + lane * 4) = R.gk4;
        LDS_WAIT();
#pragma unroll
        for (int t = 0; t < 16; ++t) { float gk[16];
#pragma unroll
            for (int r4 = 0; r4 < 4; ++r4) { const f32x4 q4 = *(const LAS f32x4*)(gl + t * 16 + 4 * r4); gk[4 * r4] = q4.x; gk[4 * r4 + 1] = q4.y; gk[4 * r4 + 2] = q4.z; gk[4 * r4 + 3] = q4.w; }
            float zz = bg;
#pragma unroll
            for (int r = 0; r < 16; ++r) zz += gk[r] * wg[r];
            la[t] = logsigmoidf_(zz) * (1.0f / 16.0f); kk[t] = bf2f(R.k[t]); qq[t] = bf2f(R.q[t]) * 0.17677669529663687f; }
    }
    if (MODE == 0 || lane < 32) {
        float g = 0.f;
#pragma unroll
        for (int t = 0; t < 16; ++t) { g += la[t]; la[t] = g; }
        unsigned w[8];
#pragma unroll
        for (int t = 0; t < 16; ++t) {
            qp[(size_t)t * NP] = (bf16)f2bf(qq[t] * __expf(la[t]));
            kp[(size_t)t * NP] = (bf16)f2bf(kk[t] * __expf(fminf(-la[t], 80.f)));
            const unsigned kt = f2bf(kk[t] * __expf(g - la[t]));
            if (t & 1) w[t >> 1] |= kt << 16; else w[t >> 1] = kt;
        }
        { v4u* o = (v4u*)(Kt + d * 16); o[0] = (v4u){w[0], w[1], w[2], w[3]}; o[1] = (v4u){w[4], w[5], w[6], w[7]}; }
        Ad[d] = __expf(g);
    }
}
template <int MODE>
__device__ __forceinline__ void lin_stage1_pair(Ctx& C, int l, int itemA, int itemB, LAS unsigned char* wl) {
    LinRaw A, B; lin_stage1_load<MODE>(C, itemA, A); lin_stage1_load<MODE>(C, itemB, B);
    lin_stage1_finish<MODE>(C, l, itemA, A, (LAS float*)wl); lin_stage1_finish<MODE>(C, l, itemB, B, (LAS float*)(wl + 1024));
}
template <int MODE>
__device__ __forceinline__ void lin_stage1_quad(Ctx& C, int l, int item, int stride, LAS unsigned char* wl) {
    LinRaw A, B, D, E; lin_stage1_load<MODE>(C, item, A); lin_stage1_load<MODE>(C, item + stride, B); lin_stage1_load<MODE>(C, item + 2 * stride, D); lin_stage1_load<MODE>(C, item + 3 * stride, E);
    lin_stage1_finish<MODE>(C, l, item, A, (LAS float*)wl); lin_stage1_finish<MODE>(C, l, item + stride, B, (LAS float*)(wl + 1024));
    lin_stage1_finish<MODE>(C, l, item + 2 * stride, D, (LAS float*)(wl + 2048)); lin_stage1_finish<MODE>(C, l, item + 3 * stride, E, (LAS float*)(wl + 3072));
}

struct ScanSeg { const unsigned char* g; unsigned gstride, gstep; int nch, rowch, lpitch, loff; };
constexpr int SCAN_BH_LDS = 11520, SCAN_BUF = 2 * SCAN_BH_LDS, SCAN_XS = 2 * SCAN_BUF;
struct ScanCopy { const unsigned char* gp[3]; unsigned gstep[3]; int loff[3]; };
__device__ __forceinline__ void scan_copy_init(ScanCopy& cp, const ScanSeg (&segs)[2][6], int tid) {
    int per = 0;
#pragma unroll
    for (int s = 0; s < 6; ++s) per += segs[0][s].nch;
#pragma unroll
    for (int j = 0; j < 3; ++j) {
        const int c = tid + 512 * j; cp.gp[j] = nullptr; cp.gstep[j] = 0; cp.loff[j] = 0;
        if (c < 2 * per) {
            const int bhl = c >= per ? 1 : 0; int r = c - bhl * per;
#pragma unroll
            for (int s = 0; s < 6; ++s) {
                const ScanSeg& sg = segs[bhl][s];
                if (r >= 0 && r < sg.nch) {
                    const int row = sg.rowch ? r / sg.rowch : 0, ch = sg.rowch ? r % sg.rowch : r;
                    cp.gp[j] = sg.g + (size_t)row * sg.gstride + ch * 16; cp.gstep[j] = sg.gstep; cp.loff[j] = bhl * SCAN_BH_LDS + sg.loff + row * sg.lpitch + ch * 16;
                }
                r -= sg.nch;
            }
        } else { cp.gp[j] = cp.gp[0]; cp.gstep[j] = cp.gstep[0]; cp.loff[j] = cp.loff[0]; }
    }
}
__device__ __forceinline__ void scan_copy_load(const ScanCopy& cp, v4u (&R)[3], int step) {
#pragma unroll
    for (int j = 0; j < 3; ++j) R[j] = *(const v4u*)(cp.gp[j] + (size_t)step * cp.gstep[j]);
}
__device__ __forceinline__ void scan_copy_store(const ScanCopy& cp, const v4u (&R)[3], LAS unsigned char* buf) {
#pragma unroll
    for (int j = 0; j < 3; ++j) *(LAS v4u*)(buf + cp.loff[j]) = R[j];
}

template <int MODE>
__device__ __forceinline__ void lin_scan(Ctx& C, int l, int bh0) {
    constexpr int DK = MODE == 0 ? 64 : 32, ND = DK / 16, PQ = DK * 2 + 16;
    constexpr int OQ = 0, OK = 16 * PQ, OZ = 2 * 16 * PQ, OKT = OZ + 2304, OVT = OKT + DK * 32, OAD = OVT + 2048;
    static_assert(OAD + DK * 4 <= SCAN_BH_LDS, "scan LDS map");
    const int lane = C.lane, n = lane & 15, g = lane >> 4, et = C.wave & 3, bhl = C.wave >> 2, bh = bh0 + bhl, b = bh >> 2, h = bh & 3;
    const unsigned char* P = C.ws + WS_P; bf16* O = (bf16*)(C.ws + WS_O);
    const float* gain = (MODE == 0 ? C.ka->in[12] : C.ka->in[15]) + l * 64;
    const int ocol = (MODE == 0 ? 512 : 768) + h * 64;
    ScanSeg segs[2][6];
#pragma unroll
    for (int q = 0; q < 2; ++q) {
        const int bq = bh0 + q, hq = bq & 3; const size_t rb = (size_t)(bq >> 2) * SEQ;
        const int qcol = MODE == 0 ? 7 * 256 + hq * 64 : 11 * 256 + hq * 32, kcol = MODE == 0 ? 8 * 256 + hq * 64 : 11 * 256 + 128 + hq * 32, zcol = (MODE == 0 ? 10 : 13) * 256 + hq * 64;
        segs[q][0] = ScanSeg{P + (rb * NP + qcol) * 2, NP * 2, 16 * NP * 2, 16 * (DK / 8), DK / 8, PQ, OQ};
        segs[q][1] = ScanSeg{P + (rb * NP + kcol) * 2, NP * 2, 16 * NP * 2, 16 * (DK / 8), DK / 8, PQ, OK};
        segs[q][2] = ScanSeg{P + (rb * NP + zcol) * 2, NP * 2, 16 * NP * 2, 128, 8, 144, OZ};
        segs[q][3] = ScanSeg{(unsigned char*)C.out + (MODE == 0 ? OS_KTH : OS_KTG) + (size_t)bq * 128 * DK * 32, 0, DK * 32, DK * 2, 0, 0, OKT};
        segs[q][4] = ScanSeg{(unsigned char*)C.out + (MODE == 0 ? OS_VTH : OS_VTG) + (size_t)bq * 128 * 2048, 0, 2048, 128, 0, 0, OVT};
        segs[q][5] = ScanSeg{(unsigned char*)C.out + (MODE == 0 ? OS_ADH : OS_ADG) + (size_t)bq * 128 * DK * 4, 0, DK * 4, DK / 4, 0, 0, OAD};
    }
    ScanCopy cp; scan_copy_init(cp, segs, C.tid);
    LAS unsigned char* lds = C.lds; LAS float* xs = (LAS float*)(lds + SCAN_XS);
    f32x4 S[ND];
#pragma unroll
    for (int i = 0; i < ND; ++i) S[i] = (f32x4){0.f, 0.f, 0.f, 0.f};
    const f32x4 gn = *(const f32x4*)(gain + 16 * et + 4 * g);
    const size_t rowb = (size_t)b * SEQ;
    v4u R[4][3];
    scan_copy_load(cp, R[0], 0); scan_copy_store(cp, R[0], lds);
    scan_copy_load(cp, R[1], 1); scan_copy_load(cp, R[2], 2); scan_copy_load(cp, R[3], 3); scan_copy_load(cp, R[0], 4);
    __syncthreads();
#pragma unroll 1
    for (int blk0 = 0; blk0 < 128; blk0 += 4) {
#pragma unroll
        for (int u = 0; u < 4; ++u) {
            const int blk = blk0 + u;
            scan_copy_store(cp, R[(u + 1) & 3], lds + ((blk + 1) & 1) * SCAN_BUF);
            scan_copy_load(cp, R[(u + 1) & 3], blk + 5 < 128 ? blk + 5 : 127);
            const LAS unsigned char* base = lds + (blk & 1) * SCAN_BUF + bhl * SCAN_BH_LDS;
            s16x4 qf[ND], khf[ND], ktf[ND]; f32x4 ad[ND];
#pragma unroll
            for (int i = 0; i < ND; ++i) { qf[i] = *(const LAS s16x4*)(base + OQ + n * PQ + (16 * i + 4 * g) * 2); khf[i] = *(const LAS s16x4*)(base + OK + n * PQ + (16 * i + 4 * g) * 2);
                ktf[i] = *(const LAS s16x4*)(base + OKT + ((16 * i + n) * 16 + 4 * g) * 2); ad[i] = *(const LAS f32x4*)(base + OAD + (16 * i + 4 * g) * 4); }
            const s16x4 vtf = *(const LAS s16x4*)(base + OVT + ((16 * et + n) * 16 + 4 * g) * 2), zf = *(const LAS s16x4*)(base + OZ + n * 144 + (16 * et + 4 * g) * 2);
            f32x4 at = (f32x4){0.f, 0.f, 0.f, 0.f};
#pragma unroll
            for (int i = 0; i < ND; ++i) at = mfma16(khf[i], qf[i], at);
#pragma unroll
            for (int j = 0; j < 4; ++j) if (4 * g + j > n) at[j] = 0.f;
            f32x4 oT = mfma16(vtf, cvt4(at), (f32x4){0.f, 0.f, 0.f, 0.f});
#pragma unroll
            for (int i = 0; i < ND; ++i) oT = mfma16(cvt4(S[i]), qf[i], oT);
#pragma unroll
            for (int i = 0; i < ND; ++i) S[i] = mfma16(ktf[i], vtf, S[i] * ad[i]);
            float ss = (oT.x * oT.x + oT.y * oT.y) + (oT.z * oT.z + oT.w * oT.w);
            ss = xsum32(xsum16(ss));
            LAS float* xp = xs + (blk & 1) * 128 + bhl * 64;
            if (g == 0) xp[et * 16 + n] = ss;
            __syncthreads();
            ss = (xp[n] + xp[16 + n]) + (xp[32 + n] + xp[48 + n]);
            const float r = rsqf_(ss * (1.0f / 64.0f) + RMS_EPS);
            { const v2u zw = __builtin_bit_cast(v2u, zf);
              const float z0 = bf2f(zw.x & 0xffffu), z1 = bf2f(zw.x >> 16), z2 = bf2f(zw.y & 0xffffu), z3 = bf2f(zw.y >> 16);
              v2u w; w.x = pk2(oT.x * r * gn.x * siluf_(z0), oT.y * r * gn.y * siluf_(z1)); w.y = pk2(oT.z * r * gn.z * siluf_(z2), oT.w * r * gn.w * siluf_(z3));
              *(v2u*)(O + (rowb + blk * 16 + n) * DM + ocol + 16 * et + 4 * g) = w; }
        }
    }
    __syncthreads();
}

struct GlaRaw { unsigned short v[16], q[2][4], k[2][4]; f32x4 gk4; };
struct GlaW { s16x4 bh[2], bl[2]; float bias[2]; };
__device__ __forceinline__ void gla_w_load(Ctx& C, int l, int h, GlaW& W) {
    const int n = C.lane & 15, g = C.lane >> 4;
#pragma unroll
    for (int dt = 0; dt < 2; ++dt) { const float* wp = C.ka->in[13] + l * 16 * 128 + h * 32 + 16 * dt + n; float w[4], lo[4];
#pragma unroll
        for (int j = 0; j < 4; ++j) { w[j] = wp[(4 * g + j) * 128]; lo[j] = w[j] - bf2f(f2bf(w[j])); }
        W.bh[dt] = cvt4((f32x4){w[0], w[1], w[2], w[3]}); W.bl[dt] = cvt4((f32x4){lo[0], lo[1], lo[2], lo[3]});
        W.bias[dt] = C.ka->in[14][l * 128 + h * 32 + 16 * dt + n]; }
}
__device__ __forceinline__ void gla_stage1_load(Ctx& C, int item, GlaRaw& R) {
    const int lane = C.lane, n = lane & 15, g = lane >> 4, bh = item >> 7, blk = item & 127, b = bh >> 2, h = bh & 3;
    const bf16* P = (const bf16*)(C.ws + WS_P); const size_t row0 = (size_t)b * SEQ + blk * 16;
    const bf16* vp = P + row0 * NP + 12 * 256 + h * 64 + lane;
#pragma unroll
    for (int dt = 0; dt < 2; ++dt)
#pragma unroll
        for (int j = 0; j < 4; ++j) { const bf16* qp = P + (row0 + 4 * g + j) * NP + 11 * 256 + h * 32 + 16 * dt + n; R.q[dt][j] = qp[0]; R.k[dt][j] = qp[128]; }
    R.gk4 = *(const f32x4*)((const float*)(C.ws + WS_PS) + (row0 + n) * 32 + 12 + 4 * g);
}
__device__ __forceinline__ void gla_stage1_finish(Ctx& C, int item, const GlaRaw& R, const GlaW& W) {
    const int lane = C.lane, n = lane & 15, g = lane >> 4, bh = item >> 7, blk = item & 127, b = bh >> 2, h = bh & 3;
    bf16* P = (bf16*)(C.ws + WS_P); const size_t row0 = (size_t)b * SEQ + blk * 16;
    bf16* Kt = (bf16*)((unsigned char*)C.out + OS_KTG) + (size_t)item * 32 * 16;
    bf16* Vt = (bf16*)((unsigned char*)C.out + OS_VTG) + (size_t)item * 64 * 16;
    float* Ad = (float*)((unsigned char*)C.out + OS_ADG) + (size_t)item * 32;
    f32x4 alo;
#pragma unroll
    for (int j = 0; j < 4; ++j) alo[j] = R.gk4[j] - bf2f(f2bf(R.gk4[j]));
    const s16x4 ah = cvt4(R.gk4), al = cvt4(alo);
#pragma unroll
    for (int dt = 0; dt < 2; ++dt) {
        f32x4 z = mfma16(ah, W.bh[dt], (f32x4){0.f, 0.f, 0.f, 0.f}); z = mfma16(al, W.bh[dt], z); z = mfma16(ah, W.bl[dt], z);
        float gc[4]; float run = 0.f;
#pragma unroll
        for (int j = 0; j < 4; ++j) { run += logsigmoidf_(z[j] + W.bias[dt]) * (1.0f / 16.0f); gc[j] = run; }
        const float s16 = xsum16(run), p16 = s16 - run, p32 = xsum32(s16) - s16;
        const float ex = ((g & 1) ? p16 : 0.f) + ((g & 2) ? p32 : 0.f), glast = s16 + p32;
        bf16* qp = P + (row0 + 4 * g) * NP + 11 * 256 + h * 32 + 16 * dt + n;
        float kt[4];
#pragma unroll
        for (int j = 0; j < 4; ++j) { const float G = ex + gc[j], kv = bf2f(R.k[dt][j]);
            qp[(size_t)j * NP] = (bf16)f2bf(bf2f(R.q[dt][j]) * 0.17677669529663687f * __expf(G));
            qp[(size_t)j * NP + 128] = (bf16)f2bf(kv * __expf(fminf(-G, 80.f)));
            kt[j] = kv * __expf(glast - G); }
        *(s16x4*)(Kt + (16 * dt + n) * 16 + 4 * g) = cvt4((f32x4){kt[0], kt[1], kt[2], kt[3]});
        if (g == 0) Ad[16 * dt + n] = __expf(glast);
    }
}
__device__ __forceinline__ void gla_stage1_pair(Ctx& C, int itemA, int itemB, const GlaW& W) {
    GlaRaw A, B; gla_stage1_load(C, itemA, A); gla_stage1_load(C, itemB, B);
    gla_stage1_finish(C, itemA, A, W); gla_stage1_finish(C, itemB, B, W);
}
constexpr size_t WS_GD_Q = 412 * MiB, WS_GD_W = 428 * MiB, WS_GD_KT = 444 * MiB, WS_GD_UT = 460 * MiB, WS_GD_AQ = 476 * MiB, WS_GD_AB = 480 * MiB;
typedef unsigned short us2_t __attribute__((ext_vector_type(2)));
struct GdnRaw { us2_t r[3][10]; float pb, pa; };
__device__ __forceinline__ void gdn_stage1_load(Ctx& C, int item, GdnRaw& R) {
    const int lane = C.lane, bh = item >> 7, blk = item & 127, b = bh >> 2, h = bh & 3;
    const bf16* P = (const bf16*)(C.ws + WS_P); const float* PS = (const float*)(C.ws + WS_PS);
    const size_t row0 = (size_t)b * SEQ + blk * 16;
#pragma unroll
    for (int part = 0; part < 3; ++part) { const bf16* rp = P + row0 * NP + 768 + part * 256 + h * 64 + lane;
#pragma unroll
        for (int i = 0; i < 19; ++i) R.r[part][i >> 1][i & 1] = rp[(long)((blk * 16 + i - 3 >= 0) ? i - 3 : 0) * NP]; }
    const float* ps = PS + (row0 + (lane & 15)) * 32; R.pb = ps[4 + h]; R.pa = ps[8 + h];
}
__device__ __forceinline__ void gdn_stage1_finish(Ctx& C, int l, int item, const GdnRaw& R, LAS unsigned char* wl) {
    const int lane = C.lane, bh = item >> 7, blk = item & 127, b = bh >> 2, h = bh & 3, n = lane & 15, g = lane >> 4;
    const size_t row0 = (size_t)b * SEQ + blk * 16;
    bf16* Qg = (bf16*)(C.ws + WS_GD_Q) + row0 * 256 + h * 64; bf16* Wg = (bf16*)(C.ws + WS_GD_W) + row0 * 256 + h * 64;
    bf16* Ktg = (bf16*)(C.ws + WS_GD_KT) + (size_t)item * 1024; bf16* Utg = (bf16*)(C.ws + WS_GD_UT) + (size_t)item * 1024;
    bf16* Aqg = (bf16*)(C.ws + WS_GD_AQ) + (size_t)item * 256; float* Abg = (float*)(C.ws + WS_GD_AB);
    LAS bf16* qh = (LAS bf16*)wl; LAS bf16* kh = qh + 1024; LAS bf16* kT = kh + 1024; LAS bf16* vT = kT + 1024;
    LAS float* Ms = (LAS float*)(wl + 8192); LAS bf16* Xw = (LAS bf16*)(wl + 9216); LAS bf16* Xu = Xw + 256; LAS float* sc = (LAS float*)(wl + 10240);
    {
        const float Acoef = -__expf(C.ka->in[8][l * 4 + h]), dtb = C.ka->in[9][l * 4 + h];
        const float beta = sigmoidf_(R.pb); float gc = Acoef * softplusf_(R.pa + dtb);
#pragma unroll
        for (int o = 1; o < 16; o <<= 1) { const float t = __shfl_up(gc, o); if (n >= o) gc += t; }
        if (lane < 16) { sc[lane] = beta; sc[16 + lane] = gc; }
    }
    LDS_WAIT();
    float gc[16];
#pragma unroll
    for (int t = 0; t < 16; t += 4) { const f32x4 v = *(const LAS f32x4*)(sc + 16 + t); gc[t] = v.x; gc[t + 1] = v.y; gc[t + 2] = v.z; gc[t + 3] = v.w; }
    const float glast = gc[15];
    const float* cw = C.ka->in[7] + l * 4 * 768 + h * 64 + lane;
    float raw[3][19];
#pragma unroll
    for (int part = 0; part < 3; ++part)
#pragma unroll
        for (int i = 0; i < 19; ++i) raw[part][i] = (i >= 3 || blk > 0) ? bf2f(R.r[part][i >> 1][i & 1]) : 0.f;
    float kraw[16];
#pragma unroll
    for (int part = 0; part < 3; ++part) {
        const float w0 = cw[part * 256], w1 = cw[768 + part * 256], w2 = cw[2 * 768 + part * 256], w3 = cw[3 * 768 + part * 256];
        float y[16];
#pragma unroll
        for (int t = 0; t < 16; ++t) y[t] = siluf_(w0 * raw[part][t] + w1 * raw[part][t + 1] + w2 * raw[part][t + 2] + w3 * raw[part][t + 3]);
        if (part == 0) {
#pragma unroll
            for (int t = 0; t < 16; ++t) qh[t * 64 + lane] = (bf16)f2bf(y[t]);
        } else if (part == 1) {
            unsigned w[8];
#pragma unroll
            for (int t = 0; t < 16; ++t) { kh[t * 64 + lane] = (bf16)f2bf(y[t]); kraw[t] = y[t]; }
#pragma unroll
            for (int t = 0; t < 16; t += 2) w[t >> 1] = pk2(y[t], y[t + 1]);
            LAS v4u* o = (LAS v4u*)(kT + lane * 16); o[0] = (v4u){w[0], w[1], w[2], w[3]}; o[1] = (v4u){w[4], w[5], w[6], w[7]};
        } else {
            unsigned w[8];
#pragma unroll
            for (int t = 0; t < 16; t += 2) w[t >> 1] = pk2(y[t], y[t + 1]);
            LAS v4u* o = (LAS v4u*)(vT + lane * 16); o[0] = (v4u){w[0], w[1], w[2], w[3]}; o[1] = (v4u){w[4], w[5], w[6], w[7]};
        }
    }
    LDS_WAIT();
    f32x4 ckk = (f32x4){0.f, 0.f, 0.f, 0.f}, cqk = ckk, cqq = ckk;
#pragma unroll
    for (int i = 0; i < 4; ++i) { const s16x4 kf = *(const LAS s16x4*)(kh + n * 64 + 16 * i + 4 * g), qf = *(const LAS s16x4*)(qh + n * 64 + 16 * i + 4 * g);
        ckk = mfma16(kf, kf, ckk); cqk = mfma16(kf, qf, cqk); cqq = mfma16(qf, qf, cqq); }
    if (g == (n >> 2)) { const int j = n & 3; sc[32 + n] = rsqf_(ckk[j] + RMS_EPS); sc[48 + n] = rsqf_(cqq[j] + RMS_EPS) * 0.125f; }
    LDS_WAIT();
    float rnk[16], rnq[16];
#pragma unroll
    for (int t = 0; t < 16; t += 4) { const f32x4 a = *(const LAS f32x4*)(sc + 32 + t), c2 = *(const LAS f32x4*)(sc + 48 + t);
        rnk[t] = a.x; rnk[t + 1] = a.y; rnk[t + 2] = a.z; rnk[t + 3] = a.w; rnq[t] = c2.x; rnq[t + 1] = c2.y; rnq[t + 2] = c2.z; rnq[t + 3] = c2.w; }
    {
#pragma unroll
        for (int t = 0; t < 16; ++t) Qg[(size_t)t * 256 + lane] = (bf16)f2bf(bf2f(qh[t * 64 + lane]) * rnq[t] * __expf(gc[t]));
        unsigned wk[8];
#pragma unroll
        for (int t = 0; t < 16; t += 2) wk[t >> 1] = pk2(kraw[t] * rnk[t] * __expf(glast - gc[t]), kraw[t + 1] * rnk[t + 1] * __expf(glast - gc[t + 1]));
        v4u* og = (v4u*)(Ktg + lane * 16); og[0] = (v4u){wk[0], wk[1], wk[2], wk[3]}; og[1] = (v4u){wk[4], wk[5], wk[6], wk[7]};
    }
    { const float rkr = sc[32 + n], rqr = sc[48 + n]; const f32x4 rks = *(const LAS f32x4*)(sc + 32 + 4 * g);
#pragma unroll
      for (int j = 0; j < 4; ++j) { ckk[j] *= rks[j] * rkr; cqk[j] *= rks[j] * rqr; } }
    const float Gr = sc[16 + n], beta_r = sc[n];
    const f32x4 Gs = *(const LAS f32x4*)(sc + 16 + 4 * g);
    f32x4 mv, av;
#pragma unroll
    for (int j = 0; j < 4; ++j) { const int s = 4 * g + j; const float dec = __expf(Gr - Gs[j]); mv[j] = s < n ? beta_r * ckk[j] * dec : 0.f; av[j] = s <= n ? cqk[j] * dec : 0.f; }
    *(LAS f32x4*)(Ms + n * 16 + 4 * g) = mv;
    *(s16x4*)(Aqg + n * 16 + 4 * g) = cvt4(av);
    LDS_WAIT();
    float X[16];
    X[0] = (n == 0) ? 1.f : 0.f;
#pragma unroll
    for (int r = 1; r < 16; ++r) {
        float a0 = (n == r) ? 1.f : 0.f, a1 = 0.f;
#pragma unroll
        for (int s4 = 0; s4 < r; s4 += 4) { const f32x4 m4 = *(const LAS f32x4*)(Ms + r * 16 + s4);
            a0 -= m4.x * X[s4]; if (s4 + 1 < r) a1 -= m4.y * X[s4 + 1]; if (s4 + 2 < r) a0 -= m4.z * X[s4 + 2]; if (s4 + 3 < r) a1 -= m4.w * X[s4 + 3]; }
        X[r] = a0 + a1;
    }
    { const float bu = sc[n], bw = bu * __expf(sc[16 + n]) * sc[32 + n];
      if (lane < 16) {
#pragma unroll
          for (int r = 0; r < 16; ++r) { Xw[r * 16 + n] = (bf16)f2bf(X[r] * bw); Xu[r * 16 + n] = (bf16)f2bf(X[r] * bu); } } }
    LDS_WAIT();
    const s16x4 xwf = *(const LAS s16x4*)(Xw + n * 16 + 4 * g), xuf = *(const LAS s16x4*)(Xu + n * 16 + 4 * g);
#pragma unroll
    for (int i = 0; i < 4; ++i) {
        const f32x4 cwt = mfma16(*(const LAS s16x4*)(kT + (16 * i + n) * 16 + 4 * g), xwf, (f32x4){0.f, 0.f, 0.f, 0.f});
        *(s16x4*)(Wg + (size_t)n * 256 + 16 * i + 4 * g) = cvt4(cwt);
        const f32x4 cut = mfma16(xuf, *(const LAS s16x4*)(vT + (16 * i + n) * 16 + 4 * g), (f32x4){0.f, 0.f, 0.f, 0.f});
        *(s16x4*)(Utg + (16 * i + n) * 16 + 4 * g) = cvt4(cut);
    }
    if (lane == 0) Abg[item] = __expf(glast);
    LDS_WAIT();
}

__device__ __forceinline__ void gdn_scan(Ctx& C, int l, int bh0) {
    constexpr int OQ = 0, OW = 2304, OZ = 4608, OKT = 6912, OUT = 8960, OAQ = 11008;
    const int lane = C.lane, n = lane & 15, g = lane >> 4, et = C.wave & 3, bhl = C.wave >> 2, bh = bh0 + bhl, b = bh >> 2, h = bh & 3;
    bf16* O = (bf16*)(C.ws + WS_O);
    const float* Abg = (const float*)(C.ws + WS_GD_AB) + bh * 128;
    const float* gain = C.ka->in[10] + l * 64;
    ScanSeg segs[2][6];
#pragma unroll
    for (int q = 0; q < 2; ++q) {
        const int bq = bh0 + q, hq = bq & 3; const size_t rb = (size_t)(bq >> 2) * SEQ;
        segs[q][0] = ScanSeg{C.ws + WS_GD_Q + (rb * 256 + hq * 64) * 2, 512, 16 * 512, 128, 8, 144, OQ};
        segs[q][1] = ScanSeg{C.ws + WS_GD_W + (rb * 256 + hq * 64) * 2, 512, 16 * 512, 128, 8, 144, OW};
        segs[q][2] = ScanSeg{C.ws + WS_P + (rb * NP + 1536 + hq * 64) * 2, NP * 2, 16 * NP * 2, 128, 8, 144, OZ};
        segs[q][3] = ScanSeg{C.ws + WS_GD_KT + (size_t)bq * 128 * 2048, 0, 2048, 128, 0, 0, OKT};
        segs[q][4] = ScanSeg{C.ws + WS_GD_UT + (size_t)bq * 128 * 2048, 0, 2048, 128, 0, 0, OUT};
        segs[q][5] = ScanSeg{C.ws + WS_GD_AQ + (size_t)bq * 128 * 512, 0, 512, 32, 0, 0, OAQ};
    }
    ScanCopy cp; scan_copy_init(cp, segs, C.tid);
    LAS unsigned char* lds = C.lds; LAS float* xs = (LAS float*)(lds + SCAN_XS);
    f32x4 S[4];
#pragma unroll
    for (int i = 0; i < 4; ++i) S[i] = (f32x4){0.f, 0.f, 0.f, 0.f};
    const f32x4 gn = *(const f32x4*)(gain + 16 * et + 4 * g);
    const size_t rowb = (size_t)b * SEQ;
    v4u R[4][3]; float abr[4];
    scan_copy_load(cp, R[0], 0); scan_copy_store(cp, R[0], lds);
    scan_copy_load(cp, R[1], 1); scan_copy_load(cp, R[2], 2); scan_copy_load(cp, R[3], 3); scan_copy_load(cp, R[0], 4);
#pragma unroll
    for (int u = 0; u < 4; ++u) abr[u] = Abg[u];
    __syncthreads();
#pragma unroll 1
    for (int blk0 = 0; blk0 < 128; blk0 += 4) {
#pragma unroll
        for (int u = 0; u < 4; ++u) {
            const int blk = blk0 + u;
            scan_copy_store(cp, R[(u + 1) & 3], lds + ((blk + 1) & 1) * SCAN_BUF);
            scan_copy_load(cp, R[(u + 1) & 3], blk + 5 < 128 ? blk + 5 : 127);
            const float ab = abr[u]; abr[u] = Abg[blk + 4 < 128 ? blk + 4 : 127];
            const LAS unsigned char* base = lds + (blk & 1) * SCAN_BUF + bhl * SCAN_BH_LDS;
            s16x4 qf[4], wf[4], ktf[4];
#pragma unroll
            for (int i = 0; i < 4; ++i) { qf[i] = *(const LAS s16x4*)(base + OQ + n * 144 + (16 * i + 4 * g) * 2); wf[i] = *(const LAS s16x4*)(base + OW + n * 144 + (16 * i + 4 * g) * 2);
                ktf[i] = *(const LAS s16x4*)(base + OKT + ((16 * i + n) * 16 + 4 * g) * 2); }
            const s16x4 utf = *(const LAS s16x4*)(base + OUT + ((16 * et + n) * 16 + 4 * g) * 2), zf = *(const LAS s16x4*)(base + OZ + n * 144 + (16 * et + 4 * g) * 2);
            const s16x4 aqf = *(const LAS s16x4*)(base + OAQ + (n * 16 + 4 * g) * 2);
            s16x4 Sb[4];
#pragma unroll
            for (int i = 0; i < 4; ++i) Sb[i] = cvt4(S[i]);
            f32x4 acc = (f32x4){0.f, 0.f, 0.f, 0.f};
#pragma unroll
            for (int i = 0; i < 4; ++i) acc = mfma16(wf[i], Sb[i], acc);
            const v2u uw = __builtin_bit_cast(v2u, utf);
            f32x4 vn; vn.x = bf2f(uw.x & 0xffffu) - acc.x; vn.y = bf2f(uw.x >> 16) - acc.y; vn.z = bf2f(uw.y & 0xffffu) - acc.z; vn.w = bf2f(uw.y >> 16) - acc.w;
            const s16x4 vb = cvt4(vn);
            f32x4 oT = mfma16(vb, aqf, (f32x4){0.f, 0.f, 0.f, 0.f});
#pragma unroll
            for (int i = 0; i < 4; ++i) oT = mfma16(Sb[i], qf[i], oT);
#pragma unroll
            for (int i = 0; i < 4; ++i) S[i] = mfma16(ktf[i], vb, S[i] * ab);
            float ss = (oT.x * oT.x + oT.y * oT.y) + (oT.z * oT.z + oT.w * oT.w);
            ss = xsum32(xsum16(ss));
            LAS float* xp = xs + (blk & 1) * 128 + bhl * 64;
            if (g == 0) xp[et * 16 + n] = ss;
            __syncthreads();
            ss = (xp[n] + xp[16 + n]) + (xp[32 + n] + xp[48 + n]);
            const float r = rsqf_(ss * (1.0f / 64.0f) + RMS_EPS);
            { const v2u zw = __builtin_bit_cast(v2u, zf);
              const float z0 = bf2f(zw.x & 0xffffu), z1 = bf2f(zw.x >> 16), z2 = bf2f(zw.y & 0xffffu), z3 = bf2f(zw.y >> 16);
              v2u w; w.x = pk2(oT.x * r * gn.x * siluf_(z0), oT.y * r * gn.y * siluf_(z1)); w.y = pk2(oT.z * r * gn.z * siluf_(z2), oT.w * r * gn.w * siluf_(z3));
              *(v2u*)(O + (rowb + blk * 16 + n) * DM + 256 + h * 64 + 16 * et + 4 * g) = w; }
        }
    }
    __syncthreads();
}
typedef short bf16x8 __attribute__((ext_vector_type(8)));
constexpr size_t WS_FVT = 484 * MiB;
constexpr int FOX_KP = 72, FOX_BUF = 64 * FOX_KP * 2 * 2 + 256;
__device__ __forceinline__ void fox_vt_item(Ctx& C, int item) {
    const int lane = C.lane, bh = item >> 7, blk = item & 127, b = bh >> 2, h = bh & 3;
    const bf16* vp = (const bf16*)(C.ws + WS_P) + ((size_t)b * SEQ + blk * 16) * NP + 512 + h * 64 + lane; unsigned w[8];
#pragma unroll
    for (int t = 0; t < 16; t += 2) w[t >> 1] = (unsigned)vp[(size_t)t * NP] | ((unsigned)vp[(size_t)(t + 1) * NP] << 16);
    v4u* o = (v4u*)((bf16*)(C.ws + WS_FVT) + ((size_t)item * 64 + lane) * 16); o[0] = (v4u){w[0], w[1], w[2], w[3]}; o[1] = (v4u){w[4], w[5], w[6], w[7]};
}
__device__ __forceinline__ void fox_vt_pair(Ctx& C, int itemA, int itemB) {
    const int lane = C.lane; unsigned w[2][8];
#pragma unroll
    for (int q = 0; q < 2; ++q) { const int item = q ? itemB : itemA, bh = item >> 7, blk = item & 127, b = bh >> 2, h = bh & 3;
        const bf16* vp = (const bf16*)(C.ws + WS_P) + ((size_t)b * SEQ + blk * 16) * NP + 512 + h * 64 + lane;
#pragma unroll
        for (int t = 0; t < 16; t += 2) w[q][t >> 1] = (unsigned)vp[(size_t)t * NP] | ((unsigned)vp[(size_t)(t + 1) * NP] << 16); }
#pragma unroll
    for (int q = 0; q < 2; ++q) { const int item = q ? itemB : itemA;
        v4u* o = (v4u*)((bf16*)(C.ws + WS_FVT) + ((size_t)item * 64 + lane) * 16); o[0] = (v4u){w[q][0], w[q][1], w[q][2], w[q][3]}; o[1] = (v4u){w[q][4], w[q][5], w[q][6], w[q][7]}; }
}
__device__ __forceinline__ void fox_unit(Ctx& C, int l, int bh, int qb) {
    const int tid = C.tid, lane = C.lane, wave = C.wave, n = lane & 15, g = lane >> 4, b = bh >> 2, h = bh & 3;
    const bf16* P = (const bf16*)(C.ws + WS_P); const float* CF = (const float*)(C.ws + WS_CF) + (size_t)bh * SEQ; bf16* O = (bf16*)(C.ws + WS_O);
    const bf16* Vtf = (const bf16*)(C.ws + WS_FVT) + (size_t)bh * 128 * 1024;
    const size_t rowb = (size_t)b * SEQ;
    const int q0 = qb * 256 + wave * 32;
    bf16x8 qf[2][2]; float ct[2];
#pragma unroll
    for (int qs = 0; qs < 2; ++qs) { ct[qs] = CF[q0 + 16 * qs + n];
#pragma unroll
        for (int ks = 0; ks < 2; ++ks) qf[qs][ks] = *(const bf16x8*)(P + (rowb + q0 + 16 * qs + n) * NP + h * 64 + 32 * ks + 8 * g); }
    f32x4 OT[2][4];
#pragma unroll
    for (int qs = 0; qs < 2; ++qs)
#pragma unroll
        for (int dt = 0; dt < 4; ++dt) OT[qs][dt] = (f32x4){0.f, 0.f, 0.f, 0.f};
    float mx[2] = {-INFINITY, -INFINITY}, lsum[2] = {0.f, 0.f};
    const int ntiles = 4 * (qb + 1);
    const int kkey = tid >> 3, kch = tid & 7, vb4 = tid >> 7, vd = (tid >> 1) & 63, vh = tid & 1;
    const bf16* kptr = P + (rowb + kkey) * NP + 256 + h * 64 + 8 * kch;
    const bf16* vptr = Vtf + ((size_t)vb4 * 64 + vd) * 16 + 8 * vh;
    const int kw = kkey * FOX_KP + 8 * kch, vw = 64 * FOX_KP + vd * FOX_KP + 16 * vb4 + 8 * vh;
    LAS unsigned char* lds = C.lds;
    v4u kr[2], vr[2]; float cr[2];
#define FOX_LOAD(set, t) do { const int t_ = (t) < ntiles ? (t) : ntiles - 1; kr[set] = *(const v4u*)(kptr + (size_t)t_ * 64 * NP); vr[set] = *(const v4u*)(vptr + (size_t)t_ * 4 * 1024); cr[set] = CF[t_ * 64 + (tid & 63)]; } while (0)
#define FOX_STORE(set, buf) do { *(LAS v4u*)((LAS bf16*)(buf) + kw) = kr[set]; *(LAS v4u*)((LAS bf16*)(buf) + vw) = vr[set]; if (tid < 64) ((LAS float*)((buf) + 64 * FOX_KP * 4))[tid] = cr[set]; } while (0)
    FOX_LOAD(0, 0); FOX_STORE(0, lds);
    FOX_LOAD(1, 1); FOX_LOAD(0, 2);
    __syncthreads();
#pragma unroll 1
    for (int kt0 = 0; kt0 < ntiles; kt0 += 2) {
#pragma unroll
      for (int u = 0; u < 2; ++u) {
        const int kt = kt0 + u;
        LAS unsigned char* cur = lds + (kt & 1) * FOX_BUF; LAS unsigned char* nxt = lds + ((kt & 1) ^ 1) * FOX_BUF;
        FOX_STORE((u + 1) & 1, nxt);
        FOX_LOAD((u + 1) & 1, kt + 3);
        if (64 * kt <= q0 + 31) {
            const bool diag = 64 * kt + 63 > q0;
            const LAS bf16* Ks = (const LAS bf16*)cur; const LAS bf16* Vs = Ks + 64 * FOX_KP; const LAS float* Cs = (const LAS float*)(cur + 64 * FOX_KP * 4);
            bf16x8 kf[4][2]; f32x4 c4[4];
#pragma unroll
            for (int mt = 0; mt < 4; ++mt) { c4[mt] = *(const LAS f32x4*)(Cs + 16 * mt + 4 * g);
#pragma unroll
                for (int ks = 0; ks < 2; ++ks) kf[mt][ks] = *(const LAS bf16x8*)(Ks + (16 * mt + n) * FOX_KP + 32 * ks + 8 * g); }
            __builtin_amdgcn_sched_barrier(0);
            f32x4 sv[2][4];
#pragma unroll
            for (int qs = 0; qs < 2; ++qs)
#pragma unroll
                for (int mt = 0; mt < 4; ++mt) {
                    f32x4 a = (f32x4){0.f, 0.f, 0.f, 0.f};
#pragma unroll
                    for (int ks = 0; ks < 2; ++ks) a = __builtin_amdgcn_mfma_f32_16x16x32_bf16(kf[mt][ks], qf[qs][ks], a, 0, 0, 0);
                    sv[qs][mt] = a;
                }
            s16x4 pb[2][4]; float corr[2];
#pragma unroll
            for (int qs = 0; qs < 2; ++qs) {
                float mloc = -INFINITY;
#pragma unroll
                for (int mt = 0; mt < 4; ++mt) { sv[qs][mt] = sv[qs][mt] + (ct[qs] - c4[mt]);
                    if (diag) {
#pragma unroll
                        for (int j = 0; j < 4; ++j) if (64 * kt + 16 * mt + 4 * g + j > q0 + 16 * qs + n) sv[qs][mt][j] = -INFINITY; }
                    mloc = fmaxf(fmaxf(mloc, fmaxf(sv[qs][mt][0], sv[qs][mt][1])), fmaxf(sv[qs][mt][2], sv[qs][mt][3])); }
                mloc = xmax32(xmax16(mloc));
                const float mn = fmaxf(mx[qs], mloc); corr[qs] = __builtin_amdgcn_exp2f(mx[qs] - mn);
                mx[qs] = mn; lsum[qs] *= corr[qs];
#pragma unroll
                for (int mt = 0; mt < 4; ++mt) { f32x4 p;
#pragma unroll
                    for (int j = 0; j < 4; ++j) { p[j] = __builtin_amdgcn_exp2f(sv[qs][mt][j] - mn); lsum[qs] += p[j]; }
                    pb[qs][mt] = cvt4(p); }
            }
#pragma unroll
            for (int dt = 0; dt < 4; ++dt) {
                bf16x8 vf2[2];
#pragma unroll
                for (int a = 0; a < 2; ++a) { const s16x4 lo = *(const LAS s16x4*)(Vs + (16 * dt + n) * FOX_KP + 32 * a + 4 * g), hi = *(const LAS s16x4*)(Vs + (16 * dt + n) * FOX_KP + 32 * a + 16 + 4 * g);
                    vf2[a] = (bf16x8){lo[0], lo[1], lo[2], lo[3], hi[0], hi[1], hi[2], hi[3]}; }
#pragma unroll
                for (int qs = 0; qs < 2; ++qs) { OT[qs][dt] = OT[qs][dt] * corr[qs];
#pragma unroll
                    for (int a = 0; a < 2; ++a) { const s16x4 lo = pb[qs][2 * a], hi = pb[qs][2 * a + 1];
                        OT[qs][dt] = __builtin_amdgcn_mfma_f32_16x16x32_bf16(vf2[a], (bf16x8){lo[0], lo[1], lo[2], lo[3], hi[0], hi[1], hi[2], hi[3]}, OT[qs][dt], 0, 0, 0); } }
            }
        }
        __syncthreads();
      }
    }
#undef FOX_LOAD
#undef FOX_STORE
    const float* on_g = C.ka->in[6] + l * 64;
#pragma unroll
    for (int qs = 0; qs < 2; ++qs) {
        float ls = xsum32(xsum16(lsum[qs]));
        const float inv = rcpf_(ls); float ss = 0.f;
#pragma unroll
        for (int dt = 0; dt < 4; ++dt) { OT[qs][dt] = OT[qs][dt] * inv; ss += (OT[qs][dt].x * OT[qs][dt].x + OT[qs][dt].y * OT[qs][dt].y) + (OT[qs][dt].z * OT[qs][dt].z + OT[qs][dt].w * OT[qs][dt].w); }
        ss = xsum32(xsum16(ss));
        const float r = rsqf_(ss * (1.0f / 64.0f) + RMS_EPS);
#pragma unroll
        for (int dt = 0; dt < 4; ++dt) { const f32x4 gg = *(const f32x4*)(on_g + 16 * dt + 4 * g);
            v2u w; w.x = pk2(OT[qs][dt].x * r * gg.x, OT[qs][dt].y * r * gg.y); w.y = pk2(OT[qs][dt].z * r * gg.z, OT[qs][dt].w * r * gg.w);
            *(v2u*)(O + (rowb + q0 + 16 * qs + n) * DM + h * 64 + 16 * dt + 4 * g) = w; }
    }
}
#ifdef PROBE_TS
#define SUBTS(i) do { if (blockIdx.x == PROBE_BLK && threadIdx.x == 0 && l == 0) ((volatile LAS unsigned long long*)(C.lds + LDS_BYTES - 512))[16 + (i)] = __builtin_amdgcn_s_memrealtime(); } while (0)
#else
#define SUBTS(i) do { } while (0)
#endif
constexpr int SCAN_BLOCKS = 96;
__device__ __forceinline__ void m1_mixers(Ctx& C, int l) {
    const int bx = (int)blockIdx.x;
    SUBTS(6);
#ifdef PROBE_FOXW
    if (blockIdx.x == PROBE_BLK && threadIdx.x == 0 && l == 0) { volatile LAS unsigned long long* t_ = (volatile LAS unsigned long long*)(C.lds + LDS_BYTES - 512); t_[25] = 0; t_[26] = 0; }
#endif
    if (bx < SCAN_BLOCKS) {
        if (bx < 32) gdn_scan(C, l, 2 * bx);
        else if (bx < 64) lin_scan<0>(C, l, 2 * (bx - 32));
        else lin_scan<1>(C, l, 2 * (bx - 64));
        SUBTS(7);
#ifdef DUP_SCAN
        __syncthreads();
        if (bx < 32) gdn_scan(C, l, 2 * bx);
        else if (bx < 64) lin_scan<0>(C, l, 2 * (bx - 32));
        else lin_scan<1>(C, l, 2 * (bx - 64));
#endif
    } else {
        const int G2 = (int)gridDim.x - SCAN_BLOCKS, j = (int)blockIdx.x - SCAN_BLOCKS;
        for (int r = 0; r * G2 < 512; ++r) { const int u = r * G2 + ((r & 1) ? (G2 - 1 - j) : j); if (u < 512) fox_unit(C, l, u & 63, 7 - (u >> 6)); }
        SUBTS(7);
#ifdef DUP_FOX
        for (int r = 0; r * G2 < 512; ++r) { const int u = r * G2 + ((r & 1) ? (G2 - 1 - j) : j); if (u < 512) fox_unit(C, l, u & 63, 7 - (u >> 6)); }
#endif
    }
}

__device__ __forceinline__ void cv_fixup(Ctx& C, int l) {
    const float* H = (const float*)(C.ws + WS_HALO); bf16* ACT = (bf16*)(C.ws + WS_ACT);
    const float* cw = C.ka->in[19] + (size_t)l * 3 * NUP; const float* cb = C.ka->in[20] + (size_t)l * NUP;
    for (int i = blockIdx.x * NTHREADS + C.tid; i < 128 * 22 * 2 * 128; i += gridDim.x * NTHREADS) {
        const int j = i & 127, rr = (i >> 7) & 1, t = i >> 8, pn = t % 22, pm = t / 22;
        if ((pm & 7) == 0) continue;
        const float* h0 = H + (size_t)(pm * 22 + pn) * 1024; const float* hp = H + (size_t)((pm - 1) * 22 + pn) * 1024;
        float uo[2];
#pragma unroll
        for (int bj = 0; bj < 2; ++bj) { const int c = bj * 128 + j, col = bj * DFF + pn * 128 + j;
            const float y0 = h0[rr * 256 + c], y1 = rr == 0 ? hp[3 * 256 + c] : h0[c], y2 = rr == 0 ? hp[2 * 256 + c] : hp[3 * 256 + c];
            uo[bj] = cw[col] * y2 + cw[NUP + col] * y1 + cw[2 * NUP + col] * y0 + cb[col]; }
        ACT[(size_t)(pm * 256 + rr) * DFF + pn * 128 + j] = (bf16)f2bf(siluf_(uo[0]) * uo[1]);
    }
}

struct Args { const float* in[22]; float* out; unsigned char* ws; };
__global__ void __launch_bounds__(NTHREADS, 2) fwd_megakernel(Args args) {
    extern __shared__ __attribute__((aligned(16))) unsigned char lds_raw[];
    cg::grid_group grid = cg::this_grid();
    Ctx C;
    C.ka = (const CAS KArgs*)__builtin_amdgcn_kernarg_segment_ptr();
    C.out = args.out; C.ws = args.ws;
    C.lds = (LAS unsigned char*)lds_raw;
    C.tid = threadIdx.x; C.lane = C.tid & 63; C.wave = __builtin_amdgcn_readfirstlane(C.tid >> 6);
    C.gw = blockIdx.x * NWAVES + C.wave; C.ngw = gridDim.x * NWAVES;
    const int G = gridDim.x;
    volatile LAS unsigned* bst = (volatile LAS unsigned*)(C.lds + LDS_BYTES - 16);
    if (threadIdx.x < 4) bst[threadIdx.x] = 0u;
    __syncthreads();
    const XcdBarrier xbar = xcd_barrier_post((unsigned*)(args.ws + WS_BAR), bst);
#ifdef PROBE_TS
    volatile LAS unsigned long long* tsl = (volatile LAS unsigned long long*)(C.lds + LDS_BYTES - 512); int nts = 0;
#define GRID_SYNC() do { xcd_barrier(xbar); if (blockIdx.x == PROBE_BLK && threadIdx.x == 0) tsl[nts] = __builtin_amdgcn_s_memrealtime(); ++nts; } while (0)
#else
#define GRID_SYNC() xcd_barrier(xbar)
#endif
    unsigned char* const ws0 = args.ws; float* const out0 = args.out;
#define PHASE_BEGIN() do { size_t z_ = 0; const CAS KArgs* k_ = (const CAS KArgs*)__builtin_amdgcn_kernarg_segment_ptr(); int t_ = threadIdx.x; asm volatile("" : "+s"(z_), "+s"(k_), "+v"(t_)); \
        unsigned char* w_ = ws0 + z_; float* o_ = out0 + z_;     \
        C.ws = w_; C.out = o_; C.ka = k_; C.tid = t_; C.lane = t_ & 63; C.wave = __builtin_amdgcn_readfirstlane(t_ >> 6); C.gw = blockIdx.x * NWAVES + C.wave; ss = (float*)(w_ + WS_SS); XB = (bf16*)(w_ + WS_XB); } while (0)
    float* ss; bf16* XB;

#ifdef PROBE_TS
    if (blockIdx.x == PROBE_BLK && threadIdx.x == 0) tsl[15] = __builtin_amdgcn_s_memrealtime();
#endif
#ifndef NO_P0
    p0_prologue(C);
#ifdef DUP_P0
    grid.sync(); p0_prologue(C);
#endif
#endif
    GRID_SYNC();
    if (gridDim.x > 65536u) grid.sync();
    for (int l = 0; l < DEPTH; ++l) {
        PHASE_BEGIN();
        {
            pg8::Gemm g{XB, (const bf16*)(C.ws + WS_W1T) + (size_t)l * N1 * DM, MTOK, N1, DM}; pg8::StaticOrder S; S.init(MTOK, N1, G, (int)blockIdx.x);
            pg8::EpiP E{(bf16*)(C.ws + WS_P), (float*)(C.ws + WS_PS), ss + (size_t)l * MTOK, (float*)(C.ws + WS_FF), C.ka->in[3] + l * 64, C.ka->in[4] + l * 64, (bf16*)(C.ws + WS_FVT), (bf16*)((unsigned char*)C.out + OS_VTH), (bf16*)((unsigned char*)C.out + OS_VTG), C.ka->in[11], l, (bf16*)((unsigned char*)C.out + OS_KTH), (float*)((unsigned char*)C.out + OS_ADH)};
#ifndef NO_G1
            pg8::gemm_phase<pg8::EpiP, pg8::StaticOrder, true, true>(C.lds, g, S, E);
#ifdef DUP_G1
            GRID_SYNC(); pg8::gemm_phase<pg8::EpiP, pg8::StaticOrder, true, true>(C.lds, g, S, E);
#endif
#endif
        }
        GRID_SYNC();
        PHASE_BEGIN();
        SUBTS(0);
#ifndef NO_M0
        m0_prep(C, l);
#endif
        SUBTS(1);
        for (int it = C.gw; it < 4096; it += C.ngw) { GdnRaw ga, gb; gdn_stage1_load(C, it, ga); gdn_stage1_load(C, it + 4096, gb);
            gdn_stage1_finish(C, l, it, ga, C.lds + C.wave * 20480); gdn_stage1_finish(C, l, it + 4096, gb, C.lds + C.wave * 20480); }
        SUBTS(2);
        SUBTS(3);
        { GlaW gw_; gla_w_load(C, l, (C.gw >> 7) & 3, gw_);
          for (int it = C.gw; it < 4096; it += C.ngw) gla_stage1_pair(C, it, it + 4096, gw_); }
        SUBTS(4);
        SUBTS(5);
#ifdef DUP_GDN1
        { GdnRaw ga, gb; int it = C.gw;
          if (it < 8192) gdn_stage1_load(C, it, ga);
          for (; it < 8192; it += 2 * C.ngw) {
              if (it + C.ngw < 8192) gdn_stage1_load(C, it + C.ngw, gb);
              gdn_stage1_finish(C, l, it, ga, C.lds + C.wave * 20480);
              if (it + C.ngw < 8192) { if (it + 2 * C.ngw < 8192) gdn_stage1_load(C, it + 2 * C.ngw, ga); gdn_stage1_finish(C, l, it + C.ngw, gb, C.lds + C.wave * 20480); }
          } }
#endif
#ifdef DUP_FVT
        for (int r_ = 0; r_ < 4; ++r_) for (int it = C.gw; it < 8192; it += C.ngw) fox_vt_item(C, it);
#endif
        GRID_SYNC();
        PHASE_BEGIN();
#ifndef NO_M1
        m1_mixers(C, l);
#ifdef DUP_M1
        GRID_SYNC(); m1_mixers(C, l);
#endif
#endif
        GRID_SYNC();
        PHASE_BEGIN();
        {
            pg8::Gemm g{(const bf16*)(C.ws + WS_O), (const bf16*)(C.ws + WS_WOT) + (size_t)l * DM * DM, MTOK, DM, DM}; pg8::StaticOrder S; S.init(MTOK, DM, G, (int)blockIdx.x);
            pg8::EpiRes<false> E{XB, nullptr, ss + (size_t)(2 + l) * MTOK};
#ifndef NO_G2
            pg8::gemm_phase<pg8::EpiRes<false>, pg8::StaticOrder, true, true>(C.lds, g, S, E);
#ifdef DUP_G2P
            { GRID_SYNC(); pg8::EpiRes<false> E2{XB, nullptr, (float*)(C.ws + WS_HALO), (bf16*)(C.ws + WS_P)}; pg8::gemm_phase<pg8::EpiRes<false>, pg8::StaticOrder, true, true>(C.lds, g, S, E2); }
#endif
#ifdef DUP_G2_OLD
            if (l == 0) { GRID_SYNC(); pg8::EpiRes E2{C.ka->in[0], C.out, XB, (float*)(C.ws + WS_HALO)}; pg8::gemm_phase<pg8::EpiRes, pg8::StaticOrder, true, true>(C.lds, g, S, E2); }
#endif
#endif
        }
        GRID_SYNC();
        PHASE_BEGIN();
        {
            pg8::Gemm g{XB, (const bf16*)(C.ws + WS_WUT) + (size_t)l * NUP * DM, MTOK, NUP, DM}; pg8::StaticOrder S; S.init(MTOK, NUP, G, (int)blockIdx.x);
            pg8::EpiConv E{(bf16*)(C.ws + WS_ACT), (float*)(C.ws + WS_HALO), ss + (size_t)(2 + l) * MTOK, C.ka->in[19] + (size_t)l * 3 * NUP, C.ka->in[20] + (size_t)l * NUP, (LAS float*)(C.lds + 131072)};
#ifndef NO_G3
            pg8::gemm_phase<pg8::EpiConv, pg8::StaticOrder, true, true>(C.lds, g, S, E);
#ifdef DUP_G3
            GRID_SYNC(); pg8::gemm_phase<pg8::EpiConv, pg8::StaticOrder, true, true>(C.lds, g, S, E);
#endif
#endif
        }
        GRID_SYNC();
        PHASE_BEGIN();
        cv_fixup(C, l);
#ifdef DUP_FIX
        GRID_SYNC(); cv_fixup(C, l);
#endif
#ifdef DUP_SYNC
        for (int q = 0; q < 10; ++q) GRID_SYNC();
#endif
        GRID_SYNC();
        PHASE_BEGIN();
        {
            pg8::Gemm g{(const bf16*)(C.ws + WS_ACT), (const bf16*)(C.ws + WS_WDT) + (size_t)l * DM * DFF, MTOK, DM, DFF}; pg8::StaticOrder S; S.init(MTOK, DM, G, (int)blockIdx.x);
            if (l + 1 < DEPTH) { pg8::EpiRes<false> E{XB, nullptr, ss + (size_t)(l + 1) * MTOK};
#ifdef DUP_G4P
                { pg8::EpiRes<false> E2{XB, nullptr, (float*)(C.ws + WS_HALO), (bf16*)(C.ws + WS_P)}; pg8::gemm_phase<pg8::EpiRes<false>, pg8::StaticOrder, true, true>(C.lds, g, S, E2); GRID_SYNC(); }
#endif
                pg8::gemm_phase<pg8::EpiRes<false>, pg8::StaticOrder, true, true>(C.lds, g, S, E);
            } else { pg8::EpiRes<true> E{XB, C.out, nullptr};
                pg8::gemm_phase<pg8::EpiRes<true>, pg8::StaticOrder, true, true>(C.lds, g, S, E); }
        }
        GRID_SYNC();
    }
#ifdef PROBE_TS
    if (blockIdx.x == PROBE_BLK && threadIdx.x == 0) {
        const unsigned long long d = tsl[PROBE_B] - tsl[PROBE_A], t0 = __builtin_amdgcn_s_memrealtime();
        while (__builtin_amdgcn_s_memrealtime() - t0 < 8ull * d) __builtin_amdgcn_s_sleep(16);
    }
#endif
}

extern "C" void kernel_launch(void* const* d_in, const int* in_sizes, int n_in, void* d_out, int out_size, void* d_ws, size_t ws_size, hipStream_t stream) {
    static int grid = 0;
    if (grid == 0) {
        if (n_in != 22 || in_sizes[0] != MTOK * DM || out_size != MTOK * DM || ws_size < WS_END) {
            fprintf(stderr, "kernel_launch: unexpected problem (n_in %d, in0 %d, out %d, ws %zu < %zu)\n", n_in, n_in > 0 ? in_sizes[0] : -1, out_size, ws_size, (size_t)WS_END); grid = -1; return; }
        int dev = 0, cus = 0, per_cu = 0;
        (void)hipGetDevice(&dev); (void)hipDeviceGetAttribute(&cus, hipDeviceAttributeMultiprocessorCount, dev);
        if (hipFuncSetAttribute((const void*)fwd_megakernel, hipFuncAttributeMaxDynamicSharedMemorySize, LDS_BYTES) != hipSuccess) { fprintf(stderr, "kernel_launch: hipFuncSetAttribute failed\n"); grid = -1; return; }
        if (hipOccupancyMaxActiveBlocksPerMultiprocessor(&per_cu, (const void*)fwd_megakernel, NTHREADS, LDS_BYTES) != hipSuccess || per_cu < 1) { fprintf(stderr, "kernel_launch: occupancy query says %d blocks per CU\n", per_cu); per_cu = 1; }
        (void)hipGetLastError();
        grid = cus;
    }
    if (grid < 0) return;
    if (hipMemsetAsync((char*)d_ws + WS_BAR, 0, 16384, stream) != hipSuccess) { fprintf(stderr, "kernel_launch: memset of the barrier words failed\n"); return; }
    Args a{};
    for (int i = 0; i < 22; ++i) a.in[i] = (const float*)d_in[i];
    a.out = (float*)d_out; a.ws = (unsigned char*)d_ws;
    void* kargs[] = {&a};
    hipError_t e = hipLaunchCooperativeKernel((const void*)fwd_megakernel, dim3(grid), dim3(NTHREADS), kargs, LDS_BYTES, stream);
    if (e != hipSuccess) fprintf(stderr, "kernel_launch: cooperative launch failed: %s (grid %d)\n", hipGetErrorString(e), grid);
}
```

```cpp
#include <hip/hip_runtime.h>
#include <hip/hip_cooperative_groups.h>
#include <cstdio>
#include <cstdint>
namespace cg = cooperative_groups;
constexpr float RMS_EPS = 1e-6f;

namespace pg8 {
#define PG8_LAS __attribute__((address_space(3)))
typedef unsigned short bf16_t;
typedef short bf16x8 __attribute__((ext_vector_type(8)));
typedef float f32x4 __attribute__((ext_vector_type(4)));
typedef unsigned u32x4 __attribute__((ext_vector_type(4)));
constexpr int BM = 256, BK = 64, HALF = 128, HTB = HALF * BK * 2  , STAGE_BYTES = 8 * HTB, NXCD = 8, WGM = 8;

__host__ __device__ __forceinline__ int lds_byte(int r, int c) { const int st = (r >> 4) * 2 + (c >> 5), rr = r & 15, cc = c & 31, ob = rr * 64 + cc * 2; return st * 1024 + (ob ^ (((ob >> 9) & 1) << 5)); }
__host__ __device__ __forceinline__ void stage_rc(int b, int& R, int& C) { const int st = b / 1024, sb = b % 1024, swz = sb ^ (((sb >> 9) & 1) << 5); R = (st >> 1) * 16 + swz / 64; C = (st & 1) * 32 + (swz % 64) / 2; }
__host__ __device__ __forceinline__ int perm32(int rho) { const int n = rho >> 4, i = rho & 15; return 8 * (i >> 2) + 4 * n + (i & 3); }

struct Unit { int pm, pn; };
struct Gemm { const bf16_t* A; const bf16_t* Bt; int M, N, K; };

struct StaticOrder {
    int nM, nN, nwg, G, c;
    __host__ __device__ void init(int M, int N, int G_, int c_) { nM = M / BM; nN = N / BM; nwg = nM * nN; G = G_; c = c_; }
    __host__ __device__ bool next(int i, Unit& u) const {
        const long L = (long)i * G + c; if (L >= nwg) return false;
        int wgid = (int)L; { const int q = nwg / NXCD, r = nwg % NXCD, xcd = wgid % NXCD, off = wgid / NXCD; wgid = (xcd < r ? xcd * (q + 1) : r * (q + 1) + (xcd - r) * q) + off; }
        const int nig = WGM * nN, gid = wgid / nig, fm = gid * WGM, gsz = (nM - fm) < WGM ? (nM - fm) : WGM;
        u.pm = fm + ((wgid % nig) % gsz); u.pn = (wgid % nig) / gsz; return true;
    }
    __device__ __forceinline__ void a_ready(const Unit&) const {}
    __device__ __forceinline__ void done(const Unit&) const {}
};
__device__ __forceinline__ unsigned cvt_pk_bf16(float lo, float hi) { unsigned r; asm volatile("v_cvt_pk_bf16_f32 %0, %1, %2" : "=v"(r) : "v"(lo), "v"(hi)); return r; }
typedef float f32x2 __attribute__((ext_vector_type(2)));
#ifndef HGP
#define HGP 0
#endif
#ifndef HGX
#define HGX 0
#endif
#ifdef HG_SWAP
#define HGT(t) (8 - (t))
#else
#define HGT(t) ((t) - 7)
#endif

typedef unsigned u32x2 __attribute__((ext_vector_type(2)));
struct EpiP {
    static constexpr bool PERM = true, AFTER_DRAIN = false, PROBE_DUP = true;
    bf16_t* P; float* PS; const float* ss; float* FF; const float* qg; const float* kg; bf16_t* FVT; bf16_t* VTH; bf16_t* VTG; const float* hglb; int layer; bf16_t* KTH; float* ADH; const float* glab; bf16_t* KTG; float* ADG;
    template <int CTRL> static __device__ __forceinline__ float dppf(float old, float src) {
        return __builtin_bit_cast(float, __builtin_amdgcn_update_dpp(__builtin_bit_cast(int, old), __builtin_bit_cast(int, src), CTRL, 0xf, 0xf, false)); }
    template <int R> static __device__ __forceinline__ void tap_dpp(f32x4& a, const f32x4& cur, const f32x4& prev, const f32x4& w, unsigned long long m) {
        float a0 = a[0], a1 = a[1], a2 = a[2], a3 = a[3], z0, z1, z2, z3;
        if (R == 1)
            asm("v_cndmask_b32_e64 %4, %8, %12, %20\n\tv_cndmask_b32_e64 %5, %9, %13, %20\n\tv_cndmask_b32_e64 %6, %10, %14, %20\n\tv_cndmask_b32_e64 %7, %11, %15, %20\n\t"
                "v_fmac_f32_dpp %0, %4, %16 row_ror:1 row_mask:0xf bank_mask:0xf\n\tv_fmac_f32_dpp %1, %5, %17 row_ror:1 row_mask:0xf bank_mask:0xf\n\t"
                "v_fmac_f32_dpp %2, %6, %18 row_ror:1 row_mask:0xf bank_mask:0xf\n\tv_fmac_f32_dpp %3, %7, %19 row_ror:1 row_mask:0xf bank_mask:0xf"
                : "+v"(a0), "+v"(a1), "+v"(a2), "+v"(a3), "=&v"(z0), "=&v"(z1), "=&v"(z2), "=&v"(z3)
                : "v"(cur[0]), "v"(cur[1]), "v"(cur[2]), "v"(cur[3]), "v"(prev[0]), "v"(prev[1]), "v"(prev[2]), "v"(prev[3]), "v"(w[0]), "v"(w[1]), "v"(w[2]), "v"(w[3]), "s"(m));
        else
            asm("v_cndmask_b32_e64 %4, %8, %12, %20\n\tv_cndmask_b32_e64 %5, %9, %13, %20\n\tv_cndmask_b32_e64 %6, %10, %14, %20\n\tv_cndmask_b32_e64 %7, %11, %15, %20\n\t"
                "v_fmac_f32_dpp %0, %4, %16 row_ror:2 row_mask:0xf bank_mask:0xf\n\tv_fmac_f32_dpp %1, %5, %17 row_ror:2 row_mask:0xf bank_mask:0xf\n\t"
                "v_fmac_f32_dpp %2, %6, %18 row_ror:2 row_mask:0xf bank_mask:0xf\n\tv_fmac_f32_dpp %3, %7, %19 row_ror:2 row_mask:0xf bank_mask:0xf"
                : "+v"(a0), "+v"(a1), "+v"(a2), "+v"(a3), "=&v"(z0), "=&v"(z1), "=&v"(z2), "=&v"(z3)
                : "v"(cur[0]), "v"(cur[1]), "v"(cur[2]), "v"(cur[3]), "v"(prev[0]), "v"(prev[1]), "v"(prev[2]), "v"(prev[3]), "v"(w[0]), "v"(w[1]), "v"(w[2]), "v"(w[3]), "s"(m));
        a = (f32x4){a0, a1, a2, a3};
    }
    template <int CTRL> static __device__ __forceinline__ float rorf(float src) { return __builtin_bit_cast(float, __builtin_amdgcn_mov_dpp(__builtin_bit_cast(int, src), CTRL, 0xf, 0xf, true)); }
    static __device__ __forceinline__ u32x2 tile_t4(const f32x4& v, int fr, int fq) {
        typedef short s16x4_ __attribute__((ext_vector_type(4))); typedef float f32x2_ __attribute__((ext_vector_type(2))); typedef __bf16 bf16x2_ __attribute__((ext_vector_type(2)));
        u32x2 idb; idb.x = (4 * fq == fr ? 0x3F80u : 0u) | (4 * fq + 1 == fr ? 0x3F800000u : 0u); idb.y = (4 * fq + 2 == fr ? 0x3F80u : 0u) | (4 * fq + 3 == fr ? 0x3F800000u : 0u);
        u32x2 ab; ab.x = __builtin_bit_cast(unsigned, __builtin_convertvector((f32x2_){v[0], v[1]}, bf16x2_)); ab.y = __builtin_bit_cast(unsigned, __builtin_convertvector((f32x2_){v[2], v[3]}, bf16x2_));
        const f32x4 t = __builtin_amdgcn_mfma_f32_16x16x16bf16_1k(__builtin_bit_cast(s16x4_, ab), __builtin_bit_cast(s16x4_, idb), (f32x4){0.f, 0.f, 0.f, 0.f}, 0, 0, 0);
        u32x2 o; o.x = __builtin_bit_cast(unsigned, __builtin_convertvector((f32x2_){t[0], t[1]}, bf16x2_)); o.y = __builtin_bit_cast(unsigned, __builtin_convertvector((f32x2_){t[2], t[3]}, bf16x2_));
        return o;
    }
    __device__ __forceinline__ void operator()(const f32x4 (&acc)[2][2][4][2], const Unit& u, int wr, int wc, int fr, int fq) const {
        const int row0 = u.pm * BM + wr * 64 + fr;
        float rs[2][4];
#pragma unroll
        for (int ai = 0; ai < 2; ++ai)
#pragma unroll
            for (int m = 0; m < 4; ++m) rs[ai][m] = ss[row0 + ai * HALF + m * 16];
        float hlb[2][4];
#pragma unroll
        for (int n = 0; n < 2; ++n)
#pragma unroll
            for (int k = 0; k < 4; ++k) { hlb[n][k] = 0.f;
                if ((u.pn == 7 || u.pn == 8) && layer == 1) { const int c = (2 * HGT(u.pn) + (wc >> 1)) * 64 + 32 * (wc & 1) + 8 * fq + 4 * n + k; hlb[n][k] = __builtin_amdgcn_rcpf(1.0f + __expf(hglb[c] - hglb[256 + c])); } }
#pragma unroll
        for (int ai = 0; ai < 2; ++ai)
#pragma unroll
            for (int m = 0; m < 4; ++m) {
                const int row = row0 + ai * HALF + m * 16;
                const float rstd = __builtin_amdgcn_rsqf(rs[ai][m] * (1.0f / 1024.0f) + RMS_EPS);
                if (u.pn < 2) {
                    const float* gp = u.pn == 0 ? qg : kg;
                    f32x4 p[2][2]; float sq = 0.f;
#pragma unroll
                    for (int bj = 0; bj < 2; ++bj)
#pragma unroll
                        for (int n = 0; n < 2; ++n) { p[bj][n] = acc[ai][bj][m][n] * rstd; sq += (p[bj][n][0] * p[bj][n][0] + p[bj][n][1] * p[bj][n][1]) + (p[bj][n][2] * p[bj][n][2] + p[bj][n][3] * p[bj][n][3]); }
                    sq += __shfl_xor(sq, 16); sq += __shfl_xor(sq, 32);
                                        const float r = __builtin_amdgcn_rsqf(sq * (1.0f / 64.0f) + RMS_EPS) * (u.pn == 0 ? 0.18033688011112042f : 1.0f);
                    bf16_t* rowp = P + (size_t)row * 3584 + u.pn * BM + wc * 64 + 8 * fq;
#pragma unroll
                    for (int bj = 0; bj < 2; ++bj) { const f32x4 g0 = *(const f32x4*)(gp + 32 * bj + 8 * fq), g1 = *(const f32x4*)(gp + 32 * bj + 8 * fq + 4);
                                                const f32x4 v0 = p[bj][0] * g0 * r, v1 = p[bj][1] * g1 * r;
                        u32x4 w; w.x = cvt_pk_bf16(v0[0], v0[1]); w.y = cvt_pk_bf16(v0[2], v0[3]); w.z = cvt_pk_bf16(v1[0], v1[1]); w.w = cvt_pk_bf16(v1[2], v1[3]);
                        *(u32x4*)(rowp + 32 * bj) = w; }
                } else if (u.pn == 2 || u.pn == 9 || u.pn == 12) {
                    const int rowb = u.pm * BM + wr * 64 + ai * HALF + m * 16;
                    bf16_t* vb = (u.pn == 2 ? FVT : u.pn == 9 ? VTH : VTG) + (((size_t)(rowb >> 11) * 4 * 128 + ((rowb & 2047) >> 4)) * 64) * 16 + 4 * fq;
                    typedef short s16x4_ __attribute__((ext_vector_type(4)));
                    u32x2 idb; idb.x = (4 * fq == fr ? 0x3F80u : 0u) | (4 * fq + 1 == fr ? 0x3F800000u : 0u); idb.y = (4 * fq + 2 == fr ? 0x3F80u : 0u) | (4 * fq + 3 == fr ? 0x3F800000u : 0u);
                    const s16x4_ ident = __builtin_bit_cast(s16x4_, idb);
#pragma unroll
                    for (int bj = 0; bj < 2; ++bj)
#pragma unroll
                        for (int n = 0; n < 2; ++n) { const f32x4 v = acc[ai][bj][m][n] * rstd;
                            typedef float f32x2_ __attribute__((ext_vector_type(2))); typedef __bf16 bf16x2_ __attribute__((ext_vector_type(2)));
                            u32x2 ab; ab.x = __builtin_bit_cast(unsigned, __builtin_convertvector((f32x2_){v[0], v[1]}, bf16x2_)); ab.y = __builtin_bit_cast(unsigned, __builtin_convertvector((f32x2_){v[2], v[3]}, bf16x2_));
                            const f32x4 t = __builtin_amdgcn_mfma_f32_16x16x16bf16_1k(__builtin_bit_cast(s16x4_, ab), ident, (f32x4){0.f, 0.f, 0.f, 0.f}, 0, 0, 0);
                            const int c = 128 * bj + 32 * wc + 8 * (fr >> 2) + 4 * n + (fr & 3);
                            u32x2 o; o.x = __builtin_bit_cast(unsigned, __builtin_convertvector((f32x2_){t[0], t[1]}, bf16x2_)); o.y = __builtin_bit_cast(unsigned, __builtin_convertvector((f32x2_){t[2], t[3]}, bf16x2_));
                            *(u32x2*)(vb + ((size_t)((c >> 6) ^ (u.pn == 9 ? HGX : 0)) * 128 * 64 + (c & 63)) * 16) = o; }
                } else if (u.pn == 7 || u.pn == 8) {
                    const int h = 2 * HGT(u.pn) + (wc >> 1), d0 = 32 * (wc & 1) + 8 * fq;
                    const size_t item = ((size_t)(row >> 11) * 4 + (h ^ HGX)) * 128 + ((row & 2047) >> 4);
                    u32x4 wq, wk; unsigned* wqp = (unsigned*)&wq; unsigned* wkp = (unsigned*)&wk; float adv[8];
#pragma unroll
                    for (int n = 0; n < 2; ++n) { float qo[4], ko[4]; f32x4 ktv;
#pragma unroll
                        for (int k = 0; k < 4; ++k) {
                            const float lb = hlb[n][k];
                            const float qv = acc[ai][0][m][n][k] * rstd, fv = acc[ai][1][m][n][k] * rstd;
                            const float sg = __builtin_amdgcn_rcpf(1.0f + __expf(-fv));
                            const float la = __logf(lb + (1.0f - lb) * sg), kk = (1.0f - lb) * (1.0f - sg);
                            float gc = la;
                            gc += dppf<0x111>(0.f, gc); gc += dppf<0x112>(0.f, gc); gc += dppf<0x114>(0.f, gc); gc += dppf<0x118>(0.f, gc);
                            const float gl = __shfl(gc, (fq << 4) | 15);
                            qo[k] = qv * __builtin_amdgcn_rcpf(1.0f + __expf(-qv)) * 0.125f * __expf(gc);
                            ko[k] = kk * __expf(fminf(-gc, 80.f));
                            ktv[k] = kk * __expf(gl - gc);
                            adv[4 * n + k] = __expf(gl); }
                        wqp[2 * n] = cvt_pk_bf16(qo[0], qo[1]); wqp[2 * n + 1] = cvt_pk_bf16(qo[2], qo[3]); wkp[2 * n] = cvt_pk_bf16(ko[0], ko[1]); wkp[2 * n + 1] = cvt_pk_bf16(ko[2], ko[3]);
                        *(u32x2*)(KTH + (item * 64 + 32 * (wc & 1) + 8 * (fr >> 2) + 4 * n + (fr & 3)) * 16 + 4 * fq) = tile_t4(ktv, fr, fq); }
                    *(u32x4*)(P + (size_t)row * 3584 + 7 * BM + (h ^ HGP) * 64 + d0) = wq;
                    *(u32x4*)(P + (size_t)row * 3584 + 8 * BM + (h ^ HGP) * 64 + d0) = wk;
                    if (fr == 0) { float* ap = ADH + item * 64 + d0; *(f32x4*)ap = (f32x4){adv[0], adv[1], adv[2], adv[3]}; *(f32x4*)(ap + 4) = (f32x4){adv[4], adv[5], adv[6], adv[7]}; }
                } else if (u.pn == 11 || u.pn == 14) {
                    const int ch0 = 64 * (u.pn == 14) + 16 * wc + 4 * fq, h = ch0 >> 5, d0 = ch0 & 31;
                    const size_t item = ((size_t)(row >> 11) * 4 + h) * 128 + ((row & 2047) >> 4);
                    const f32x4 bg = *(const f32x4*)(glab + ch0);
                    float qo[4], ko[4], adv[4]; f32x4 ktv;
#pragma unroll
                    for (int k = 0; k < 4; ++k) {
                        const float qv = acc[ai][0][m][0][k] * rstd, kv = acc[ai][0][m][1][k] * rstd, zz = acc[ai][1][m][0][k] * rstd + bg[k];
                        const float la = (fminf(zz, 0.f) - __logf(1.0f + __expf(-fabsf(zz)))) * (1.0f / 16.0f);
                        float gc = la;
                        gc += dppf<0x111>(0.f, gc); gc += dppf<0x112>(0.f, gc); gc += dppf<0x114>(0.f, gc); gc += dppf<0x118>(0.f, gc);
                        const float gl = __shfl(gc, (fq << 4) | 15);
                        qo[k] = qv * 0.17677669529663687f * __expf(gc); ko[k] = kv * __expf(fminf(-gc, 80.f));
                        ktv[k] = kv * __expf(gl - gc);
                        adv[k] = __expf(gl); }
                    u32x2 wq, wk; wq.x = cvt_pk_bf16(qo[0], qo[1]); wq.y = cvt_pk_bf16(qo[2], qo[3]); wk.x = cvt_pk_bf16(ko[0], ko[1]); wk.y = cvt_pk_bf16(ko[2], ko[3]);
                    *(u32x2*)(KTG + (item * 32 + ((16 * wc) & 31) + fr) * 16 + 4 * fq) = tile_t4(ktv, fr, fq);
                    *(u32x2*)(P + (size_t)row * 3584 + 11 * BM + h * 32 + d0) = wq;
                    *(u32x2*)(P + (size_t)row * 3584 + 11 * BM + 128 + h * 32 + d0) = wk;
                    if (fr == 0) *(f32x4*)(ADG + item * 32 + d0) = (f32x4){adv[0], adv[1], adv[2], adv[3]};
                    if (u.pn == 14 && wc == 0 && fq < 3) {
                        const f32x4 v0 = acc[ai][1][m][1] * rstd;
                        *(f32x4*)(PS + (size_t)row * 32 + 4 * fq) = v0;
                        if (fq == 0) { float* fp = FF + (size_t)(row >> 11) * 4 * 2048 + (row & 2047); fp[0] = v0[0]; fp[2048] = v0[1]; fp[2 * 2048] = v0[2]; fp[3 * 2048] = v0[3]; } }
                } else if (u.pn < 14) {
                    bf16_t* rowp = P + (size_t)row * 3584 + u.pn * BM + wc * 32 + 8 * fq;
#pragma unroll
                    for (int bj = 0; bj < 2; ++bj) { const f32x4 v0 = acc[ai][bj][m][0] * rstd, v1 = acc[ai][bj][m][1] * rstd;
                        u32x4 w; w.x = cvt_pk_bf16(v0[0], v0[1]); w.y = cvt_pk_bf16(v0[2], v0[3]); w.z = cvt_pk_bf16(v1[0], v1[1]); w.w = cvt_pk_bf16(v1[2], v1[3]);
                        *(u32x4*)(rowp + bj * HALF) = w; }
                }
            }
    }
};
template <bool LAST> struct EpiRes {
    static constexpr bool PERM = true, AFTER_DRAIN = false, PROBE_DUP = false;
    bf16_t* xb; float* out; float* ssq; bf16_t* xbw = nullptr;
    __device__ __forceinline__ void operator()(const f32x4 (&acc)[2][2][4][2], const Unit& u, int wr, int wc, int fr, int fq) const {
        const int row0 = u.pm * BM + wr * 64 + fr, col0 = u.pn * BM + wc * 32 + 8 * fq;
        u32x4 bv[4][2][2];
#define EPR_LOADQ(q_) do { _Pragma("unroll") for (int mm = 0; mm < 2; ++mm) _Pragma("unroll") for (int bj = 0; bj < 2; ++bj) \
            bv[(q_)][mm][bj] = *(const u32x4*)(xb + (size_t)(row0 + ((q_) >> 1) * HALF + (2 * ((q_) & 1) + mm) * 16) * 1024 + col0 + bj * HALF); } while (0)
        EPR_LOADQ(0); EPR_LOADQ(1); EPR_LOADQ(2); EPR_LOADQ(3);
#pragma unroll
        for (int q = 0; q < 4; ++q) {
            const int ai = q >> 1;
#pragma unroll
            for (int mm = 0; mm < 2; ++mm) {
                const int m = 2 * (q & 1) + mm;
                const int row = row0 + ai * HALF + m * 16; float s = 0.f;
#pragma unroll
                for (int bj = 0; bj < 2; ++bj) { const size_t off = (size_t)row * 1024 + col0 + bj * HALF; const u32x4 b = bv[q][mm][bj];
                    f32x4 o0 = acc[ai][bj][m][0], o1 = acc[ai][bj][m][1];
                    o0[0] += __uint_as_float(b.x << 16); o0[1] += __uint_as_float(b.x & 0xffff0000u); o0[2] += __uint_as_float(b.y << 16); o0[3] += __uint_as_float(b.y & 0xffff0000u);
                    o1[0] += __uint_as_float(b.z << 16); o1[1] += __uint_as_float(b.z & 0xffff0000u); o1[2] += __uint_as_float(b.w << 16); o1[3] += __uint_as_float(b.w & 0xffff0000u);
                    if (LAST) { *(f32x4*)(out + off) = o0; *(f32x4*)(out + off + 4) = o1; }
                    else { s += ((o0[0] * o0[0] + o0[1] * o0[1]) + (o0[2] * o0[2] + o0[3] * o0[3])) + ((o1[0] * o1[0] + o1[1] * o1[1]) + (o1[2] * o1[2] + o1[3] * o1[3]));
                        u32x4 w; w.x = cvt_pk_bf16(o0[0], o0[1]); w.y = cvt_pk_bf16(o0[2], o0[3]); w.z = cvt_pk_bf16(o1[0], o1[1]); w.w = cvt_pk_bf16(o1[2], o1[3]); *(u32x4*)((xbw ? xbw : xb) + off) = w; } }
                if (!LAST) { s += __shfl_xor(s, 16); s += __shfl_xor(s, 32);
                    if (fq == 0) atomicAdd(ssq + row, s); }
            }
        }
#undef EPR_LOADQ
    }
};
struct EpiConv {
    static constexpr bool PERM = true, AFTER_DRAIN = false, PROBE_DUP = false;
    bf16_t* ACT; float* HALO; const float* ss; const float* cw; const float* cb; PG8_LAS float* xl;
    template <int CTRL> static __device__ __forceinline__ float dpp(float old, float src) {
        return __builtin_bit_cast(float, __builtin_amdgcn_update_dpp(__builtin_bit_cast(int, old), __builtin_bit_cast(int, src), CTRL, 0xf, 0xf, false)); }
    template <int R> static __device__ __forceinline__ void tap_dpp(f32x4& a, const f32x4& cur, const f32x4& prev, const f32x4& w, unsigned long long m) {
        float a0 = a[0], a1 = a[1], a2 = a[2], a3 = a[3], z0, z1, z2, z3;
        if (R == 1)
            asm("v_cndmask_b32_e64 %4, %8, %12, %20\n\tv_cndmask_b32_e64 %5, %9, %13, %20\n\tv_cndmask_b32_e64 %6, %10, %14, %20\n\tv_cndmask_b32_e64 %7, %11, %15, %20\n\t"
                "v_fmac_f32_dpp %0, %4, %16 row_ror:1 row_mask:0xf bank_mask:0xf\n\tv_fmac_f32_dpp %1, %5, %17 row_ror:1 row_mask:0xf bank_mask:0xf\n\t"
                "v_fmac_f32_dpp %2, %6, %18 row_ror:1 row_mask:0xf bank_mask:0xf\n\tv_fmac_f32_dpp %3, %7, %19 row_ror:1 row_mask:0xf bank_mask:0xf"
                : "+v"(a0), "+v"(a1), "+v"(a2), "+v"(a3), "=&v"(z0), "=&v"(z1), "=&v"(z2), "=&v"(z3)
                : "v"(cur[0]), "v"(cur[1]), "v"(cur[2]), "v"(cur[3]), "v"(prev[0]), "v"(prev[1]), "v"(prev[2]), "v"(prev[3]), "v"(w[0]), "v"(w[1]), "v"(w[2]), "v"(w[3]), "s"(m));
        else
            asm("v_cndmask_b32_e64 %4, %8, %12, %20\n\tv_cndmask_b32_e64 %5, %9, %13, %20\n\tv_cndmask_b32_e64 %6, %10, %14, %20\n\tv_cndmask_b32_e64 %7, %11, %15, %20\n\t"
                "v_fmac_f32_dpp %0, %4, %16 row_ror:2 row_mask:0xf bank_mask:0xf\n\tv_fmac_f32_dpp %1, %5, %17 row_ror:2 row_mask:0xf bank_mask:0xf\n\t"
                "v_fmac_f32_dpp %2, %6, %18 row_ror:2 row_mask:0xf bank_mask:0xf\n\tv_fmac_f32_dpp %3, %7, %19 row_ror:2 row_mask:0xf bank_mask:0xf"
                : "+v"(a0), "+v"(a1), "+v"(a2), "+v"(a3), "=&v"(z0), "=&v"(z1), "=&v"(z2), "=&v"(z3)
                : "v"(cur[0]), "v"(cur[1]), "v"(cur[2]), "v"(cur[3]), "v"(prev[0]), "v"(prev[1]), "v"(prev[2]), "v"(prev[3]), "v"(w[0]), "v"(w[1]), "v"(w[2]), "v"(w[3]), "s"(m));
        a = (f32x4){a0, a1, a2, a3};
    }
    template <int CTRL> static __device__ __forceinline__ float rorf(float src) { return __builtin_bit_cast(float, __builtin_amdgcn_mov_dpp(__builtin_bit_cast(int, src), CTRL, 0xf, 0xf, true)); }
    __device__ __forceinline__ void operator()(const f32x4 (&acc)[2][2][4][2], const Unit& u, int wr, int wc, int fr, int fq) const {
        const int row0 = u.pm * BM + wr * 64 + fr;
        float rs[2][4];
#pragma unroll
        for (int ai = 0; ai < 2; ++ai)
#pragma unroll
            for (int m = 0; m < 4; ++m) rs[ai][m] = __builtin_amdgcn_rsqf(ss[row0 + ai * HALF + m * 16] * (1.0f / 1024.0f) + RMS_EPS);
        const int colg = u.pn * HALF + wc * 32 + 8 * fq;
        f32x4 wn[1][2][3], bn[1][2];
#define EPC_LOADW(n_) do { _Pragma("unroll") for (int bj = 0; bj < 2; ++bj) { const int c = bj * 2816 + colg + 4 * (n_); bn[0][bj] = *(const f32x4*)(cb + c); \
            _Pragma("unroll") for (int j = 0; j < 3; ++j) wn[0][bj][j] = *(const f32x4*)(cw + j * 5632 + c); } } while (0)
        EPC_LOADW(0);
        if (fr >= 14) {
#pragma unroll
            for (int ai = 0; ai < 2; ++ai) { PG8_LAS float* xp = xl + ((((ai * 2 + wr) * 4 + wc) * 2 + (fr - 14)) * 64) + 8 * fq;
#pragma unroll
                for (int bj = 0; bj < 2; ++bj)
#pragma unroll
                    for (int n = 0; n < 2; ++n) *(PG8_LAS f32x4*)(xp + bj * 32 + 4 * n) = acc[ai][bj][3][n] * rs[ai][3]; }
            if (wr == 1) { float* hp = HALO + ((size_t)(u.pm * 22 + u.pn) * 4 + 2 + (fr - 14)) * 256 + wc * 32 + 8 * fq;
#pragma unroll
                for (int bj = 0; bj < 2; ++bj)
#pragma unroll
                    for (int n = 0; n < 2; ++n) *(f32x4*)(hp + bj * HALF + 4 * n) = acc[1][bj][3][n] * rs[1][3]; }
        }
        if (fr < 2 && wr == 0) { float* hp = HALO + ((size_t)(u.pm * 22 + u.pn) * 4 + fr) * 256 + wc * 32 + 8 * fq;
#pragma unroll
            for (int bj = 0; bj < 2; ++bj)
#pragma unroll
                for (int n = 0; n < 2; ++n) *(f32x4*)(hp + bj * HALF + 4 * n) = acc[0][bj][0][n] * rs[0][0]; }
        asm volatile("s_waitcnt lgkmcnt(0)" ::: "memory"); __builtin_amdgcn_s_barrier(); asm volatile("" ::: "memory");
        const bool seq_start = (u.pm & 7) == 0;
        const unsigned long long m15 = __builtin_amdgcn_ballot_w64(fr == 15), m14 = __builtin_amdgcn_ballot_w64(fr >= 14);
#ifdef DUP_EPC
        for (int rep_ = 0; rep_ < 2; ++rep_) { asm volatile("" ::: "memory"); EPC_LOADW(0);
#endif
#pragma unroll
        for (int n = 0; n < 2; ++n) {
            if (n == 1) EPC_LOADW(1);
            f32x4 (&w)[2][3] = wn[0]; f32x4 (&bb)[2] = bn[0];
#pragma unroll
            for (int ai = 0; ai < 2; ++ai) {
                f32x4 prev[2];
                const int pg = ai * 2 + wr - 1;
#pragma unroll
                for (int bj = 0; bj < 2; ++bj) {
                    if (pg >= 0) prev[bj] = *(const PG8_LAS f32x4*)(xl + (((pg * 4 + wc) * 2 + (fr != 14)) * 64) + 8 * fq + bj * 32 + 4 * n);
                    else prev[bj] = (f32x4){0.f, 0.f, 0.f, 0.f};
                }
#pragma unroll
                for (int m = 0; m < 4; ++m) {
                    f32x4 cur[2], uo[2];
#pragma unroll
                    for (int bj = 0; bj < 2; ++bj) { cur[bj] = acc[ai][bj][m][n] * rs[ai][m];
                        uo[bj] = bb[bj] + w[bj][2] * cur[bj];
                        tap_dpp<1>(uo[bj], cur[bj], prev[bj], w[bj][1], m15);
                        tap_dpp<2>(uo[bj], cur[bj], prev[bj], w[bj][0], m14);
                        prev[bj] = cur[bj]; }
                    const f32x4 gu = uo[0] * uo[1]; f32x4 den, a;
#pragma unroll
                    for (int k = 0; k < 4; ++k) den[k] = __builtin_amdgcn_exp2f(uo[0][k]);
                    den = den + 1.0f;
#pragma unroll
                    for (int k = 0; k < 4; ++k) den[k] = __builtin_amdgcn_rcpf(den[k]);
                    a = gu * den;
                    u32x2 o; o.x = cvt_pk_bf16(a[0], a[1]); o.y = cvt_pk_bf16(a[2], a[3]);
                    *(u32x2*)(ACT + (size_t)(row0 + ai * HALF + m * 16) * 2816 + colg + 4 * n) = o;
                }
            }
        }
#ifdef DUP_EPC
        }
#endif
        (void)seq_start;
#undef EPC_LOADW
    }
};
template <class Epi, class Sched, bool ALIGN_EPI = false, bool SP2 = false>
__device__ __forceinline__ void gemm_phase(PG8_LAS unsigned char* lds, const Gemm g, const Sched& S, const Epi& E, int tid0) {
    int tid_ = tid0; asm volatile("" : "+v"(tid_));
    const int tid = tid_, wid = __builtin_amdgcn_readfirstlane(tid >> 6), lane = tid & 63, wr = wid >> 2, wc = wid & 3, fr = lane & 15, fq = lane >> 4;
    const int K = g.K, nt = K / BK;
    unsigned voffA[2], voffB[2];
#pragma unroll
    for (int i = 0; i < 2; ++i) { int R, C; stage_rc(tid * 16 + i * 8192, R, C); const int Rb = Epi::PERM ? ((R & ~31) + perm32(R & 31)) : R;
        voffA[i] = (unsigned)(R * K + C) * 2u; voffB[i] = (unsigned)(Rb * K + C) * 2u; }
    const size_t kstep = (size_t)(BK * 2);
    const size_t hstep = (size_t)HALF * K * 2;
    const size_t tstep = 2 * hstep;
    const unsigned ldsw = (unsigned)wid * 1024u;
    const int aoff = lds_byte(wr * 64 + fr, fq * 8), boff = lds_byte(wc * 32 + fr, fq * 8);
#define PG8_SA(b, h) (((b) * 2 + (h)) * HTB)
#define PG8_SB(b, h) ((4 + (b) * 2 + (h)) * HTB)
#define PG8_STAGE(bufoff, gbase, voff) do { _Pragma("unroll") for (int _i = 0; _i < 2; ++_i) \
        __builtin_amdgcn_global_load_lds((const unsigned*)((const char*)(gbase) + (voff)[_i]), (PG8_LAS unsigned*)(lds + (bufoff) + ldsw + _i * 8192), 16, 0, 0); } while (0)
#define PG8_LDA(dst, b, h) do { _Pragma("unroll") for (int m = 0; m < 4; ++m) _Pragma("unroll") for (int k = 0; k < 2; ++k) dst[m][k] = *(const PG8_LAS bf16x8*)(lds + PG8_SA(b, h) + aoff + m * 2048 + k * 1024); } while (0)
#define PG8_LDB(dst, b, h) do { _Pragma("unroll") for (int n = 0; n < 2; ++n) _Pragma("unroll") for (int k = 0; k < 2; ++k) dst[n][k] = *(const PG8_LAS bf16x8*)(lds + PG8_SB(b, h) + boff + n * 2048 + k * 1024); } while (0)
#define PG8_MMA(ai, bj, At, Bt) do { __builtin_amdgcn_s_setprio(1); _Pragma("unroll") for (int m = 0; m < 4; ++m) _Pragma("unroll") for (int n = 0; n < 2; ++n) _Pragma("unroll") for (int k = 0; k < 2; ++k) \
        acc[ai][bj][m][n] = __builtin_amdgcn_mfma_f32_16x16x32_bf16(Bt[n][k], At[m][k], acc[ai][bj][m][n], 0, 0, 0); __builtin_amdgcn_s_setprio(0); } while (0)
#define PG8_WAIT_V(n) asm volatile("s_waitcnt vmcnt(" #n ")" ::: "memory")
#define PG8_WAIT_L(n) asm volatile("s_waitcnt lgkmcnt(" #n ")" ::: "memory")
#define PG8_BAR __builtin_amdgcn_s_barrier()
#define PG8_SCHED __builtin_amdgcn_sched_barrier(0)
    Unit cur, nxt; int ui = 0;
    if (!S.next(0, cur)) return;
    f32x4 acc[2][2][4][2];
#pragma unroll
    for (int a = 0; a < 2; ++a)
#pragma unroll
        for (int b = 0; b < 2; ++b)
#pragma unroll
            for (int m = 0; m < 4; ++m)
#pragma unroll
                for (int n = 0; n < 2; ++n) acc[a][b][m][n] = (f32x4){0.f, 0.f, 0.f, 0.f};
    bf16x8 At[4][2], B0[2][2], B1[2][2];
    const char* cA = (const char*)g.A + (size_t)cur.pm * tstep; const char* cB = (const char*)g.Bt + (size_t)cur.pn * tstep;
    S.a_ready(cur);
    if constexpr (SP2) {
        PG8_STAGE(PG8_SB(0, 0), cB, voffB); PG8_STAGE(PG8_SB(0, 1), cB + hstep, voffB); PG8_STAGE(PG8_SA(0, 0), cA, voffA); PG8_STAGE(PG8_SA(0, 1), cA + hstep, voffA);
        if (wr == 1) PG8_BAR;
        PG8_WAIT_V(2); PG8_BAR;
        PG8_STAGE(PG8_SB(1, 0), cB + kstep, voffB); PG8_STAGE(PG8_SA(1, 0), cA + kstep, voffA); PG8_STAGE(PG8_SB(1, 1), cB + hstep + kstep, voffB);
        PG8_WAIT_V(6); PG8_BAR;
    } else {
        PG8_STAGE(PG8_SB(0, 0), cB, voffB); PG8_STAGE(PG8_SA(0, 0), cA, voffA); PG8_STAGE(PG8_SB(0, 1), cB + hstep, voffB); PG8_STAGE(PG8_SA(0, 1), cA + hstep, voffA);
        if (wr == 1) PG8_BAR;
        PG8_WAIT_V(4); PG8_BAR;
        PG8_STAGE(PG8_SB(1, 0), cB + kstep, voffB); PG8_STAGE(PG8_SA(1, 0), cA + kstep, voffA); PG8_STAGE(PG8_SB(1, 1), cB + hstep + kstep, voffB);
        PG8_WAIT_V(6); PG8_BAR;
    }
    for (;;) {
        const bool has_next = S.next(ui + 1, nxt);
        const char* nA = has_next ? (const char*)g.A + (size_t)nxt.pm * tstep : cA; const char* nB = has_next ? (const char*)g.Bt + (size_t)nxt.pn * tstep : cB;
        for (int t = 0; t < nt; t += 2) {
            const bool last = (t == nt - 2);
            const char* a1 = cA + (size_t)(t + 1) * kstep;
            const char* a2 = last ? nA : cA + (size_t)(t + 2) * kstep; const char* b2 = last ? nB : cB + (size_t)(t + 2) * kstep;
            const char* a3 = a2 + kstep; const char* b3 = b2 + kstep;
            if (last && has_next) S.a_ready(nxt);
            if constexpr (SP2) {
            PG8_LDB(B0, 0, 0); PG8_LDB(B1, 0, 1); PG8_SCHED; PG8_LDA(At, 0, 0); PG8_STAGE(PG8_SA(1, 1), a1 + hstep, voffA);
            PG8_WAIT_V(8); PG8_WAIT_L(0); PG8_BAR; PG8_MMA(0, 0, At, B0); PG8_MMA(0, 1, At, B1); PG8_BAR; PG8_SCHED;
            PG8_LDA(At, 0, 1); PG8_STAGE(PG8_SB(0, 0), b2, voffB); PG8_STAGE(PG8_SB(0, 1), b2 + hstep, voffB); PG8_STAGE(PG8_SA(0, 0), a2, voffA);
            PG8_WAIT_V(8); PG8_WAIT_L(0); PG8_BAR; PG8_MMA(1, 0, At, B0); PG8_MMA(1, 1, At, B1); PG8_BAR; PG8_SCHED;
            PG8_LDB(B0, 1, 0); PG8_LDB(B1, 1, 1); PG8_SCHED; PG8_LDA(At, 1, 0); PG8_STAGE(PG8_SA(0, 1), a2 + hstep, voffA);
            PG8_WAIT_V(8); PG8_WAIT_L(0); PG8_BAR; PG8_MMA(0, 0, At, B0); PG8_MMA(0, 1, At, B1); PG8_BAR; PG8_SCHED;
            PG8_LDA(At, 1, 1); PG8_STAGE(PG8_SB(1, 0), b3, voffB); PG8_STAGE(PG8_SB(1, 1), b3 + hstep, voffB); PG8_STAGE(PG8_SA(1, 0), a3, voffA);
            PG8_WAIT_V(8); PG8_WAIT_L(0); PG8_BAR; PG8_MMA(1, 0, At, B0); PG8_MMA(1, 1, At, B1); PG8_BAR; PG8_SCHED;
            } else {
            PG8_LDB(B0, 0, 0); PG8_SCHED; PG8_LDA(At, 0, 0); PG8_STAGE(PG8_SA(1, 1), a1 + hstep, voffA);
            PG8_WAIT_L(8); PG8_BAR; PG8_WAIT_L(0); PG8_MMA(0, 0, At, B0); PG8_BAR; PG8_SCHED;
            PG8_LDB(B1, 0, 1); PG8_STAGE(PG8_SB(0, 0), b2, voffB);
            PG8_BAR; PG8_WAIT_L(0); PG8_MMA(0, 1, At, B1); PG8_BAR;
            PG8_LDA(At, 0, 1); PG8_STAGE(PG8_SA(0, 0), a2, voffA);
            PG8_BAR; PG8_WAIT_L(0); PG8_MMA(1, 0, At, B0); PG8_BAR; PG8_SCHED;
            PG8_STAGE(PG8_SB(0, 1), b2 + hstep, voffB);
            PG8_WAIT_V(6); PG8_BAR; PG8_MMA(1, 1, At, B1); PG8_BAR;
            PG8_LDB(B0, 1, 0); PG8_SCHED; PG8_LDA(At, 1, 0); PG8_STAGE(PG8_SA(0, 1), a2 + hstep, voffA);
            PG8_WAIT_L(8); PG8_BAR; PG8_WAIT_L(0); PG8_MMA(0, 0, At, B0); PG8_BAR; PG8_SCHED;
            PG8_LDB(B1, 1, 1); PG8_STAGE(PG8_SB(1, 0), b3, voffB);
            PG8_BAR; PG8_WAIT_L(0); PG8_MMA(0, 1, At, B1); PG8_BAR;
            PG8_LDA(At, 1, 1); PG8_STAGE(PG8_SA(1, 0), a3, voffA);
            PG8_BAR; PG8_WAIT_L(0); PG8_MMA(1, 0, At, B0); PG8_BAR; PG8_SCHED;
            PG8_STAGE(PG8_SB(1, 1), b3 + hstep, voffB);
            PG8_WAIT_V(6); PG8_BAR; PG8_MMA(1, 1, At, B1); PG8_BAR;
            }
        }
        if constexpr (ALIGN_EPI) { if (wr == 0) PG8_BAR; }
        if constexpr (!Epi::AFTER_DRAIN) { E(acc, cur, wr, wc, fr, fq);
#ifdef DUP_EPI
            if constexpr (Epi::PROBE_DUP) { asm volatile("" ::: "memory"); E(acc, cur, wr, wc, fr, fq); }
#endif
            S.done(cur); }
        if (!has_next) break;
#pragma unroll
        for (int a = 0; a < 2; ++a)
#pragma unroll
            for (int b = 0; b < 2; ++b)
#pragma unroll
                for (int m = 0; m < 4; ++m)
#pragma unroll
                    for (int n = 0; n < 2; ++n) acc[a][b][m][n] = (f32x4){0.f, 0.f, 0.f, 0.f};
        cur = nxt; cA = nA; cB = nB; ++ui;
        if constexpr (ALIGN_EPI) { if (wr == 1) PG8_BAR; }
    }
    PG8_WAIT_V(0);
    if constexpr (!ALIGN_EPI) { if (wr == 0) PG8_BAR; }
    PG8_BAR;
    if constexpr (Epi::AFTER_DRAIN) { E.fused(acc, cur, wr, wc, fr, fq, lds, wid, lane); S.done(cur); }
#undef PG8_SA
#undef PG8_SB
#undef PG8_STAGE
#undef PG8_LDA
#undef PG8_LDB
#undef PG8_MMA
#undef PG8_WAIT_V
#undef PG8_WAIT_L
#undef PG8_BAR
#undef PG8_SCHED
}
}
constexpr int BATCH = 16, SEQ = 2048, DM = 1024, MTOK = BATCH * SEQ, DEPTH = 2;
constexpr int IN_COLS = 3612, NP = 3584, N1 = 3840, DFF = 2816, NUP = 5632;
constexpr int NWAVES = 8, NTHREADS = 512;
constexpr int LDS_BYTES = 163840;
#define GAS __attribute__((address_space(1)))
#define LAS __attribute__((address_space(3)))
typedef unsigned short bf16;
typedef float f32x4 __attribute__((ext_vector_type(4)));
typedef unsigned v4u __attribute__((ext_vector_type(4)));
typedef unsigned v2u __attribute__((ext_vector_type(2)));
#define LDS_WAIT() asm volatile("s_waitcnt lgkmcnt(0)" ::: "memory")

constexpr size_t MiB = 1u << 20;
constexpr size_t WS_SS = 0;
constexpr size_t WS_BAR = 1536 * 1024;
constexpr size_t WS_CWS = 1536 * 1024 + 64 * 1024;
constexpr size_t WS_CF = 1 * MiB;
constexpr size_t WS_W1T = 2 * MiB;
constexpr size_t WS_WOT = 18 * MiB;
constexpr size_t WS_WUT = 22 * MiB;
constexpr size_t WS_WDT = 44 * MiB;
constexpr size_t WS_FF = 55 * MiB;
constexpr size_t WS_XB = 56 * MiB;
constexpr size_t WS_P = 120 * MiB;
constexpr size_t WS_PS = 344 * MiB;
constexpr size_t WS_O = 348 * MiB;
constexpr size_t WS_GQ = 412 * MiB;
constexpr size_t WS_HALO = 476 * MiB;
constexpr size_t WS_ACT = 296 * MiB;
constexpr size_t WS_END = 508 * MiB;

__device__ __forceinline__ float bf2f(unsigned u) { return __uint_as_float(u << 16); }
__device__ __forceinline__ unsigned f2bf(float f) { unsigned u = __float_as_uint(f); return (u + 0x7fffu + ((u >> 16) & 1u)) >> 16; }
typedef float f32x2_t __attribute__((ext_vector_type(2))); typedef __bf16 bf16x2_t __attribute__((ext_vector_type(2)));
__device__ __forceinline__ unsigned pk2(float lo, float hi) { f32x2_t v = {lo, hi}; bf16x2_t r = __builtin_convertvector(v, bf16x2_t); return __builtin_bit_cast(unsigned, r); }
__device__ __forceinline__ float xsum16(float x) { return x + __shfl_xor(x, 16); }
__device__ __forceinline__ float xsum32(float x) { return x + __shfl_xor(x, 32); }
__device__ __forceinline__ float fmax3_(float a, float b, float c) { float r; asm("v_max3_f32 %0, %1, %2, %3" : "=v"(r) : "v"(a), "v"(b), "v"(c)); return r; }
__device__ __forceinline__ float xmax16(float x) { return fmaxf(x, __shfl_xor(x, 16)); }
__device__ __forceinline__ float xmax32(float x) { return fmaxf(x, __shfl_xor(x, 32)); }
__device__ __forceinline__ float wave_sum(float v) {
#pragma unroll
    for (int o = 1; o < 64; o <<= 1) v += __shfl_xor(v, o);
    return v;
}
__device__ __forceinline__ float rcpf_(float x) { return __builtin_amdgcn_rcpf(x); }
__device__ __forceinline__ float rsqf_(float x) { return __builtin_amdgcn_rsqf(x); }
__device__ __forceinline__ float sigmoidf_(float x) { return rcpf_(1.0f + __expf(-x)); }
__device__ __forceinline__ float siluf_(float x) { return x * rcpf_(1.0f + __expf(-x)); }
__device__ __forceinline__ float softplusf_(float x) { return x > 20.f ? x : __logf(1.0f + __expf(x)); }
__device__ __forceinline__ float logsigmoidf_(float x) { return fminf(x, 0.f) - __logf(1.0f + __expf(-fabsf(x))); }
__device__ __forceinline__ void unpack8(const v4u w, float* f) {
    f[0] = __uint_as_float(w.x << 16); f[1] = __uint_as_float(w.x & 0xffff0000u); f[2] = __uint_as_float(w.y << 16); f[3] = __uint_as_float(w.y & 0xffff0000u);
    f[4] = __uint_as_float(w.z << 16); f[5] = __uint_as_float(w.z & 0xffff0000u); f[6] = __uint_as_float(w.w << 16); f[7] = __uint_as_float(w.w & 0xffff0000u);
}

#ifdef HG_SWAP
#define HGT(t) (8 - (t))
#else
#define HGT(t) ((t) - 7)
#endif
__device__ __forceinline__ int map_w1(int j) {
    const int t = j >> 8, i = j & 255;
    if (t < 2) return t * 256 + 64 * ((i >> 5) & 3) + 32 * (i >> 7) + (i & 31);
    if (t < 3) return j;
    if (t < 6) return 772 + (t - 3) * 256 + i;
    if (t == 6) return 1548 + i;
    if (t == 7 || t == 8) { const int bj = i >> 7, wc = (i >> 5) & 3, x = i & 31; return (bj ? 2060 : 1804) + (2 * HGT(t) + (wc >> 1)) * 64 + 32 * (wc & 1) + x; }
    if (t < 11) return 1804 + (t - 7) * 256 + i;
    if (t == 11 || t == 14) {
        const int bj = i >> 7, wc = (i >> 5) & 3, x = i & 31, fq = x >> 3, n = (x >> 2) & 1, k = x & 3, ch = 64 * (t == 14) + 16 * wc + 4 * fq + k;
        if (bj == 0) return 2828 + 128 * n + ch;
        if (n == 0) return 100000 + ch;
        if (t == 14) { const int s = 16 * wc + 4 * fq + k; if (s < 4) return 768 + s; if (s < 8) return 1540 + (s - 4); if (s < 12) return 1544 + (s - 8); }
        return -1;
    }
    if (t == 12) return 3084 + i;
    if (t == 13) return 3356 + i;
    return -1;
}
template <int MAPKIND>
__device__ __forceinline__ void transpose_item(const float* W, int K, int N, bf16* WT, const float* gk, LAS float* scr, int item, int nblk, int lane) {
    const int kb = item / nblk, nb = item % nblk, k0 = 64 * kb, n0 = 32 * nb;
    const int jn = n0 + (lane & 31);
    const int src = MAPKIND == 1 ? map_w1(jn) : MAPKIND == 2 ? ((jn >> 8) * 128 + (jn & 127) + ((jn & 128) ? DFF : 0)) : jn;
    const int srcc = src >= 0 ? src : 0; const float keep = src >= 0 ? 1.f : 0.f;
    float wv[32], gv[32];
#pragma unroll
    for (int i = 0; i < 32; ++i) { const int kk = 2 * i + (lane >> 5); wv[i] = W[(size_t)(k0 + kk) * N + srcc]; gv[i] = gk ? gk[k0 + kk] : 1.f; }
#pragma unroll
    for (int i = 0; i < 32; ++i) { const int kk = 2 * i + (lane >> 5); scr[kk * 33 + (lane & 31)] = wv[i] * gv[i] * keep; }
    LDS_WAIT();
    const int c = lane & 7;
#pragma unroll
    for (int j = 0; j < 4; ++j) { const int n = (lane >> 3) + 8 * j; const LAS float* s = scr + (8 * c) * 33 + n;
        v4u o; o.x = pk2(s[0 * 33], s[1 * 33]); o.y = pk2(s[2 * 33], s[3 * 33]); o.z = pk2(s[4 * 33], s[5 * 33]); o.w = pk2(s[6 * 33], s[7 * 33]);
        *(v4u*)(WT + (size_t)(n0 + n) * K + k0 + 8 * c) = o; }
    LDS_WAIT();
}

__device__ __forceinline__ void transpose_item_z(const float* W, bf16* WT, const float* gk, const float* Wg, LAS float* scr, int item, int nblk, int lane) {
    constexpr int K = DM, N = IN_COLS;
    const int kb = item / nblk, nb = item % nblk, k0 = 64 * kb, n0 = 32 * nb;
    const int code = map_w1(n0 + (lane & 31)), ch = code >= 100000 ? code - 100000 : 0; const float keep = code >= 100000 ? 1.f : 0.f;
    const int pcol = (code >= 0 && code < 100000) ? code : 0; const float keepp = (code >= 0 && code < 100000) ? 1.f : 0.f;
    const float* bp = W + (size_t)(k0 + lane) * N + 3340;
    f32x4 b4[4];
#pragma unroll
    for (int q = 0; q < 4; ++q) b4[q] = *(const f32x4*)(bp + 4 * q);
    float pv[32];
#pragma unroll
    for (int i = 0; i < 32; ++i) pv[i] = W[(size_t)(k0 + 2 * i + (lane >> 5)) * N + pcol];
    float wg[16];
#pragma unroll
    for (int r = 0; r < 16; ++r) wg[r] = Wg[r * 128 + ch] * keep;
    const int c = lane & 7;
    const f32x4 g0 = *(const f32x4*)(gk + k0 + 8 * c), g1 = *(const f32x4*)(gk + k0 + 8 * c + 4);
    LAS float* blk = scr + 64 * 33;
#pragma unroll
    for (int q = 0; q < 4; ++q) *(LAS f32x4*)(blk + lane * 16 + 4 * q) = b4[q];
    LDS_WAIT();
#pragma unroll
    for (int i = 0; i < 32; ++i) { const int kk = 2 * i + (lane >> 5); float s = pv[i] * keepp;
#pragma unroll
        for (int q = 0; q < 4; ++q) { const f32x4 t = *(const LAS f32x4*)(blk + kk * 16 + 4 * q); s += t[0] * wg[4 * q]; s += t[1] * wg[4 * q + 1]; s += t[2] * wg[4 * q + 2]; s += t[3] * wg[4 * q + 3]; }
        scr[kk * 33 + (lane & 31)] = s; }
    LDS_WAIT();
    const float gg[8] = {g0[0], g0[1], g0[2], g0[3], g1[0], g1[1], g1[2], g1[3]};
#pragma unroll
    for (int j = 0; j < 4; ++j) { const int n = (lane >> 3) + 8 * j; const LAS float* sp = scr + (8 * c) * 33 + n;
        v4u o; o.x = pk2(sp[0 * 33] * gg[0], sp[1 * 33] * gg[1]); o.y = pk2(sp[2 * 33] * gg[2], sp[3 * 33] * gg[3]); o.z = pk2(sp[4 * 33] * gg[4], sp[5 * 33] * gg[5]); o.w = pk2(sp[6 * 33] * gg[6], sp[7 * 33] * gg[7]);
        *(v4u*)(WT + (size_t)(n0 + n) * K + k0 + 8 * c) = o; }
    LDS_WAIT();
}

#define CAS __attribute__((address_space(4)))
__device__ __forceinline__ int tid_from(int wv, unsigned z) { return (wv << 6) | (int)__builtin_amdgcn_mbcnt_hi(~0u, __builtin_amdgcn_mbcnt_lo(~0u, z)); }
struct KArgs { const float* in[22]; float* out; unsigned char* ws; };
struct Ctx {
    const CAS KArgs* ka; float* out; unsigned char* ws;
    LAS unsigned char* lds;
    int tid, lane, wave, gw, ngw;
};

#ifndef HGO
#define HGO 1
#endif
#ifndef GDO
#define GDO 0
#endif
struct TrD { const float* wp; size_t N2; const float* gp; float keep, gkeep; bf16* op; size_t K8; int z, l, r; };
__device__ __forceinline__ TrD tr_desc(const Ctx& C, int it) {
    constexpr int I1 = 16 * 120, I2 = 16 * 32, I3 = 16 * 176, I4 = 44 * 32, IL = I1 + I2 + I3 + I4;
    const int lane = C.lane, l = it / IL; int r = it % IL;
    const float* W; const float* gk; bf16* WT; int K, N, nblk, kind; TrD d; d.z = 0; d.l = l; d.r = r;
    if (r < I1) { W = C.ka->in[2] + (size_t)l * DM * IN_COLS; K = DM; N = IN_COLS; WT = (bf16*)(C.ws + WS_W1T) + (size_t)l * N1 * DM; gk = C.ka->in[1] + l * DM; nblk = 120; kind = 1;
        const int nb = r % 120, t = nb >> 3; d.z = ((t == 11 || t == 14) && (nb & 7) >= 4) ? 1 : 0; }
    else if (r < I1 + I2) { r -= I1; W = C.ka->in[16] + (size_t)l * DM * DM; K = DM; N = DM; WT = (bf16*)(C.ws + WS_WOT) + (size_t)l * DM * DM; gk = nullptr; nblk = 32; kind = 0; }
    else if (r < I1 + I2 + I3) { r -= I1 + I2; W = C.ka->in[18] + (size_t)l * DM * NUP; K = DM; N = NUP; WT = (bf16*)(C.ws + WS_WUT) + (size_t)l * NUP * DM; gk = C.ka->in[17] + l * DM; nblk = 176; kind = 2; }
    else { r -= I1 + I2 + I3; W = C.ka->in[21] + (size_t)l * DFF * DM; K = DFF; N = DM; WT = (bf16*)(C.ws + WS_WDT) + (size_t)l * DM * DFF; gk = nullptr; nblk = 32; kind = 0; }
    const int kb = r / nblk, nb = r % nblk, k0 = 64 * kb, n0 = 32 * nb, jn = n0 + (lane & 31), c = lane & 7;
    int src = kind == 1 ? map_w1(jn) : kind == 2 ? ((jn >> 8) * 128 + (jn & 127) + ((jn & 128) ? DFF : 0)) : jn;
    if (src >= 100000) src = -1;
    d.wp = W + (size_t)(k0 + (lane >> 5)) * N + (src >= 0 ? src : 0); d.keep = src >= 0 ? 1.f : 0.f; d.N2 = (size_t)2 * N;
    d.gp = gk ? gk + k0 + 8 * c : W; d.gkeep = gk ? 1.f : 0.f;
    const int kdst = (HGO && kind == 0 && K == DM && k0 >= 512 && k0 < 768) ? (k0 ^ 128) : (GDO && kind == 0 && K == DM && k0 >= 256 && k0 < 512) ? (k0 ^ (64 * GDO)) : k0;
    d.op = WT + (size_t)(n0 + (lane >> 3)) * K + kdst + 8 * c; d.K8 = (size_t)8 * K;
    return d;
}
__device__ __forceinline__ void tr_load(const TrD& d, float (&wv)[32], f32x4 (&g)[2]) {
#pragma unroll
    for (int i = 0; i < 32; ++i) wv[i] = __builtin_nontemporal_load(d.wp + (size_t)i * d.N2);
    g[0] = *(const f32x4*)d.gp; g[1] = *(const f32x4*)(d.gp + 4);
}
__device__ __forceinline__ void tr_finish(const Ctx& C, const TrD& d, const float (&wv)[32], const f32x4 (&g)[2], LAS float* scr) {
    const int lane = C.lane;
    if (d.z) { transpose_item_z(C.ka->in[2] + (size_t)d.l * DM * IN_COLS, (bf16*)(C.ws + WS_W1T) + (size_t)d.l * N1 * DM, C.ka->in[1] + d.l * DM, C.ka->in[13] + d.l * 16 * 128, scr, d.r, 120, lane); return; }
#pragma unroll
    for (int i = 0; i < 32; ++i) { const int kk = 2 * i + (lane >> 5); scr[kk * 33 + (lane & 31)] = wv[i] * d.keep; }
    LDS_WAIT();
    float gg[8];
#pragma unroll
    for (int j = 0; j < 8; ++j) gg[j] = d.gkeep != 0.f ? g[j >> 2][j & 3] : 1.f;
    const int c = lane & 7;
#pragma unroll
    for (int j = 0; j < 4; ++j) { const int n = (lane >> 3) + 8 * j; const LAS float* s = scr + (8 * c) * 33 + n;
        v4u o; o.x = pk2(s[0 * 33] * gg[0], s[1 * 33] * gg[1]); o.y = pk2(s[2 * 33] * gg[2], s[3 * 33] * gg[3]); o.z = pk2(s[4 * 33] * gg[4], s[5 * 33] * gg[5]); o.w = pk2(s[6 * 33] * gg[6], s[7 * 33] * gg[7]);
        if (d.l == 1) __builtin_nontemporal_store(o, (v4u*)(d.op + (size_t)j * d.K8));
        else *(v4u*)(d.op + (size_t)j * d.K8) = o; }
    LDS_WAIT();
}

#define P0_ALL_WEIGHTS 1
constexpr int TR_IL = 16 * 120 + 16 * 32 + 16 * 176 + 44 * 32;
#ifndef TR_TAIL
#define TR_TAIL 4000
#endif
constexpr int TR_SPLIT = 2 * TR_IL - TR_TAIL;
__device__ __forceinline__ void p0_weights(Ctx& C, int ib, int ie, int w0, int nw) {
    LAS float* scr = (LAS float*)(C.lds + C.wave * 16384);
#pragma unroll 1
    for (int it = ib + w0; it < ie; it += 2 * nw) {
        const int it2 = it + nw; const bool two = it2 < ie;
        const TrD da = tr_desc(C, it), db = tr_desc(C, two ? it2 : it);
        float wa[32], wb[32]; f32x4 ga[2], gb[2];
        tr_load(da, wa, ga); tr_load(db, wb, gb);
        tr_finish(C, da, wa, ga, scr);
        if (two) tr_finish(C, db, wb, gb, scr);
    }
}
__device__ __forceinline__ void p0_prologue(Ctx& C) {
    float* ss = (float*)(C.ws + WS_SS);
    bf16* XB = (bf16*)(C.ws + WS_XB);
#pragma unroll 1
    for (int pass = 0; pass < 2; ++pass) {
#ifdef P0_MIX
        const bool do_w = (pass == 0) != ((C.wave & 1) != 0);
#else
        const bool do_w = pass == 0;
#endif
        if (do_w) {
            p0_weights(C, 0, 2 * TR_IL, C.gw, C.ngw);
#ifdef PROBE_TS
            if (blockIdx.x == PROBE_BLK && C.tid == 0) ((volatile LAS unsigned long long*)(C.lds + LDS_BYTES - 512))[27] = __builtin_amdgcn_s_memrealtime();
#endif
        } else {
#pragma unroll 1
            for (int m0 = C.gw * 4; m0 < MTOK; m0 += C.ngw * 4) {
                f32x4 v[4][4];
#pragma unroll
                for (int r = 0; r < 4; ++r) { const f32x4* xr = (const f32x4*)(C.ka->in[0] + (size_t)(m0 + r) * DM) + C.lane;
#pragma unroll
                    for (int j = 0; j < 4; ++j) v[r][j] = __builtin_nontemporal_load(xr + 64 * j); }
#pragma unroll
                for (int r = 0; r < 4; ++r) { unsigned long long* o8 = (unsigned long long*)(XB + (size_t)(m0 + r) * DM) + C.lane; float s = 0.f;
#pragma unroll
                    for (int j = 0; j < 4; ++j) { const f32x4 w = v[r][j]; s += (w.x * w.x + w.y * w.y) + (w.z * w.z + w.w * w.w);
                        o8[64 * j] = (unsigned long long)pk2(w.x, w.y) | ((unsigned long long)pk2(w.z, w.w) << 32); }
                    s = wave_sum(s);
                    if (C.lane == 0) ss[m0 + r] = s; }
            }
        }
    }
    for (int i = blockIdx.x * NTHREADS + C.tid; i < 3 * MTOK; i += gridDim.x * NTHREADS) ss[MTOK + i] = 0.f;
    for (int i = blockIdx.x * NTHREADS + C.tid; i < 2 * 4 * NUP; i += gridDim.x * NTHREADS) { const int l = i / (4 * NUP), j = (i / NUP) & 3, col = i % NUP;
        const float v = j < 3 ? C.ka->in[19][(size_t)l * 3 * NUP + j * NUP + col] : C.ka->in[20][(size_t)l * NUP + col];
        ((float*)(C.ws + WS_CWS))[i] = v * (col < DFF ? -1.4426950408889634f : -0.6931471805599453f); }
}

__device__ __forceinline__ void m0_prep(Ctx& C, int l) {
    bf16* P = (bf16*)(C.ws + WS_P); const float* PS = (const float*)(C.ws + WS_PS); float* CF = (float*)(C.ws + WS_CF);
    const float* qn_g = C.ka->in[3] + l * 64; const float* kn_g = C.ka->in[4] + l * 64; const float* b_f = C.ka->in[5] + l * 4; const float* cw = C.ka->in[7] + l * 4 * 768;
    const int lane = C.lane;
    for (int bh = C.gw; bh < 64; bh += C.ngw) {
        const int b = bh >> 2, h = bh & 3; const float bias = b_f[h];
        const size_t r0 = (size_t)b * SEQ + lane * 32;
        float v[32]; (void)r0;
        { const f32x4* fp = (const f32x4*)((const float*)(C.ws + WS_FF) + (size_t)bh * SEQ + lane * 32);
#pragma unroll
          for (int i = 0; i < 8; ++i) { const f32x4 q4 = fp[i]; v[4 * i] = q4.x; v[4 * i + 1] = q4.y; v[4 * i + 2] = q4.z; v[4 * i + 3] = q4.w; } }
        float run = 0.f;
#pragma unroll
        for (int i = 0; i < 32; ++i) { run += logsigmoidf_(v[i] + bias); v[i] = run; }
        float inc = run;
#pragma unroll
        for (int o = 1; o < 64; o <<= 1) { const float t = __shfl_up(inc, o); if (lane >= o) inc += t; }
        const float ex = inc - run;
        float* cf = CF + (size_t)bh * SEQ + lane * 32;
#pragma unroll
        for (int i = 0; i < 32; i += 4) *(f32x4*)(cf + i) = (f32x4){ex + v[i], ex + v[i + 1], ex + v[i + 2], ex + v[i + 3]} * 1.4426950408889634f;
    }
}
#define XB_TMO      128
#define XB_XCNT(j)  (256  + 64 * (j))
#define XB_XSUB(j)  (1280 + 64 * (j))
#define XB_XGEN(j)  (2304 + 64 * (j))
#define XB_TOP      3328
#define XB_TOPGEN   3392
#define XCD_BAR_WORDS 3456
#define XB_SPIN_CAP (1u << 18)

__device__ __forceinline__ unsigned xb_ld(unsigned* p)              { return __hip_atomic_load(p, __ATOMIC_RELAXED, __HIP_MEMORY_SCOPE_AGENT); }
__device__ __forceinline__ unsigned xb_add(unsigned* p, unsigned v) { return __hip_atomic_fetch_add(p, v, __ATOMIC_RELAXED, __HIP_MEMORY_SCOPE_AGENT); }
__device__ __forceinline__ unsigned xb_xcc_id() { return (unsigned)__builtin_amdgcn_s_getreg((3 << 11) | 20) & 0xFu; }
#define XB_SPIN(cond, bar) do { unsigned _sp = 0; while (cond) { __builtin_amdgcn_s_sleep(1); \
    if ((++_sp & 255u) == 0u) { if (xb_ld(&(bar)[XB_TMO])) break; if (_sp > XB_SPIN_CAP) { atomicAdd(&(bar)[XB_TMO], 1u); break; } } } } while (0)

struct XcdBarrier {
    unsigned* bar; unsigned x;
    volatile LAS unsigned* st;
};

__device__ __forceinline__ XcdBarrier xcd_barrier_post(unsigned* bar, volatile LAS unsigned* st, int tid) {
    XcdBarrier b; b.bar = bar; b.x = xb_xcc_id(); b.st = st;
    if (tid == 0) (void)xb_add(&bar[XB_XCNT(b.x)], 1u);
    return b;
}
__device__ __forceinline__ void xcd_barrier_complete(unsigned* bar, unsigned x, unsigned& nloc, unsigned& nx) {
    const unsigned G = gridDim.x * gridDim.y * gridDim.z;
    unsigned sum, cnt, mine, sp = 0u;
    for (;;) {
        sum = 0u; cnt = 0u; mine = 0u;
#pragma unroll
        for (unsigned j = 0; j < 16; ++j) { const unsigned c = xb_ld(&bar[XB_XCNT(j)]); sum += c; cnt += (c > 0u) ? 1u : 0u; mine = (j == x) ? c : mine; }
        if (sum == G) break;
        __builtin_amdgcn_s_sleep(1);
        if ((++sp & 255u) == 0u) { if (xb_ld(&bar[XB_TMO])) break; if (sp > XB_SPIN_CAP) { atomicAdd(&bar[XB_TMO], 1u); break; } }
    }
    nloc = mine > 0u ? mine : 1u; nx = cnt > 0u ? cnt : 1u;
}

__device__ __forceinline__ void xcd_barrier(const XcdBarrier& b, int tid) {
    asm volatile("s_waitcnt vmcnt(0)" ::: "memory");
    __syncthreads();
    if (tid == 0) {
        unsigned* bar = b.bar;
        __builtin_amdgcn_s_waitcnt(0);
        unsigned nloc = b.st[0], nx = b.st[1];
        if (nloc == 0u) { xcd_barrier_complete(bar, b.x, nloc, nx); b.st[0] = nloc; b.st[1] = nx; }
        const unsigned old = xb_add(&bar[XB_XSUB(b.x)], 1u);
        const unsigned gen = old / nloc;
        if (old + 1u == (gen + 1u) * nloc) {
            __builtin_amdgcn_fence(__ATOMIC_RELEASE, "agent");
            asm volatile("s_waitcnt vmcnt(0)" ::: "memory");
            const unsigned og = xb_add(&bar[XB_TOP], 1u);
            const unsigned tg = og / nx;
            if (og + 1u == (tg + 1u) * nx) xb_add(&bar[XB_TOPGEN], 1u);
            else XB_SPIN(xb_ld(&bar[XB_TOPGEN]) == tg, bar);
            __builtin_amdgcn_fence(__ATOMIC_ACQUIRE, "agent");
            xb_add(&bar[XB_XGEN(b.x)], 1u);
            asm volatile("s_waitcnt vmcnt(0)" ::: "memory");
        } else {
            XB_SPIN(xb_ld(&bar[XB_XGEN(b.x)]) == gen, bar);
            __builtin_amdgcn_fence(__ATOMIC_ACQUIRE, "agent");
            asm volatile("s_waitcnt vmcnt(0)" ::: "memory");
        }
    }
    __syncthreads();
}
typedef short s16x4 __attribute__((ext_vector_type(4)));
constexpr size_t OS_VTH = 0 * MiB, OS_VTG = 16 * MiB, OS_KTH = 32 * MiB, OS_KTG = 48 * MiB, OS_ADH = 56 * MiB, OS_ADG = 58 * MiB;
__device__ __forceinline__ f32x4 mfma16(s16x4 a, s16x4 b, f32x4 c) { return __builtin_amdgcn_mfma_f32_16x16x16bf16_1k(a, b, c, 0, 0, 0); }
__device__ __forceinline__ s16x4 ld8(const bf16* p) { return *(const s16x4*)p; }
__device__ __forceinline__ s16x4 cvt4(f32x4 v) { v2u w; w.x = pk2(v.x, v.y); w.y = pk2(v.z, v.w); return __builtin_bit_cast(s16x4, w); }

struct LinRaw { unsigned short v[16], q[16], k[16]; f32x4 gk4; };
template <int MODE>
__device__ __forceinline__ void lin_stage1_load(Ctx& C, int item, LinRaw& R) {
    const int lane = C.lane, bh = item >> 7, blk = item & 127, b = bh >> 2, h = bh & 3;
    const bf16* P = (const bf16*)(C.ws + WS_P); const size_t row0 = (size_t)b * SEQ + blk * 16;
    const bf16* vp = P + row0 * NP + (MODE == 0 ? 9 : 12) * 256 + h * 64 + lane;
    const bf16* qp = MODE == 0 ? P + row0 * NP + 7 * 256 + h * 64 + lane : P + row0 * NP + 11 * 256 + h * 32 + (lane & 31);
    const bf16* kp = qp + (MODE == 0 ? 256 : 128);
#pragma unroll
    for (int t = 0; t < 16; ++t) { R.q[t] = qp[(size_t)t * NP]; R.k[t] = kp[(size_t)t * NP]; }
    if (MODE == 1) R.gk4 = *(const f32x4*)((const float*)(C.ws + WS_PS) + (row0 + (lane >> 2)) * 32 + 12 + 4 * (lane & 3));
}
template <int MODE>
__device__ __forceinline__ void lin_stage1_finish(Ctx& C, int l, int item, const LinRaw& R, LAS float* gl) {
    constexpr int DK = MODE == 0 ? 64 : 32;
    const int lane = C.lane, bh = item >> 7, blk = item & 127, b = bh >> 2, h = bh & 3;
    bf16* P = (bf16*)(C.ws + WS_P);
    const size_t row0 = (size_t)b * SEQ + blk * 16;
    bf16* Kt = (bf16*)((unsigned char*)C.out + (MODE == 0 ? OS_KTH : OS_KTG)) + (size_t)item * DK * 16;
    bf16* Vt = (bf16*)((unsigned char*)C.out + (MODE == 0 ? OS_VTH : OS_VTG)) + (size_t)item * 64 * 16;
    float* Ad = (float*)((unsigned char*)C.out + (MODE == 0 ? OS_ADH : OS_ADG)) + (size_t)item * DK;
    const int d = lane;
    float la[16], kk[16], qq[16];
    bf16* qp; bf16* kp;
    if (MODE == 0) {
        float lb = 0.f;
        if (l == 1) { const float a0 = C.ka->in[11][h * 64 + d], a1 = C.ka->in[11][256 + h * 64 + d]; lb = rcpf_(1.0f + __expf(a0 - a1)); }
        qp = P + row0 * NP + 7 * 256 + h * 64 + d; kp = qp + 256;
#pragma unroll
        for (int t = 0; t < 16; ++t) { const float qv = bf2f(R.q[t]), fv = bf2f(R.k[t]); const float sg = sigmoidf_(fv);
            la[t] = __logf(lb + (1.0f - lb) * sg); kk[t] = (1.0f - lb) * (1.0f - sg); qq[t] = siluf_(qv) * 0.125f; }
    } else {
        const float* Wg = C.ka->in[13] + l * 16 * 128 + h * 32 + (d & 31); const float bg = C.ka->in[14][l * 128 + h * 32 + (d & 31)];
        float wg[16];
#pragma unroll
        for (int r = 0; r < 16; ++r) wg[r] = Wg[r * 128];
        qp = P + row0 * NP + 11 * 256 + h * 32 + (d & 31); kp = qp + 128;
        *(LAS f32x4*)(gl + lane * 4) = R.gk4;
        LDS_WAIT();
#pragma unroll
        for (int t = 0; t < 16; ++t) { float gk[16];
#pragma unroll
            for (int r4 = 0; r4 < 4; ++r4) { const f32x4 q4 = *(const LAS f32x4*)(gl + t * 16 + 4 * r4); gk[4 * r4] = q4.x; gk[4 * r4 + 1] = q4.y; gk[4 * r4 + 2] = q4.z; gk[4 * r4 + 3] = q4.w; }
            float zz = bg;
#pragma unroll
            for (int r = 0; r < 16; ++r) zz += gk[r] * wg[r];
            la[t] = logsigmoidf_(zz) * (1.0f / 16.0f); kk[t] = bf2f(R.k[t]); qq[t] = bf2f(R.q[t]) * 0.17677669529663687f; }
    }
    if (MODE == 0 || lane < 32) {
        float g = 0.f;
#pragma unroll
        for (int t = 0; t < 16; ++t) { g += la[t]; la[t] = g; }
        unsigned w[8];
#pragma unroll
        for (int t = 0; t < 16; ++t) {
            qp[(size_t)t * NP] = (bf16)f2bf(qq[t] * __expf(la[t]));
            kp[(size_t)t * NP] = (bf16)f2bf(kk[t] * __expf(fminf(-la[t], 80.f)));
            const unsigned kt = f2bf(kk[t] * __expf(g - la[t]));
            if (t & 1) w[t >> 1] |= kt << 16; else w[t >> 1] = kt;
        }
        { v4u* o = (v4u*)(Kt + d * 16); o[0] = (v4u){w[0], w[1], w[2], w[3]}; o[1] = (v4u){w[4], w[5], w[6], w[7]}; }
        Ad[d] = __expf(g);
    }
}
template <int MODE>
__device__ __forceinline__ void lin_stage1_pair(Ctx& C, int l, int itemA, int itemB, LAS unsigned char* wl) {
    LinRaw A, B; lin_stage1_load<MODE>(C, itemA, A); lin_stage1_load<MODE>(C, itemB, B);
    lin_stage1_finish<MODE>(C, l, itemA, A, (LAS float*)wl); lin_stage1_finish<MODE>(C, l, itemB, B, (LAS float*)(wl + 1024));
}
template <int MODE>
__device__ __forceinline__ void lin_stage1_quad(Ctx& C, int l, int item, int stride, LAS unsigned char* wl) {
    LinRaw A, B, D, E; lin_stage1_load<MODE>(C, item, A); lin_stage1_load<MODE>(C, item + stride, B); lin_stage1_load<MODE>(C, item + 2 * stride, D); lin_stage1_load<MODE>(C, item + 3 * stride, E);
    lin_stage1_finish<MODE>(C, l, item, A, (LAS float*)wl); lin_stage1_finish<MODE>(C, l, item + stride, B, (LAS float*)(wl + 1024));
    lin_stage1_finish<MODE>(C, l, item + 2 * stride, D, (LAS float*)(wl + 2048)); lin_stage1_finish<MODE>(C, l, item + 3 * stride, E, (LAS float*)(wl + 3072));
}

struct ScanSeg { const unsigned char* g; unsigned gstride, gstep; int nch, rowch, lpitch, loff; };
constexpr int SCAN_BH_LDS = 11520, SCAN_BUF = 2 * SCAN_BH_LDS, SCAN_XS = 2 * SCAN_BUF;
struct ScanCopy { const unsigned char* gp[3]; unsigned gstep[3]; int loff[3]; };
__device__ __forceinline__ void scan_copy_init(ScanCopy& cp, const ScanSeg (&segs)[2][6], int tid) {
    int per = 0;
#pragma unroll
    for (int s = 0; s < 6; ++s) per += segs[0][s].nch;
#pragma unroll
    for (int j = 0; j < 3; ++j) {
        const int c = tid + 512 * j; cp.gp[j] = nullptr; cp.gstep[j] = 0; cp.loff[j] = 0;
        if (c < 2 * per) {
            const int bhl = c >= per ? 1 : 0; int r = c - bhl * per;
#pragma unroll
            for (int s = 0; s < 6; ++s) {
                const ScanSeg& sg = segs[bhl][s];
                if (r >= 0 && r < sg.nch) {
                    const int row = sg.rowch ? r / sg.rowch : 0, ch = sg.rowch ? r % sg.rowch : r;
                    cp.gp[j] = sg.g + (size_t)row * sg.gstride + ch * 16; cp.gstep[j] = sg.gstep; cp.loff[j] = bhl * SCAN_BH_LDS + sg.loff + row * sg.lpitch + ch * 16;
                }
                r -= sg.nch;
            }
        } else { cp.gp[j] = cp.gp[0]; cp.gstep[j] = cp.gstep[0]; cp.loff[j] = cp.loff[0]; }
    }
}
__device__ __forceinline__ void scan_copy_load(const ScanCopy& cp, v4u (&R)[3], int step) {
#pragma unroll
#ifdef SCAN_NT
    for (int j = 0; j < 3; ++j) R[j] = __builtin_nontemporal_load((const v4u*)(cp.gp[j] + (size_t)step * cp.gstep[j]));
#else
    for (int j = 0; j < 3; ++j) R[j] = *(const v4u*)(cp.gp[j] + (size_t)step * cp.gstep[j]);
#endif
}
__device__ __forceinline__ void scan_copy_store(const ScanCopy& cp, const v4u (&R)[3], LAS unsigned char* buf) {
#pragma unroll
    for (int j = 0; j < 3; ++j) *(LAS v4u*)(buf + cp.loff[j]) = R[j];
}

template <int MODE>
__device__ __forceinline__ void lin_scan(Ctx& C, int l, int bh0) {
    constexpr int DK = MODE == 0 ? 64 : 32, ND = DK / 16, PQ = DK * 2 + 16;
    constexpr int OQ = 0, OK = 16 * PQ, OZ = 2 * 16 * PQ, OKT = OZ + 2304, OVT = OKT + DK * 32, OAD = OVT + 2048;
    static_assert(OAD + DK * 4 <= SCAN_BH_LDS, "scan LDS map");
    const int lane = C.lane, n = lane & 15, g = lane >> 4, et = C.wave & 3, bhl = C.wave >> 2, bh = bh0 + bhl, b = bh >> 2, h = bh & 3;
    const unsigned char* P = C.ws + WS_P; bf16* O = (bf16*)(C.ws + WS_O);
    const float* gain = (MODE == 0 ? C.ka->in[12] : C.ka->in[15]) + l * 64;
    const int ocol = (MODE == 0 ? 512 : 768) + (MODE == 0 ? (h ^ (HGO ? 2 : 0)) : h) * 64;
    ScanSeg segs[2][6];
#pragma unroll
    for (int q = 0; q < 2; ++q) {
        const int bq = bh0 + q, hq = bq & 3; const size_t rb = (size_t)(bq >> 2) * SEQ;
        const int qcol = MODE == 0 ? 7 * 256 + (hq ^ HGP) * 64 : 11 * 256 + hq * 32, kcol = MODE == 0 ? 8 * 256 + (hq ^ HGP) * 64 : 11 * 256 + 128 + hq * 32, zcol = (MODE == 0 ? 10 : 13) * 256 + hq * 64;
        segs[q][0] = ScanSeg{P + (rb * NP + qcol) * 2, NP * 2, 16 * NP * 2, 16 * (DK / 8), DK / 8, PQ, OQ};
        segs[q][1] = ScanSeg{P + (rb * NP + kcol) * 2, NP * 2, 16 * NP * 2, 16 * (DK / 8), DK / 8, PQ, OK};
        segs[q][2] = ScanSeg{P + (rb * NP + zcol) * 2, NP * 2, 16 * NP * 2, 128, 8, 144, OZ};
        segs[q][3] = ScanSeg{(unsigned char*)C.out + (MODE == 0 ? OS_KTH : OS_KTG) + (size_t)(MODE == 0 ? bq ^ HGX : bq) * 128 * DK * 32, 0, DK * 32, DK * 2, 0, 0, OKT};
        segs[q][4] = ScanSeg{(unsigned char*)C.out + (MODE == 0 ? OS_VTH : OS_VTG) + (size_t)(MODE == 0 ? bq ^ HGX : bq) * 128 * 2048, 0, 2048, 128, 0, 0, OVT};
        segs[q][5] = ScanSeg{(unsigned char*)C.out + (MODE == 0 ? OS_ADH : OS_ADG) + (size_t)(MODE == 0 ? bq ^ HGX : bq) * 128 * DK * 4, 0, DK * 4, DK / 4, 0, 0, OAD};
    }
    ScanCopy cp; scan_copy_init(cp, segs, C.tid);
#ifdef SCAN_PRIO
    if (C.wave >= 4) __builtin_amdgcn_s_setprio(1);
#endif
    LAS unsigned char* lds = C.lds; LAS float* xs = (LAS float*)(lds + SCAN_XS);
    f32x4 S[ND];
#pragma unroll
    for (int i = 0; i < ND; ++i) S[i] = (f32x4){0.f, 0.f, 0.f, 0.f};
    const f32x4 gn = *(const f32x4*)(gain + 16 * et + 4 * g);
    const size_t rowb = (size_t)b * SEQ;
    v4u R[4][3];
    scan_copy_load(cp, R[0], 0); scan_copy_store(cp, R[0], lds);
    scan_copy_load(cp, R[1], 1); scan_copy_load(cp, R[2], 2); scan_copy_load(cp, R[3], 3); scan_copy_load(cp, R[0], 4);
    __syncthreads();
#pragma unroll 1
    for (int blk0 = 0; blk0 < 128; blk0 += 4) {
#pragma unroll
        for (int u = 0; u < 4; ++u) {
            const int blk = blk0 + u;
            scan_copy_store(cp, R[(u + 1) & 3], lds + ((blk + 1) & 1) * SCAN_BUF);
            scan_copy_load(cp, R[(u + 1) & 3], blk + 5 < 128 ? blk + 5 : 127);
            const LAS unsigned char* base = lds + (blk & 1) * SCAN_BUF + bhl * SCAN_BH_LDS;
            s16x4 qf[ND], khf[ND], ktf[ND]; f32x4 ad[ND];
#pragma unroll
            for (int i = 0; i < ND; ++i) { qf[i] = *(const LAS s16x4*)(base + OQ + n * PQ + (16 * i + 4 * g) * 2); khf[i] = *(const LAS s16x4*)(base + OK + n * PQ + (16 * i + 4 * g) * 2);
                ktf[i] = *(const LAS s16x4*)(base + OKT + ((16 * i + n) * 16 + 4 * g) * 2); ad[i] = *(const LAS f32x4*)(base + OAD + (16 * i + 4 * g) * 4); }
            const s16x4 vtf = *(const LAS s16x4*)(base + OVT + ((16 * et + n) * 16 + 4 * g) * 2), zf = *(const LAS s16x4*)(base + OZ + n * 144 + (16 * et + 4 * g) * 2);
            f32x4 at = (f32x4){0.f, 0.f, 0.f, 0.f};
#pragma unroll
            for (int i = 0; i < ND; ++i) at = mfma16(khf[i], qf[i], at);
#pragma unroll
            for (int j = 0; j < 4; ++j) if (4 * g + j > n) at[j] = 0.f;
            f32x4 oT = mfma16(vtf, cvt4(at), (f32x4){0.f, 0.f, 0.f, 0.f});
#pragma unroll
            for (int i = 0; i < ND; ++i) oT = mfma16(cvt4(S[i]), qf[i], oT);
#pragma unroll
            for (int i = 0; i < ND; ++i) S[i] = mfma16(ktf[i], vtf, S[i] * ad[i]);
            float ss = (oT.x * oT.x + oT.y * oT.y) + (oT.z * oT.z + oT.w * oT.w);
            ss = xsum32(xsum16(ss));
            LAS float* xp = xs + (blk & 1) * 128 + bhl * 64;
            if (g == 0) xp[et * 16 + n] = ss;
            __syncthreads();
            ss = (xp[n] + xp[16 + n]) + (xp[32 + n] + xp[48 + n]);
            const float r = rsqf_(ss * (1.0f / 64.0f) + RMS_EPS);
            { const v2u zw = __builtin_bit_cast(v2u, zf);
              const float z0 = bf2f(zw.x & 0xffffu), z1 = bf2f(zw.x >> 16), z2 = bf2f(zw.y & 0xffffu), z3 = bf2f(zw.y >> 16);
              v2u w; w.x = pk2(oT.x * r * gn.x * siluf_(z0), oT.y * r * gn.y * siluf_(z1)); w.y = pk2(oT.z * r * gn.z * siluf_(z2), oT.w * r * gn.w * siluf_(z3));
              *(v2u*)(O + (rowb + blk * 16 + n) * DM + ocol + 16 * et + 4 * g) = w; }
        }
    }
    __syncthreads();
#ifdef SCAN_PRIO
    __builtin_amdgcn_s_setprio(0);
#endif
}

struct GlaRaw { unsigned short v[16], q[2][4], k[2][4]; f32x4 gk4; };
struct GlaW { s16x4 bh[2], bl[2]; float bias[2]; };
__device__ __forceinline__ void gla_w_load(Ctx& C, int l, int h, GlaW& W) {
    const int n = C.lane & 15, g = C.lane >> 4;
#pragma unroll
    for (int dt = 0; dt < 2; ++dt) { const float* wp = C.ka->in[13] + l * 16 * 128 + h * 32 + 16 * dt + n; float w[4], lo[4];
#pragma unroll
        for (int j = 0; j < 4; ++j) { w[j] = wp[(4 * g + j) * 128]; lo[j] = w[j] - bf2f(f2bf(w[j])); }
        W.bh[dt] = cvt4((f32x4){w[0], w[1], w[2], w[3]}); W.bl[dt] = cvt4((f32x4){lo[0], lo[1], lo[2], lo[3]});
        W.bias[dt] = C.ka->in[14][l * 128 + h * 32 + 16 * dt + n]; }
}
__device__ __forceinline__ void gla_stage1_load(Ctx& C, int item, GlaRaw& R) {
    const int lane = C.lane, n = lane & 15, g = lane >> 4, bh = item >> 7, blk = item & 127, b = bh >> 2, h = bh & 3;
    const bf16* P = (const bf16*)(C.ws + WS_P); const size_t row0 = (size_t)b * SEQ + blk * 16;
    const bf16* vp = P + row0 * NP + 12 * 256 + h * 64 + lane;
#pragma unroll
    for (int dt = 0; dt < 2; ++dt)
#pragma unroll
        for (int j = 0; j < 4; ++j) { const bf16* qp = P + (row0 + 4 * g + j) * NP + 11 * 256 + h * 32 + 16 * dt + n; R.q[dt][j] = qp[0]; R.k[dt][j] = qp[128]; }
    R.gk4 = *(const f32x4*)((const float*)(C.ws + WS_PS) + (row0 + n) * 32 + 12 + 4 * g);
}
__device__ __forceinline__ void gla_stage1_finish(Ctx& C, int item, const GlaRaw& R, const GlaW& W) {
    const int lane = C.lane, n = lane & 15, g = lane >> 4, bh = item >> 7, blk = item & 127, b = bh >> 2, h = bh & 3;
    bf16* P = (bf16*)(C.ws + WS_P); const size_t row0 = (size_t)b * SEQ + blk * 16;
    bf16* Kt = (bf16*)((unsigned char*)C.out + OS_KTG) + (size_t)item * 32 * 16;
    bf16* Vt = (bf16*)((unsigned char*)C.out + OS_VTG) + (size_t)item * 64 * 16;
    float* Ad = (float*)((unsigned char*)C.out + OS_ADG) + (size_t)item * 32;
    f32x4 alo;
#pragma unroll
    for (int j = 0; j < 4; ++j) alo[j] = R.gk4[j] - bf2f(f2bf(R.gk4[j]));
    const s16x4 ah = cvt4(R.gk4), al = cvt4(alo);
#pragma unroll
    for (int dt = 0; dt < 2; ++dt) {
        f32x4 z = mfma16(ah, W.bh[dt], (f32x4){0.f, 0.f, 0.f, 0.f}); z = mfma16(al, W.bh[dt], z); z = mfma16(ah, W.bl[dt], z);
        float gc[4]; float run = 0.f;
#pragma unroll
        for (int j = 0; j < 4; ++j) { run += logsigmoidf_(z[j] + W.bias[dt]) * (1.0f / 16.0f); gc[j] = run; }
        const float s16 = xsum16(run), p16 = s16 - run, p32 = xsum32(s16) - s16;
        const float ex = ((g & 1) ? p16 : 0.f) + ((g & 2) ? p32 : 0.f), glast = s16 + p32;
        bf16* qp = P + (row0 + 4 * g) * NP + 11 * 256 + h * 32 + 16 * dt + n;
        float kt[4];
#pragma unroll
        for (int j = 0; j < 4; ++j) { const float G = ex + gc[j], kv = bf2f(R.k[dt][j]);
            qp[(size_t)j * NP] = (bf16)f2bf(bf2f(R.q[dt][j]) * 0.17677669529663687f * __expf(G));
            qp[(size_t)j * NP + 128] = (bf16)f2bf(kv * __expf(fminf(-G, 80.f)));
            kt[j] = kv * __expf(glast - G); }
        *(s16x4*)(Kt + (16 * dt + n) * 16 + 4 * g) = cvt4((f32x4){kt[0], kt[1], kt[2], kt[3]});
        if (g == 0) Ad[16 * dt + n] = __expf(glast);
    }
}
__device__ __forceinline__ void gla_stage1_pair(Ctx& C, int itemA, int itemB, const GlaW& W) {
    GlaRaw A, B; gla_stage1_load(C, itemA, A); gla_stage1_load(C, itemB, B);
    gla_stage1_finish(C, itemA, A, W); gla_stage1_finish(C, itemB, B, W);
}
constexpr size_t WS_GD_Q = 412 * MiB, WS_GD_W = 428 * MiB, WS_GD_KT = 444 * MiB, WS_GD_UT = 460 * MiB, WS_GD_AQ = 476 * MiB, WS_GD_AB = 480 * MiB;
typedef unsigned short us2_t __attribute__((ext_vector_type(2)));
struct GdnRaw { us2_t r[3][10]; float pb, pa; };
__device__ __forceinline__ void gdn_stage1_load(Ctx& C, int item, GdnRaw& R) {
    const int lane = C.lane, bh = item >> 7, blk = item & 127, b = bh >> 2, h = bh & 3;
    const bf16* P = (const bf16*)(C.ws + WS_P); const float* PS = (const float*)(C.ws + WS_PS);
    const size_t row0 = (size_t)b * SEQ + blk * 16;
#pragma unroll
    for (int part = 0; part < 3; ++part) { const bf16* rp = P + row0 * NP + 768 + part * 256 + h * 64 + lane;
#pragma unroll
#ifdef GDN_NT
        for (int i = 0; i < 19; ++i) R.r[part][i >> 1][i & 1] = __builtin_nontemporal_load(rp + (long)((blk * 16 + i - 3 >= 0) ? i - 3 : 0) * NP); }
#else
        for (int i = 0; i < 19; ++i) R.r[part][i >> 1][i & 1] = rp[(long)((blk * 16 + i - 3 >= 0) ? i - 3 : 0) * NP]; }
#endif
    const float* ps = PS + (row0 + (lane & 15)) * 32; R.pb = ps[4 + h]; R.pa = ps[8 + h];
}
__device__ __forceinline__ void gdn_stage1_finish(Ctx& C, int l, int item, const GdnRaw& R, LAS unsigned char* wl) {
    const int lane = C.lane, bh = item >> 7, blk = item & 127, b = bh >> 2, h = bh & 3, n = lane & 15, g = lane >> 4;
    const size_t row0 = (size_t)b * SEQ + blk * 16;
    bf16* Qg = (bf16*)(C.ws + WS_GD_Q) + row0 * 256 + h * 64; bf16* Wg = (bf16*)(C.ws + WS_GD_W) + row0 * 256 + h * 64;
    bf16* Ktg = (bf16*)(C.ws + WS_GD_KT) + (size_t)item * 1024; bf16* Utg = (bf16*)(C.ws + WS_GD_UT) + (size_t)item * 1024;
    bf16* Aqg = (bf16*)(C.ws + WS_GD_AQ) + (size_t)item * 256; float* Abg = (float*)(C.ws + WS_GD_AB);
    LAS bf16* qh = (LAS bf16*)wl; LAS bf16* kh = qh + 1024; LAS bf16* kT = kh + 1024; LAS bf16* vT = kT + 1024;
    LAS float* Ms = (LAS float*)(wl + 8192); LAS bf16* Xw = (LAS bf16*)(wl + 9216); LAS bf16* Xu = Xw + 256; LAS float* sc = (LAS float*)(wl + 10240);
    {
        const float Acoef = -__expf(C.ka->in[8][l * 4 + h]), dtb = C.ka->in[9][l * 4 + h];
        const float beta = sigmoidf_(R.pb); float gc = Acoef * softplusf_(R.pa + dtb);
#pragma unroll
        for (int o = 1; o < 16; o <<= 1) { const float t = __shfl_up(gc, o); if (n >= o) gc += t; }
        if (lane < 16) { sc[lane] = beta; sc[16 + lane] = gc; }
    }
    LDS_WAIT();
    float gc[16];
#pragma unroll
    for (int t = 0; t < 16; t += 4) { const f32x4 v = *(const LAS f32x4*)(sc + 16 + t); gc[t] = v.x; gc[t + 1] = v.y; gc[t + 2] = v.z; gc[t + 3] = v.w; }
    const float glast = gc[15];
    const float* cw = C.ka->in[7] + l * 4 * 768 + h * 64 + lane;
    float raw[3][19];
#pragma unroll
    for (int part = 0; part < 3; ++part)
#pragma unroll
        for (int i = 0; i < 19; ++i) raw[part][i] = (i >= 3 || blk > 0) ? bf2f(R.r[part][i >> 1][i & 1]) : 0.f;
    float kraw[16];
#pragma unroll
    for (int part = 0; part < 3; ++part) {
        const float w0 = cw[part * 256], w1 = cw[768 + part * 256], w2 = cw[2 * 768 + part * 256], w3 = cw[3 * 768 + part * 256];
        float y[16];
#pragma unroll
        for (int t = 0; t < 16; ++t) y[t] = siluf_(w0 * raw[part][t] + w1 * raw[part][t + 1] + w2 * raw[part][t + 2] + w3 * raw[part][t + 3]);
        if (part == 0) {
#pragma unroll
            for (int t = 0; t < 16; ++t) qh[t * 64 + lane] = (bf16)f2bf(y[t]);
        } else if (part == 1) {
            unsigned w[8];
#pragma unroll
            for (int t = 0; t < 16; ++t) { kh[t * 64 + lane] = (bf16)f2bf(y[t]); kraw[t] = y[t]; }
#pragma unroll
            for (int t = 0; t < 16; t += 2) w[t >> 1] = pk2(y[t], y[t + 1]);
            LAS v4u* o = (LAS v4u*)(kT + lane * 16); o[0] = (v4u){w[0], w[1], w[2], w[3]}; o[1] = (v4u){w[4], w[5], w[6], w[7]};
        } else {
            unsigned w[8];
#pragma unroll
            for (int t = 0; t < 16; t += 2) w[t >> 1] = pk2(y[t], y[t + 1]);
            LAS v4u* o = (LAS v4u*)(vT + lane * 16); o[0] = (v4u){w[0], w[1], w[2], w[3]}; o[1] = (v4u){w[4], w[5], w[6], w[7]};
        }
    }
    LDS_WAIT();
    f32x4 ckk = (f32x4){0.f, 0.f, 0.f, 0.f}, cqk = ckk, cqq = ckk;
#pragma unroll
    for (int i = 0; i < 4; ++i) { const s16x4 kf = *(const LAS s16x4*)(kh + n * 64 + 16 * i + 4 * g), qf = *(const LAS s16x4*)(qh + n * 64 + 16 * i + 4 * g);
        ckk = mfma16(kf, kf, ckk); cqk = mfma16(kf, qf, cqk); cqq = mfma16(qf, qf, cqq); }
    if (g == (n >> 2)) { const int j = n & 3; sc[32 + n] = rsqf_(ckk[j] + RMS_EPS); sc[48 + n] = rsqf_(cqq[j] + RMS_EPS) * 0.125f; }
    LDS_WAIT();
    float rnk[16], rnq[16];
#pragma unroll
    for (int t = 0; t < 16; t += 4) { const f32x4 a = *(const LAS f32x4*)(sc + 32 + t), c2 = *(const LAS f32x4*)(sc + 48 + t);
        rnk[t] = a.x; rnk[t + 1] = a.y; rnk[t + 2] = a.z; rnk[t + 3] = a.w; rnq[t] = c2.x; rnq[t + 1] = c2.y; rnq[t + 2] = c2.z; rnq[t + 3] = c2.w; }
    {
#pragma unroll
        for (int t = 0; t < 16; ++t) Qg[(size_t)t * 256 + lane] = (bf16)f2bf(bf2f(qh[t * 64 + lane]) * rnq[t] * __expf(gc[t]));
        unsigned wk[8];
#pragma unroll
        for (int t = 0; t < 16; t += 2) wk[t >> 1] = pk2(kraw[t] * rnk[t] * __expf(glast - gc[t]), kraw[t + 1] * rnk[t + 1] * __expf(glast - gc[t + 1]));
        v4u* og = (v4u*)(Ktg + lane * 16); og[0] = (v4u){wk[0], wk[1], wk[2], wk[3]}; og[1] = (v4u){wk[4], wk[5], wk[6], wk[7]};
    }
    { const float rkr = sc[32 + n], rqr = sc[48 + n]; const f32x4 rks = *(const LAS f32x4*)(sc + 32 + 4 * g);
#pragma unroll
      for (int j = 0; j < 4; ++j) { ckk[j] *= rks[j] * rkr; cqk[j] *= rks[j] * rqr; } }
    const float Gr = sc[16 + n], beta_r = sc[n];
    const f32x4 Gs = *(const LAS f32x4*)(sc + 16 + 4 * g);
    f32x4 mv, av;
#pragma unroll
    for (int j = 0; j < 4; ++j) { const int s = 4 * g + j; const float dec = __expf(Gr - Gs[j]); mv[j] = s < n ? beta_r * ckk[j] * dec : 0.f; av[j] = s <= n ? cqk[j] * dec : 0.f; }
    *(LAS f32x4*)(Ms + n * 16 + 4 * g) = mv;
    *(s16x4*)(Aqg + n * 16 + 4 * g) = cvt4(av);
    LDS_WAIT();
    float X[16];
    X[0] = (n == 0) ? 1.f : 0.f;
#pragma unroll
    for (int r = 1; r < 16; ++r) {
        float a0 = (n == r) ? 1.f : 0.f, a1 = 0.f;
#pragma unroll
        for (int s4 = 0; s4 < r; s4 += 4) { const f32x4 m4 = *(const LAS f32x4*)(Ms + r * 16 + s4);
            a0 -= m4.x * X[s4]; if (s4 + 1 < r) a1 -= m4.y * X[s4 + 1]; if (s4 + 2 < r) a0 -= m4.z * X[s4 + 2]; if (s4 + 3 < r) a1 -= m4.w * X[s4 + 3]; }
        X[r] = a0 + a1;
    }
    { const float bu = sc[n], bw = bu * __expf(sc[16 + n]) * sc[32 + n];
      if (lane < 16) {
#pragma unroll
          for (int r = 0; r < 16; ++r) { Xw[r * 16 + n] = (bf16)f2bf(X[r] * bw); Xu[r * 16 + n] = (bf16)f2bf(X[r] * bu); } } }
    LDS_WAIT();
    const s16x4 xwf = *(const LAS s16x4*)(Xw + n * 16 + 4 * g), xuf = *(const LAS s16x4*)(Xu + n * 16 + 4 * g);
#pragma unroll
    for (int i = 0; i < 4; ++i) {
        const f32x4 cwt = mfma16(*(const LAS s16x4*)(kT + (16 * i + n) * 16 + 4 * g), xwf, (f32x4){0.f, 0.f, 0.f, 0.f});
        *(s16x4*)(Wg + (size_t)n * 256 + 16 * i + 4 * g) = cvt4(cwt);
        const f32x4 cut = mfma16(xuf, *(const LAS s16x4*)(vT + (16 * i + n) * 16 + 4 * g), (f32x4){0.f, 0.f, 0.f, 0.f});
        *(s16x4*)(Utg + (16 * i + n) * 16 + 4 * g) = cvt4(cut);
    }
    if (lane == 0) Abg[item] = __expf(glast);
    LDS_WAIT();
}

__device__ __forceinline__ void gdn_scan(Ctx& C, int l, int bh0) {
    constexpr int OQ = 0, OW = 2304, OZ = 4608, OKT = 6912, OUT = 8960, OAQ = 11008;
    const int lane = C.lane, n = lane & 15, g = lane >> 4, et = C.wave & 3, bhl = C.wave >> 2, bh = bh0 + bhl, b = bh >> 2, h = bh & 3;
    bf16* O = (bf16*)(C.ws + WS_O);
    const float* Abg = (const float*)(C.ws + WS_GD_AB) + bh * 128;
    const float* gain = C.ka->in[10] + l * 64;
    ScanSeg segs[2][6];
#pragma unroll
    for (int q = 0; q < 2; ++q) {
        const int bq = bh0 + q, hq = bq & 3; const size_t rb = (size_t)(bq >> 2) * SEQ;
        segs[q][0] = ScanSeg{C.ws + WS_GD_Q + (rb * 256 + hq * 64) * 2, 512, 16 * 512, 128, 8, 144, OQ};
        segs[q][1] = ScanSeg{C.ws + WS_GD_W + (rb * 256 + hq * 64) * 2, 512, 16 * 512, 128, 8, 144, OW};
        segs[q][2] = ScanSeg{C.ws + WS_P + (rb * NP + 1536 + hq * 64) * 2, NP * 2, 16 * NP * 2, 128, 8, 144, OZ};
        segs[q][3] = ScanSeg{C.ws + WS_GD_KT + (size_t)bq * 128 * 2048, 0, 2048, 128, 0, 0, OKT};
        segs[q][4] = ScanSeg{C.ws + WS_GD_UT + (size_t)bq * 128 * 2048, 0, 2048, 128, 0, 0, OUT};
        segs[q][5] = ScanSeg{C.ws + WS_GD_AQ + (size_t)bq * 128 * 512, 0, 512, 32, 0, 0, OAQ};
    }
    ScanCopy cp; scan_copy_init(cp, segs, C.tid);
    LAS unsigned char* lds = C.lds; LAS float* xs = (LAS float*)(lds + SCAN_XS);
    f32x4 S[4];
#pragma unroll
    for (int i = 0; i < 4; ++i) S[i] = (f32x4){0.f, 0.f, 0.f, 0.f};
    const f32x4 gn = *(const f32x4*)(gain + 16 * et + 4 * g);
    const size_t rowb = (size_t)b * SEQ;
    v4u R[4][3]; float abr[4];
    scan_copy_load(cp, R[0], 0); scan_copy_store(cp, R[0], lds);
    scan_copy_load(cp, R[1], 1); scan_copy_load(cp, R[2], 2); scan_copy_load(cp, R[3], 3); scan_copy_load(cp, R[0], 4);
#pragma unroll
    for (int u = 0; u < 4; ++u) abr[u] = Abg[u];
    __syncthreads();
#pragma unroll 1
    for (int blk0 = 0; blk0 < 128; blk0 += 4) {
#pragma unroll
        for (int u = 0; u < 4; ++u) {
            const int blk = blk0 + u;
            scan_copy_store(cp, R[(u + 1) & 3], lds + ((blk + 1) & 1) * SCAN_BUF);
            scan_copy_load(cp, R[(u + 1) & 3], blk + 5 < 128 ? blk + 5 : 127);
            const float ab = abr[u]; abr[u] = Abg[blk + 4 < 128 ? blk + 4 : 127];
            const LAS unsigned char* base = lds + (blk & 1) * SCAN_BUF + bhl * SCAN_BH_LDS;
            s16x4 qf[4], wf[4], ktf[4];
#pragma unroll
            for (int i = 0; i < 4; ++i) { qf[i] = *(const LAS s16x4*)(base + OQ + n * 144 + (16 * i + 4 * g) * 2); wf[i] = *(const LAS s16x4*)(base + OW + n * 144 + (16 * i + 4 * g) * 2);
                ktf[i] = *(const LAS s16x4*)(base + OKT + ((16 * i + n) * 16 + 4 * g) * 2); }
            const s16x4 utf = *(const LAS s16x4*)(base + OUT + ((16 * et + n) * 16 + 4 * g) * 2), zf = *(const LAS s16x4*)(base + OZ + n * 144 + (16 * et + 4 * g) * 2);
            const s16x4 aqf = *(const LAS s16x4*)(base + OAQ + (n * 16 + 4 * g) * 2);
            s16x4 Sb[4];
#pragma unroll
            for (int i = 0; i < 4; ++i) Sb[i] = cvt4(S[i]);
            f32x4 acc = (f32x4){0.f, 0.f, 0.f, 0.f};
#pragma unroll
            for (int i = 0; i < 4; ++i) acc = mfma16(wf[i], Sb[i], acc);
            const v2u uw = __builtin_bit_cast(v2u, utf);
            f32x4 vn; vn.x = bf2f(uw.x & 0xffffu) - acc.x; vn.y = bf2f(uw.x >> 16) - acc.y; vn.z = bf2f(uw.y & 0xffffu) - acc.z; vn.w = bf2f(uw.y >> 16) - acc.w;
            const s16x4 vb = cvt4(vn);
            f32x4 oT = mfma16(vb, aqf, (f32x4){0.f, 0.f, 0.f, 0.f});
#pragma unroll
            for (int i = 0; i < 4; ++i) oT = mfma16(Sb[i], qf[i], oT);
#pragma unroll
            for (int i = 0; i < 4; ++i) S[i] = mfma16(ktf[i], vb, S[i] * ab);
            float ss = (oT.x * oT.x + oT.y * oT.y) + (oT.z * oT.z + oT.w * oT.w);
            ss = xsum32(xsum16(ss));
            LAS float* xp = xs + (blk & 1) * 128 + bhl * 64;
            if (g == 0) xp[et * 16 + n] = ss;
            __syncthreads();
            ss = (xp[n] + xp[16 + n]) + (xp[32 + n] + xp[48 + n]);
            const float r = rsqf_(ss * (1.0f / 64.0f) + RMS_EPS);
            { const v2u zw = __builtin_bit_cast(v2u, zf);
              const float z0 = bf2f(zw.x & 0xffffu), z1 = bf2f(zw.x >> 16), z2 = bf2f(zw.y & 0xffffu), z3 = bf2f(zw.y >> 16);
              v2u w; w.x = pk2(oT.x * r * gn.x * siluf_(z0), oT.y * r * gn.y * siluf_(z1)); w.y = pk2(oT.z * r * gn.z * siluf_(z2), oT.w * r * gn.w * siluf_(z3));
              *(v2u*)(O + (rowb + blk * 16 + n) * DM + 256 + (h ^ GDO) * 64 + 16 * et + 4 * g) = w; }
        }
    }
    __syncthreads();
}
typedef short bf16x8 __attribute__((ext_vector_type(8)));
constexpr size_t WS_FVT = 484 * MiB;
constexpr int FOX_KP = 72, FOX_BUF = 64 * FOX_KP * 2 * 2 + 256;
__device__ __forceinline__ void fox_vt_item(Ctx& C, int item) {
    const int lane = C.lane, bh = item >> 7, blk = item & 127, b = bh >> 2, h = bh & 3;
    const bf16* vp = (const bf16*)(C.ws + WS_P) + ((size_t)b * SEQ + blk * 16) * NP + 512 + h * 64 + lane; unsigned w[8];
#pragma unroll
    for (int t = 0; t < 16; t += 2) w[t >> 1] = (unsigned)vp[(size_t)t * NP] | ((unsigned)vp[(size_t)(t + 1) * NP] << 16);
    v4u* o = (v4u*)((bf16*)(C.ws + WS_FVT) + ((size_t)item * 64 + lane) * 16); o[0] = (v4u){w[0], w[1], w[2], w[3]}; o[1] = (v4u){w[4], w[5], w[6], w[7]};
}
__device__ __forceinline__ void fox_vt_pair(Ctx& C, int itemA, int itemB) {
    const int lane = C.lane; unsigned w[2][8];
#pragma unroll
    for (int q = 0; q < 2; ++q) { const int item = q ? itemB : itemA, bh = item >> 7, blk = item & 127, b = bh >> 2, h = bh & 3;
        const bf16* vp = (const bf16*)(C.ws + WS_P) + ((size_t)b * SEQ + blk * 16) * NP + 512 + h * 64 + lane;
#pragma unroll
        for (int t = 0; t < 16; t += 2) w[q][t >> 1] = (unsigned)vp[(size_t)t * NP] | ((unsigned)vp[(size_t)(t + 1) * NP] << 16); }
#pragma unroll
    for (int q = 0; q < 2; ++q) { const int item = q ? itemB : itemA;
        v4u* o = (v4u*)((bf16*)(C.ws + WS_FVT) + ((size_t)item * 64 + lane) * 16); o[0] = (v4u){w[q][0], w[q][1], w[q][2], w[q][3]}; o[1] = (v4u){w[q][4], w[q][5], w[q][6], w[q][7]}; }
}
__device__ __forceinline__ void fox_unit(Ctx& C, int l, int bh, int qb) {
    const int tid = C.tid, lane = C.lane, wave = C.wave, n = lane & 15, g = lane >> 4, b = bh >> 2, h = bh & 3;
    const bf16* P = (const bf16*)(C.ws + WS_P); const float* CF = (const float*)(C.ws + WS_CF) + (size_t)bh * SEQ; bf16* O = (bf16*)(C.ws + WS_O);
    const bf16* Vtf = (const bf16*)(C.ws + WS_FVT) + (size_t)bh * 128 * 1024;
    const size_t rowb = (size_t)b * SEQ;
    const int q0 = qb * 256 + wave * 32;
#ifdef FOX_PRIO
    if (wave >= 4) __builtin_amdgcn_s_setprio(1);
#endif
    bf16x8 qf[2][2];
#pragma unroll
    for (int qs = 0; qs < 2; ++qs) {
#pragma unroll
        for (int ks = 0; ks < 2; ++ks) qf[qs][ks] = *(const bf16x8*)(P + (rowb + q0 + 16 * qs + n) * NP + h * 64 + 32 * ks + 8 * g); }
    f32x4 OT[2][4];
#pragma unroll
    for (int qs = 0; qs < 2; ++qs)
#pragma unroll
        for (int dt = 0; dt < 4; ++dt) OT[qs][dt] = (f32x4){0.f, 0.f, 0.f, 0.f};
    float mx[2] = {-INFINITY, -INFINITY}, lsum[2] = {0.f, 0.f};
    const int ntiles = 4 * (qb + 1);
    const int kkey = tid >> 3, kch = tid & 7, vb4 = tid >> 7, vd = (tid >> 1) & 63, vh = tid & 1;
    const bf16* kptr = P + (rowb + kkey) * NP + 256 + h * 64 + 8 * kch;
    const bf16* vptr = Vtf + ((size_t)vb4 * 64 + vd) * 16 + 8 * vh;
    const int kw = kkey * FOX_KP + 8 * kch, vw = 64 * FOX_KP + vd * FOX_KP + 16 * vb4 + 8 * vh;
    LAS unsigned char* lds = C.lds;
    v4u kr[2], vr[2]; float cr[2];
#define FOX_LOAD(set, t) do { const int t_ = (t) < ntiles ? (t) : ntiles - 1; kr[set] = *(const v4u*)(kptr + (size_t)t_ * 64 * NP); vr[set] = *(const v4u*)(vptr + (size_t)t_ * 4 * 1024); cr[set] = CF[t_ * 64 + (tid & 63)]; } while (0)
#define FOX_STORE(set, buf) do { *(LAS v4u*)((LAS bf16*)(buf) + kw) = kr[set]; *(LAS v4u*)((LAS bf16*)(buf) + vw) = vr[set]; if (tid < 64) ((LAS float*)((buf) + 64 * FOX_KP * 4))[tid] = cr[set]; } while (0)
#define FOX_QK(slot, t_) do { if (64 * (t_) <= q0 + 31 && (t_) < ntiles) { const LAS bf16* Ks_ = (const LAS bf16*)(lds + ((t_) & 3) * FOX_BUF); \
        _Pragma("unroll") for (int mt = 0; mt < 4; ++mt) { bf16x8 kf_[2]; \
            _Pragma("unroll") for (int ks = 0; ks < 2; ++ks) kf_[ks] = *(const LAS bf16x8*)(Ks_ + (16 * mt + n) * FOX_KP + 32 * ks + 8 * g); \
            _Pragma("unroll") for (int qs = 0; qs < 2; ++qs) { f32x4 a_ = (f32x4){0.f, 0.f, 0.f, 0.f}; \
                _Pragma("unroll") for (int ks = 0; ks < 2; ++ks) a_ = __builtin_amdgcn_mfma_f32_16x16x32_bf16(kf_[ks], qf[qs][ks], a_, 0, 0, 0); \
                sv[slot][qs][mt] = a_; } } } } while (0)
#define FOX_QKS(slot, t_, b_) do { if (64 * (t_) <= q0 + 31 && (t_) < ntiles) { const LAS bf16* Ks_ = (const LAS bf16*)(lds + (b_) * FOX_BUF); \
        _Pragma("unroll") for (int mt = 0; mt < 4; ++mt) { bf16x8 kf_[2]; \
            _Pragma("unroll") for (int ks = 0; ks < 2; ++ks) kf_[ks] = *(const LAS bf16x8*)(Ks_ + (16 * mt + n) * FOX_KP + 32 * ks + 8 * g); \
            _Pragma("unroll") for (int qs = 0; qs < 2; ++qs) { f32x4 a_ = (f32x4){0.f, 0.f, 0.f, 0.f}; \
                _Pragma("unroll") for (int ks = 0; ks < 2; ++ks) a_ = __builtin_amdgcn_mfma_f32_16x16x32_bf16(kf_[ks], qf[qs][ks], a_, 0, 0, 0); \
                sv[slot][qs][mt] = a_; } } } } while (0)
    f32x4 sv[2][2][4];
    FOX_LOAD(0, 0); FOX_LOAD(1, 1); FOX_STORE(0, lds); FOX_STORE(1, lds + FOX_BUF);
    FOX_LOAD(0, 2); FOX_LOAD(1, 3);
    __syncthreads();
    FOX_QK(0, 0);
#pragma unroll 1
    for (int kt0 = 0; kt0 < ntiles; kt0 += 4) {
#pragma unroll
      for (int uu = 0; uu < 4; ++uu) {
        const int kt = kt0 + uu; constexpr int dummy_ = 0; (void)dummy_;
        const int u = uu & 1;
        FOX_STORE(u, lds + ((uu + 2) & 3) * FOX_BUF);
        FOX_LOAD(u, kt + 4);
        FOX_QKS(u ^ 1, kt + 1, (uu + 1) & 3);
#ifndef FOX_NOSB
        __builtin_amdgcn_sched_barrier(0);
#endif
        if (64 * kt <= q0 + 31) {
            const bool diag = 64 * kt + 63 > q0;
            LAS unsigned char* cur = lds + uu * FOX_BUF;
            const LAS bf16* Vs = (const LAS bf16*)cur + 64 * FOX_KP; const LAS float* Cs = (const LAS float*)(cur + 64 * FOX_KP * 4);
            f32x4 c4[4];
#pragma unroll
            for (int mt = 0; mt < 4; ++mt) c4[mt] = *(const LAS f32x4*)(Cs + 16 * mt + 4 * g);
            s16x4 pb[2][4]; float corr[2];
#pragma unroll
            for (int qs = 0; qs < 2; ++qs) {
                float mloc = mx[qs];
#pragma unroll
                for (int mt = 0; mt < 4; ++mt) { sv[u][qs][mt] = sv[u][qs][mt] - c4[mt];
                    if (diag) {
#pragma unroll
                        for (int j = 0; j < 4; ++j) if (64 * kt + 16 * mt + 4 * g + j > q0 + 16 * qs + n) sv[u][qs][mt][j] = -INFINITY; }
                    mloc = fmax3_(fmax3_(mloc, sv[u][qs][mt][0], sv[u][qs][mt][1]), sv[u][qs][mt][2], sv[u][qs][mt][3]); }
                mloc = fmax3_(mloc, __shfl_xor(mloc, 16), mloc); mloc = fmax3_(mloc, __shfl_xor(mloc, 32), mloc);
                const float mn = mloc; corr[qs] = __builtin_amdgcn_exp2f(mx[qs] - mn);
                mx[qs] = mn; lsum[qs] *= corr[qs];
#pragma unroll
                for (int mt = 0; mt < 4; ++mt) { f32x4 p;
#pragma unroll
                    for (int j = 0; j < 4; ++j) { p[j] = __builtin_amdgcn_exp2f(sv[u][qs][mt][j] - mn); lsum[qs] += p[j]; }
                    pb[qs][mt] = cvt4(p); }
            }
#pragma unroll
            for (int dt = 0; dt < 4; ++dt) {
                bf16x8 vf2[2];
#pragma unroll
                for (int a = 0; a < 2; ++a) { const s16x4 lo = *(const LAS s16x4*)(Vs + (16 * dt + n) * FOX_KP + 32 * a + 4 * g), hi = *(const LAS s16x4*)(Vs + (16 * dt + n) * FOX_KP + 32 * a + 16 + 4 * g);
                    vf2[a] = (bf16x8){lo[0], lo[1], lo[2], lo[3], hi[0], hi[1], hi[2], hi[3]}; }
#pragma unroll
                for (int qs = 0; qs < 2; ++qs) { OT[qs][dt] = OT[qs][dt] * corr[qs];
#pragma unroll
                    for (int a = 0; a < 2; ++a) { const s16x4 lo = pb[qs][2 * a], hi = pb[qs][2 * a + 1];
                        OT[qs][dt] = __builtin_amdgcn_mfma_f32_16x16x32_bf16(vf2[a], (bf16x8){lo[0], lo[1], lo[2], lo[3], hi[0], hi[1], hi[2], hi[3]}, OT[qs][dt], 0, 0, 0); } }
            }
        }
        __syncthreads();
      }
    }
#undef FOX_QK
#undef FOX_QKS
#undef FOX_LOAD
#undef FOX_STORE
#ifdef FOX_PRIO
    __builtin_amdgcn_s_setprio(0);
#endif
    const float* on_g = C.ka->in[6] + l * 64;
#pragma unroll
    for (int qs = 0; qs < 2; ++qs) {
        float ls = xsum32(xsum16(lsum[qs]));
        const float inv = rcpf_(ls); float ss = 0.f;
#pragma unroll
        for (int dt = 0; dt < 4; ++dt) { OT[qs][dt] = OT[qs][dt] * inv; ss += (OT[qs][dt].x * OT[qs][dt].x + OT[qs][dt].y * OT[qs][dt].y) + (OT[qs][dt].z * OT[qs][dt].z + OT[qs][dt].w * OT[qs][dt].w); }
        ss = xsum32(xsum16(ss));
        const float r = rsqf_(ss * (1.0f / 64.0f) + RMS_EPS);
#pragma unroll
        for (int dt = 0; dt < 4; ++dt) { const f32x4 gg = *(const f32x4*)(on_g + 16 * dt + 4 * g);
            v2u w; w.x = pk2(OT[qs][dt].x * r * gg.x, OT[qs][dt].y * r * gg.y); w.y = pk2(OT[qs][dt].z * r * gg.z, OT[qs][dt].w * r * gg.w);
            *(v2u*)(O + (rowb + q0 + 16 * qs + n) * DM + h * 64 + 16 * dt + 4 * g) = w; }
    }
}
#ifdef PROBE_TS
#define SUBTS(i) do { if (blockIdx.x == PROBE_BLK && C.tid == 0 && l == 0) ((volatile LAS unsigned long long*)(C.lds + LDS_BYTES - 512))[16 + (i)] = __builtin_amdgcn_s_memrealtime(); } while (0)
#else
#define SUBTS(i) do { } while (0)
#endif
constexpr int SCAN_BLOCKS = 96;
__device__ __forceinline__ void m1_mixers(Ctx& C, int l) {
    const int bx = (int)blockIdx.x;
    SUBTS(6);
#ifdef PROBE_FOXW
    if (blockIdx.x == PROBE_BLK && C.tid == 0 && l == 0) { volatile LAS unsigned long long* t_ = (volatile LAS unsigned long long*)(C.lds + LDS_BYTES - 512); t_[25] = 0; t_[26] = 0; }
#endif
    if (bx < SCAN_BLOCKS) {
        if (bx < 32) gdn_scan(C, l, 2 * bx);
#ifdef HG_ROT
        else if (bx < 64) lin_scan<0>(C, l, 2 * ((bx - 32 + 1) & 31));
#else
        else if (bx < 64) lin_scan<0>(C, l, 2 * (bx - 32));
#endif
        else lin_scan<1>(C, l, 2 * (bx - 64));
        SUBTS(7);
#ifdef DUP_SCAN
        __syncthreads();
        if (bx < 32) gdn_scan(C, l, 2 * bx);
        else if (bx < 64) lin_scan<0>(C, l, 2 * (bx - 32));
        else lin_scan<1>(C, l, 2 * (bx - 64));
#endif
    } else {
        const int G2 = (int)gridDim.x - SCAN_BLOCKS, j = (int)blockIdx.x - SCAN_BLOCKS;
        for (int r = 0; r * G2 < 512; ++r) { const int u = r * G2 + ((r & 1) ? (G2 - 1 - j) : j); if (u < 512) fox_unit(C, l, u & 63, 7 - (u >> 6)); }
        SUBTS(7);
#ifdef DUP_FOX
        for (int r = 0; r * G2 < 512; ++r) { const int u = r * G2 + ((r & 1) ? (G2 - 1 - j) : j); if (u < 512) fox_unit(C, l, u & 63, 7 - (u >> 6)); }
#endif
    }
}

__device__ __forceinline__ void cv_fixup(Ctx& C, int l) {
    const float* H = (const float*)(C.ws + WS_HALO); bf16* ACT = (bf16*)(C.ws + WS_ACT);
    const float* cw = C.ka->in[19] + (size_t)l * 3 * NUP; const float* cb = C.ka->in[20] + (size_t)l * NUP;
    for (int i = blockIdx.x * NTHREADS + C.tid; i < 128 * 22 * 2 * 128; i += gridDim.x * NTHREADS) {
        const int j = i & 127, rr = (i >> 7) & 1, t = i >> 8, pn = t % 22, pm = t / 22;
        if ((pm & 7) == 0) continue;
        const float* h0 = H + (size_t)(pm * 22 + pn) * 1024; const float* hp = H + (size_t)((pm - 1) * 22 + pn) * 1024;
        float uo[2];
#pragma unroll
        for (int bj = 0; bj < 2; ++bj) { const int c = bj * 128 + j, col = bj * DFF + pn * 128 + j;
            const float y0 = h0[rr * 256 + c], y1 = rr == 0 ? hp[3 * 256 + c] : h0[c], y2 = rr == 0 ? hp[2 * 256 + c] : hp[3 * 256 + c];
            uo[bj] = cw[col] * y2 + cw[NUP + col] * y1 + cw[2 * NUP + col] * y0 + cb[col]; }
        ACT[(size_t)(pm * 256 + rr) * DFF + pn * 128 + j] = (bf16)f2bf(siluf_(uo[0]) * uo[1]);
    }
}

__device__ __forceinline__ void cv_fix_rows(Ctx& C, int l, const pg8::StaticOrder& S) {
    const float* H = (const float*)(C.ws + WS_HALO); bf16* ACT = (bf16*)(C.ws + WS_ACT);
    const float* cw = C.ka->in[19] + (size_t)l * 3 * NUP; const float* cb = C.ka->in[20] + (size_t)l * NUP;
    pg8::Unit u;
#pragma unroll 1
    for (int i = 0; S.next(i, u); ++i) {
        const int pm = u.pm;
        if ((pm & 7) == 0) continue;
#pragma unroll 1
        for (int it = C.tid; it < 2 * 22 * 32; it += NTHREADS) {
            const int j4 = it & 31, t = it >> 5, pn = t % 22, rr = t / 22;
            const float* h0 = H + (size_t)(pm * 22 + pn) * 1024; const float* hp = H + (size_t)((pm - 1) * 22 + pn) * 1024;
            f32x4 uo[2];
#pragma unroll
            for (int bj = 0; bj < 2; ++bj) { const int cc = bj * 128 + 4 * j4, col = bj * DFF + pn * 128 + 4 * j4;
                const f32x4 y0 = *(const f32x4*)(h0 + rr * 256 + cc), y1 = *(const f32x4*)(rr == 0 ? hp + 3 * 256 + cc : h0 + cc), y2 = *(const f32x4*)(rr == 0 ? hp + 2 * 256 + cc : hp + 3 * 256 + cc);
                uo[bj] = ((*(const f32x4*)(cb + col) + *(const f32x4*)(cw + 2 * NUP + col) * y0) + *(const f32x4*)(cw + NUP + col) * y1) + *(const f32x4*)(cw + col) * y2; }
            pg8::u32x2 o; o.x = pg8::cvt_pk_bf16(siluf_(uo[0][0]) * uo[1][0], siluf_(uo[0][1]) * uo[1][1]); o.y = pg8::cvt_pk_bf16(siluf_(uo[0][2]) * uo[1][2], siluf_(uo[0][3]) * uo[1][3]);
            *(pg8::u32x2*)(ACT + (size_t)(pm * 256 + rr) * DFF + pn * 128 + 4 * j4) = o;
        }
    }
    asm volatile("s_waitcnt vmcnt(0)" ::: "memory"); __syncthreads();
}

struct Args { const float* in[22]; float* out; unsigned char* ws; };
__global__ void __launch_bounds__(NTHREADS, 2) fwd_megakernel(Args args) {
    extern __shared__ __attribute__((aligned(16))) unsigned char lds_raw[];
    cg::grid_group grid = cg::this_grid();
    Ctx C;
    C.ka = (const CAS KArgs*)__builtin_amdgcn_kernarg_segment_ptr();
    C.out = args.out; C.ws = args.ws;
    C.lds = (LAS unsigned char*)lds_raw;
    C.tid = threadIdx.x; C.lane = C.tid & 63; C.wave = __builtin_amdgcn_readfirstlane(C.tid >> 6);
    const int wv0 = C.wave;
    C.gw = blockIdx.x * NWAVES + C.wave; C.ngw = gridDim.x * NWAVES;
    const int G = gridDim.x;
    volatile LAS unsigned* bst = (volatile LAS unsigned*)(C.lds + LDS_BYTES - 16);
    if (C.tid < 4) bst[C.tid] = 0u;
    __syncthreads();
    const XcdBarrier xbar = xcd_barrier_post((unsigned*)(args.ws + WS_BAR), bst, C.tid);
#ifdef PROBE_TS
    volatile LAS unsigned long long* tsl = (volatile LAS unsigned long long*)(C.lds + LDS_BYTES - 512); int nts = 0;
#define GRID_SYNC() do { unsigned zb_ = 0; asm volatile("" : "+s"(zb_)); xcd_barrier(xbar, tid_from(wv0, zb_)); if (blockIdx.x == PROBE_BLK && tid_from(wv0, zb_) == 0) tsl[nts] = __builtin_amdgcn_s_memrealtime(); ++nts; } while (0)
#else
#define GRID_SYNC() do { unsigned zb_ = 0; asm volatile("" : "+s"(zb_)); xcd_barrier(xbar, tid_from(wv0, zb_)); } while (0)
#endif
    unsigned char* const ws0 = args.ws; float* const out0 = args.out;
#define PHASE_BEGIN() do { size_t z_ = 0; const CAS KArgs* k_ = (const CAS KArgs*)__builtin_amdgcn_kernarg_segment_ptr(); asm volatile("" : "+s"(z_), "+s"(k_)); int t_ = tid_from(wv0, (unsigned)z_); asm volatile("" : "+v"(t_)); \
        unsigned char* w_ = ws0 + z_; float* o_ = out0 + z_;     \
        C.ws = w_; C.out = o_; C.ka = k_; C.tid = t_; C.lane = t_ & 63; C.wave = __builtin_amdgcn_readfirstlane(t_ >> 6); C.gw = blockIdx.x * NWAVES + C.wave; ss = (float*)(w_ + WS_SS); XB = (bf16*)(w_ + WS_XB); } while (0)
    float* ss; bf16* XB;

#ifdef PROBE_TS
    if (blockIdx.x == PROBE_BLK && C.tid == 0) tsl[15] = __builtin_amdgcn_s_memrealtime();
#endif
#ifndef NO_P0
    p0_prologue(C);
#ifdef DUP_P0
    grid.sync(); p0_prologue(C);
#endif
#endif
    GRID_SYNC();
    if (gridDim.x > 65536u) grid.sync();
    for (int l = 0; l < DEPTH; ++l) {
        PHASE_BEGIN();
        {
            pg8::Gemm g{XB, (const bf16*)(C.ws + WS_W1T) + (size_t)l * N1 * DM, MTOK, N1, DM}; pg8::StaticOrder S; S.init(MTOK, N1, G, (int)blockIdx.x);
            pg8::EpiP E{(bf16*)(C.ws + WS_P), (float*)(C.ws + WS_PS), ss + (size_t)l * MTOK, (float*)(C.ws + WS_FF), C.ka->in[3] + l * 64, C.ka->in[4] + l * 64, (bf16*)(C.ws + WS_FVT), (bf16*)((unsigned char*)C.out + OS_VTH), (bf16*)((unsigned char*)C.out + OS_VTG), C.ka->in[11], l, (bf16*)((unsigned char*)C.out + OS_KTH), (float*)((unsigned char*)C.out + OS_ADH), C.ka->in[14] + l * 128, (bf16*)((unsigned char*)C.out + OS_KTG), (float*)((unsigned char*)C.out + OS_ADG)};
#ifndef NO_G1
            pg8::gemm_phase<pg8::EpiP, pg8::StaticOrder, true, true>(C.lds, g, S, E, C.tid);
#ifndef P0_ALL_WEIGHTS
            if (l == 0 && (int)blockIdx.x >= 1920 - 7 * G && G == 256) { asm volatile("s_waitcnt vmcnt(0) lgkmcnt(0)" ::: "memory"); __syncthreads(); p0_weights(C, TR_SPLIT, 2 * TR_IL, ((int)blockIdx.x - 128) * NWAVES + C.wave, 128 * NWAVES); }
            else if (l == 0 && G != 256) { asm volatile("s_waitcnt vmcnt(0) lgkmcnt(0)" ::: "memory"); __syncthreads(); p0_weights(C, TR_SPLIT, 2 * TR_IL, C.gw, C.ngw); }
#endif
#ifdef DUP_G1
            GRID_SYNC(); pg8::gemm_phase<pg8::EpiP, pg8::StaticOrder, true, true>(C.lds, g, S, E, C.tid);
#endif
#endif
        }
        GRID_SYNC();
        PHASE_BEGIN();
        SUBTS(0);
#ifdef M0_EARLY_LOAD
        {
            int it = C.gw; GdnRaw ga, gb;
            { const int i0 = it < 4096 ? it : 4095; gdn_stage1_load(C, i0, ga); gdn_stage1_load(C, i0 + 4096, gb); }
            m0_prep(C, l);
            SUBTS(1);
#pragma unroll 1
            while (it < 4096) {
                gdn_stage1_finish(C, l, it, ga, C.lds + C.wave * 20480); gdn_stage1_finish(C, l, it + 4096, gb, C.lds + C.wave * 20480);
                it += C.ngw;
                const int i1 = it < 4096 ? it : 4095; gdn_stage1_load(C, i1, ga); gdn_stage1_load(C, i1 + 4096, gb);
            }
        }
#else
#ifndef NO_M0
        m0_prep(C, l);
#endif
        SUBTS(1);
        for (int it = C.gw; it < 4096; it += C.ngw) { GdnRaw ga, gb; gdn_stage1_load(C, it, ga); gdn_stage1_load(C, it + 4096, gb);
            gdn_stage1_finish(C, l, it, ga, C.lds + C.wave * 20480); gdn_stage1_finish(C, l, it + 4096, gb, C.lds + C.wave * 20480); }
#endif
        SUBTS(2);
        SUBTS(3);
        SUBTS(4);
        SUBTS(5);
#ifdef DUP_GDN1
        { GdnRaw ga, gb; int it = C.gw;
          if (it < 8192) gdn_stage1_load(C, it, ga);
          for (; it < 8192; it += 2 * C.ngw) {
              if (it + C.ngw < 8192) gdn_stage1_load(C, it + C.ngw, gb);
              gdn_stage1_finish(C, l, it, ga, C.lds + C.wave * 20480);
              if (it + C.ngw < 8192) { if (it + 2 * C.ngw < 8192) gdn_stage1_load(C, it + 2 * C.ngw, ga); gdn_stage1_finish(C, l, it + C.ngw, gb, C.lds + C.wave * 20480); }
          } }
#endif
#ifdef DUP_FVT
        for (int r_ = 0; r_ < 4; ++r_) for (int it = C.gw; it < 8192; it += C.ngw) fox_vt_item(C, it);
#endif
        GRID_SYNC();
        PHASE_BEGIN();
#ifndef NO_M1
        m1_mixers(C, l);
#ifdef DUP_M1
        GRID_SYNC(); m1_mixers(C, l);
#endif
#endif
        GRID_SYNC();
        PHASE_BEGIN();
        {
            pg8::Gemm g{(const bf16*)(C.ws + WS_O), (const bf16*)(C.ws + WS_WOT) + (size_t)l * DM * DM, MTOK, DM, DM}; pg8::StaticOrder S; S.init(MTOK, DM, G, (int)blockIdx.x);
            pg8::EpiRes<false> E{XB, nullptr, ss + (size_t)(2 + l) * MTOK};
#ifndef NO_G2
#ifdef STAG_G2
            if (blockIdx.x & 1) { const unsigned long long t0_ = __builtin_amdgcn_s_memrealtime(); while (__builtin_amdgcn_s_memrealtime() - t0_ < (unsigned long long)STAG_G2) __builtin_amdgcn_s_sleep(8); }
#endif
            pg8::gemm_phase<pg8::EpiRes<false>, pg8::StaticOrder, true, true>(C.lds, g, S, E, C.tid);
#ifdef DUP_G2P
            { GRID_SYNC(); pg8::EpiRes<false> E2{XB, nullptr, (float*)(C.ws + WS_HALO), (bf16*)(C.ws + WS_P)}; pg8::gemm_phase<pg8::EpiRes<false>, pg8::StaticOrder, true, true>(C.lds, g, S, E2, C.tid); }
#endif
#ifdef DUP_G2_OLD
            if (l == 0) { GRID_SYNC(); pg8::EpiRes E2{C.ka->in[0], C.out, XB, (float*)(C.ws + WS_HALO)}; pg8::gemm_phase<pg8::EpiRes, pg8::StaticOrder, true, true>(C.lds, g, S, E2, C.tid); }
#endif
#endif
        }
        GRID_SYNC();
        PHASE_BEGIN();
        {
            pg8::Gemm g{XB, (const bf16*)(C.ws + WS_WUT) + (size_t)l * NUP * DM, MTOK, NUP, DM}; pg8::StaticOrder S; S.init(MTOK, NUP, G, (int)blockIdx.x);
            pg8::EpiConv E{(bf16*)(C.ws + WS_ACT), (float*)(C.ws + WS_HALO), ss + (size_t)(2 + l) * MTOK, (const float*)(C.ws + WS_CWS) + (size_t)l * 4 * NUP, (const float*)(C.ws + WS_CWS) + (size_t)l * 4 * NUP + 3 * NUP, (LAS float*)(C.lds + 131072)};
#ifndef NO_G3
            pg8::gemm_phase<pg8::EpiConv, pg8::StaticOrder, true, true>(C.lds, g, S, E, C.tid);
#ifdef DUP_G3
            GRID_SYNC(); pg8::gemm_phase<pg8::EpiConv, pg8::StaticOrder, true, true>(C.lds, g, S, E, C.tid);
#endif
#endif
        }
        GRID_SYNC();
#ifdef SEPARATE_FIX
        PHASE_BEGIN();
        cv_fixup(C, l);
        GRID_SYNC();
#endif
#ifdef DUP_SYNC
        for (int q = 0; q < 10; ++q) GRID_SYNC();
#endif
        PHASE_BEGIN();
        {
            pg8::Gemm g{(const bf16*)(C.ws + WS_ACT), (const bf16*)(C.ws + WS_WDT) + (size_t)l * DM * DFF, MTOK, DM, DFF}; pg8::StaticOrder S; S.init(MTOK, DM, G, (int)blockIdx.x);
#ifndef SEPARATE_FIX
            cv_fix_rows(C, l, S);
#endif
            if (l + 1 < DEPTH) { pg8::EpiRes<false> E{XB, nullptr, ss + (size_t)(l + 1) * MTOK};
#ifdef DUP_G4P
                { pg8::EpiRes<false> E2{XB, nullptr, (float*)(C.ws + WS_HALO), (bf16*)(C.ws + WS_P)}; pg8::gemm_phase<pg8::EpiRes<false>, pg8::StaticOrder, true, true>(C.lds, g, S, E2, C.tid); GRID_SYNC(); }
#endif
                pg8::gemm_phase<pg8::EpiRes<false>, pg8::StaticOrder, true, true>(C.lds, g, S, E, C.tid);
            } else { pg8::EpiRes<true> E{XB, C.out, nullptr};
                pg8::gemm_phase<pg8::EpiRes<true>, pg8::StaticOrder, true, true>(C.lds, g, S, E, C.tid); }
        }
        GRID_SYNC();
    }
#ifdef PROBE_TS
    unsigned zq_ = 0; asm volatile("" : "+s"(zq_));
    if (blockIdx.x == PROBE_BLK && tid_from(wv0, zq_) == 0) {
        const unsigned long long d = tsl[PROBE_B] - tsl[PROBE_A], t0 = __builtin_amdgcn_s_memrealtime();
        while (__builtin_amdgcn_s_memrealtime() - t0 < 8ull * d) __builtin_amdgcn_s_sleep(16);
    }
#endif
}

extern "C" void kernel_launch(void* const* d_in, const int* in_sizes, int n_in, void* d_out, int out_size, void* d_ws, size_t ws_size, hipStream_t stream) {
    static int grid = 0;
    if (grid == 0) {
        if (n_in != 22 || in_sizes[0] != MTOK * DM || out_size != MTOK * DM || ws_size < WS_END) {
            fprintf(stderr, "kernel_launch: unexpected problem (n_in %d, in0 %d, out %d, ws %zu < %zu)\n", n_in, n_in > 0 ? in_sizes[0] : -1, out_size, ws_size, (size_t)WS_END); grid = -1; return; }
        int dev = 0, cus = 0, per_cu = 0;
        (void)hipGetDevice(&dev); (void)hipDeviceGetAttribute(&cus, hipDeviceAttributeMultiprocessorCount, dev);
        if (hipFuncSetAttribute((const void*)fwd_megakernel, hipFuncAttributeMaxDynamicSharedMemorySize, LDS_BYTES) != hipSuccess) { fprintf(stderr, "kernel_launch: hipFuncSetAttribute failed\n"); grid = -1; return; }
        if (hipOccupancyMaxActiveBlocksPerMultiprocessor(&per_cu, (const void*)fwd_megakernel, NTHREADS, LDS_BYTES) != hipSuccess || per_cu < 1) { fprintf(stderr, "kernel_launch: occupancy query says %d blocks per CU\n", per_cu); per_cu = 1; }
        (void)hipGetLastError();
        grid = cus;
    }
    if (grid < 0) return;
    if (hipMemsetAsync((char*)d_ws + WS_BAR, 0, 16384, stream) != hipSuccess) { fprintf(stderr, "kernel_launch: memset of the barrier words failed\n"); return; }
    Args a{};
    for (int i = 0; i < 22; ++i) a.in[i] = (const float*)d_in[i];
    a.out = (float*)d_out; a.ws = (unsigned char*)d_ws;
    void* kargs[] = {&a};
    hipError_t e = hipLaunchCooperativeKernel((const void*)fwd_megakernel, dim3(grid), dim3(NTHREADS), kargs, LDS_BYTES, stream);
    if (e != hipSuccess) fprintf(stderr, "kernel_launch: cooperative launch failed: %s (grid %d)\n", hipGetErrorString(e), grid);
}
```
